# Optimizing an MI355X kernel written in HIP

```python
import functools
import jax
import jax.numpy as jnp
from jax import lax
import numpy as np

D_MODEL = 2048
BATCH = 2
SEQ = 4096
DEPTH = 2
DEC_BATCH = 8
DEC_SEQ = 4
PAST_LEN = 16384
PAGE_SIZE = 128

N_BRANCH = 4
BRANCH_W = D_MODEL // 4
A_W = BRANCH_W
A_GROUPS = 4
A_GW = A_W // A_GROUPS
CHUNK = 128
B_HEADS = 4
B_HD = BRANCH_W // B_HEADS
Q_BLOCK = 128
B_BIAS_INIT = -6.0
C_W = BRANCH_W
C_HD = 64
C_HEADS = C_W // C_HD
C_RW = 64
C_RA = 64
C_RG = 128
C_SHIFT = 3 * C_W + C_RW + C_RA + C_RG
D_W = BRANCH_W
CONV_K = 31
FFN_HIDDEN = -(-8 * D_MODEL // (3 * 256)) * 256

IN_SPLITS = [2 * A_W, 2 * A_W + 3 * BRANCH_W, 2 * A_W + 3 * BRANCH_W + C_SHIFT, 2 * A_W + 3 * BRANCH_W + C_SHIFT + 2 * D_W]
IN_W = 2 * A_W + 3 * BRANCH_W + C_SHIFT + 2 * D_W + N_BRANCH * D_MODEL
C_SPLITS = [C_W, 2 * C_W, 3 * C_W, 3 * C_W + C_RW, 3 * C_W + C_RW + C_RA]
RMS_EPS = 1e-6
LN_EPS = 1e-5
GN_EPS = 64e-5
F32 = jnp.float32

kernel_name = 'hybrid_gated_gmlp_stickbreak_rwkv7_conformer_step'


def rmsnorm(x, g):
    xf = x.astype(F32)
    y = xf * lax.rsqrt(jnp.mean(xf * xf, axis=-1, keepdims=True) + RMS_EPS)
    return (y * g.astype(F32)).astype(x.dtype)


def layernorm(x, g, b):
    xf = x.astype(F32)
    xc = xf - jnp.mean(xf, axis=-1, keepdims=True)
    var = jnp.mean(xc * xc, axis=-1, keepdims=True)
    return (xc * lax.rsqrt(var + LN_EPS) * g.astype(F32) + b.astype(F32)).astype(x.dtype)


def gmlp_branch(p_a, ln_g, ln_b, ws, bs, w_o):
    bsz, L, _ = p_a.shape
    z = jax.nn.gelu(p_a)
    u, v = jnp.split(z, 2, axis=-1)
    v = layernorm(v, ln_g, ln_b)
    c = min(L, CHUNK)
    causal = jnp.tril(jnp.ones((c, c), dtype=bool))
    w = jnp.where(causal, ws[:, :c, :c], jnp.zeros((), ws.dtype)).astype(v.dtype)
    vb = v.reshape(bsz, L // c, c, A_GROUPS, A_GW)
    s = jnp.einsum('gts,bnsgc->bntgc', w, vb) + bs[:, :c].T.astype(v.dtype)[None, None, :, :, None]
    y = (u * s.reshape(bsz, L, A_W)) @ w_o
    return y, v


def sb_attend(q, k, v, bias, q_pos, k_pos):
    z = jnp.einsum('bqhd,bkhd->bhqk', q, k).astype(F32) * (B_HD ** -0.5) + bias.astype(F32)[None, :, None, None]
    vis = k_pos[None, :] < q_pos[:, None]
    log_1m = jnp.where(vis, jax.nn.log_sigmoid(-z), 0.0)
    between = lax.cumsum(log_1m, axis=3, reverse=True) - log_1m
    att = jnp.where(vis, jnp.exp(jax.nn.log_sigmoid(z) + between), 0.0)
    return jnp.einsum('bhqk,bkhd->bqhd', att.astype(v.dtype), v)


def sb_prompt(q, k, v, bias):
    bsz, L, H, Dh = q.shape
    nb = L // Q_BLOCK
    qb = jnp.moveaxis(q.reshape(bsz, nb, Q_BLOCK, H, Dh), 1, 0)
    k_pos = jnp.arange(L)

    def one_block(args):
        q_blk, i = args
        return sb_attend(q_blk, k, v, bias, i * Q_BLOCK + jnp.arange(Q_BLOCK), k_pos)

    o = lax.map(one_block, (qb, jnp.arange(nb)))
    return jnp.moveaxis(o, 0, 1).reshape(bsz, L, H, Dh)


def sb_sample(q, k, v, bias, k_past=None, v_past=None):
    P = k_past.shape[1]
    L = q.shape[1]
    k_all = jnp.concatenate([k_past.astype(k.dtype), k], axis=1)
    v_all = jnp.concatenate([v_past.astype(v.dtype), v], axis=1)
    return sb_attend(q, k_all, v_all, bias, P + jnp.arange(L), jnp.arange(P + L))


def wkv_scan(s0, r, w, k, v, kk, a):
    seq = tuple(jnp.moveaxis(t, 1, 0) for t in (r, w, k, v, kk, a))

    def step(s, inp):
        r_t, w_t, k_t, v_t, kk_t, a_t = inp
        s_kk = jnp.einsum('bhvk,bhk->bhv', s, kk_t)
        s = s * w_t[:, :, None, :] - s_kk[..., None] * (kk_t * a_t)[:, :, None, :] + v_t[..., None] * k_t[:, :, None, :]
        return s, jnp.einsum('bhvk,bhk->bhv', s, r_t)

    s, o = lax.scan(step, s0.astype(F32), seq)
    return s, jnp.moveaxis(o, 0, 1)


def rwkv_branch(p_c, shift0, wkv0, mu, w0, w_up, a0, a_up, g_up, k_k, k_a, r_k, gn_g, gn_b, w_o):
    bsz, L, _ = p_c.shape
    pc = p_c.astype(F32)
    prev = jnp.concatenate([shift0.astype(F32)[:, None], pc[:, :-1]], axis=1)
    xs = pc + (prev - pc) * mu.astype(F32)
    r, k, v, xw, xa, xg = jnp.split(xs, C_SPLITS, axis=-1)
    w_log = -jax.nn.softplus(-(w0 + jnp.tanh(xw) @ w_up)) - 0.5
    decay = jnp.exp(-jnp.exp(w_log))
    a = jax.nn.sigmoid(a0 + xa @ a_up)
    g = jax.nn.sigmoid(xg) @ g_up
    hs = (bsz, L, C_HEADS, C_HD)
    kk = (k * k_k).reshape(hs)
    kk = kk * lax.rsqrt(jnp.maximum(jnp.sum(kk * kk, axis=-1, keepdims=True), 1e-24))
    k = k * (1.0 + (a - 1.0) * k_a)
    r, k, v, decay, a = (t.reshape(hs) for t in (r, k, v, decay, a))
    s, o = wkv_scan(wkv0, r, decay, k, v, kk, a)
    oc = o - jnp.mean(o, axis=-1, keepdims=True)
    o = oc * lax.rsqrt(jnp.mean(oc * oc, axis=-1, keepdims=True) + GN_EPS)
    o = o.reshape(bsz, L, C_W) * gn_g + gn_b
    o = o + (jnp.sum(r * k * r_k, axis=-1, keepdims=True) * v).reshape(bsz, L, C_W)
    y = (o * g) @ w_o
    return y.astype(p_c.dtype), s.astype(wkv0.dtype), p_c[:, -1]


def conv_branch(p_d, conv0, conv_w, conv_b, ln_g, ln_b, w_o):
    val, gate = jnp.split(p_d, 2, axis=-1)
    z = val * jax.nn.sigmoid(gate)
    zc = jnp.concatenate([conv0.astype(z.dtype), z], axis=1)
    y = lax.conv_general_dilated(zc, conv_w[:, None, :].astype(z.dtype), window_strides=(1,), padding='VALID',
                                 dimension_numbers=('NWC', 'WIO', 'NWC'), feature_group_count=D_W)
    y = jax.nn.silu(layernorm(y + conv_b.astype(z.dtype), ln_g, ln_b))
    return y @ w_o, zc[:, -(CONV_K - 1):]


def trunk_layer(x, lp, attend, shift0, wkv0, conv0):
    bsz, L, _ = x.shape
    h = rmsnorm(x, lp['norm_mix'])
    p = h @ lp['w_in']
    p_a, p_b, p_c, p_d, p_g = jnp.split(p, IN_SPLITS, axis=-1)
    y_a, v_a = gmlp_branch(p_a, lp['a_ln_g'], lp['a_ln_b'], lp['a_ws'], lp['a_bs'], lp['a_out'])
    q, k, v = jnp.split(p_b, 3, axis=-1)
    hs = (bsz, L, B_HEADS, B_HD)
    q = rmsnorm(q.reshape(hs), lp['b_qn'])
    k = rmsnorm(k.reshape(hs), lp['b_kn'])
    v = v.reshape(hs)
    y_b = attend(q, k, v, lp['b_bias']).reshape(bsz, L, BRANCH_W) @ lp['b_out']
    y_c, wkv1, shift1 = rwkv_branch(p_c, shift0, wkv0, lp['c_mu'], lp['c_w0'], lp['c_w_up'], lp['c_a0'], lp['c_a_up'],
                                    lp['c_g_up'], lp['c_k_k'], lp['c_k_a'], lp['c_r_k'], lp['c_gn_g'], lp['c_gn_b'], lp['c_out'])
    y_d, conv1 = conv_branch(p_d, conv0, lp['d_conv_w'], lp['d_conv_b'], lp['d_ln_g'], lp['d_ln_b'], lp['d_out'])
    gates = jax.nn.sigmoid(p_g.astype(F32)).reshape(bsz, L, N_BRANCH, D_MODEL)
    branches = jnp.stack([y_a, y_b, y_c, y_d], axis=2).astype(F32)
    merged = jnp.sum(gates * branches, axis=2).astype(x.dtype)
    x = x + merged @ lp['w_mix_out']
    h2 = rmsnorm(x, lp['norm_ffn'])
    x = x + (jax.nn.silu(h2 @ lp['f_gate']) * (h2 @ lp['f_up'])) @ lp['f_down']
    return x, k, v, wkv1, shift1, conv1, v_a


def setup_inputs(seed: int = 0) -> dict:
    key = jax.random.key(seed)
    ks = iter(jax.random.split(key, 48))
    nrm = lambda shape, scale: jax.random.normal(next(ks), shape, F32) * scale
    gain = lambda shape: 1.0 + 0.02 * jax.random.normal(next(ks), shape, F32)
    n_pages = PAST_LEN // PAGE_SIZE
    n_used = DEC_BATCH * n_pages
    n_phys = n_used + n_used // 4
    page_table = jax.random.permutation(next(ks), n_phys)[:n_used].reshape(DEC_BATCH, n_pages).astype(jnp.int32)
    return {
        'x_prompt': nrm((BATCH, SEQ, D_MODEL), 1.0),
        'x_sample': nrm((DEC_BATCH, DEC_SEQ, D_MODEL), 1.0),
        'cache_k': nrm((DEPTH, n_phys, PAGE_SIZE, B_HEADS, B_HD), 1.0),
        'cache_v': nrm((DEPTH, n_phys, PAGE_SIZE, B_HEADS, B_HD), 1.0),
        'page_table': page_table,
        'state_wkv': nrm((DEPTH, DEC_BATCH, C_HEADS, C_HD, C_HD), 0.3),
        'state_shift': nrm((DEPTH, DEC_BATCH, C_SHIFT), 1.0),
        'state_conv': nrm((DEPTH, DEC_BATCH, CONV_K - 1, D_W), 0.5),
        'norm_mix': gain((DEPTH, D_MODEL)),
        'w_in': nrm((DEPTH, D_MODEL, IN_W), D_MODEL ** -0.5),
        'a_ln_g': gain((DEPTH, A_W)),
        'a_ln_b': nrm((DEPTH, A_W), 0.02),
        'a_ws': nrm((DEPTH, A_GROUPS, CHUNK, CHUNK), CHUNK ** -0.5),
        'a_bs': 1.0 + nrm((DEPTH, A_GROUPS, CHUNK), 0.1),
        'a_out': nrm((DEPTH, A_W, D_MODEL), A_W ** -0.5),
        'b_qn': gain((DEPTH, B_HD)),
        'b_kn': gain((DEPTH, B_HD)),
        'b_bias': B_BIAS_INIT + nrm((DEPTH, B_HEADS), 0.1),
        'b_out': nrm((DEPTH, BRANCH_W, D_MODEL), BRANCH_W ** -0.5),
        'c_mu': jax.random.uniform(next(ks), (DEPTH, C_SHIFT), F32),
        'c_w0': nrm((DEPTH, C_W), 0.5),
        'c_w_up': nrm((DEPTH, C_RW, C_W), 0.5 * C_RW ** -0.5),
        'c_a0': nrm((DEPTH, C_W), 0.5),
        'c_a_up': nrm((DEPTH, C_RA, C_W), 0.5 * C_RA ** -0.5),
        'c_g_up': nrm((DEPTH, C_RG, C_W), C_RG ** -0.5),
        'c_k_k': 0.85 + nrm((DEPTH, C_W), 0.05),
        'c_k_a': 1.0 + nrm((DEPTH, C_W), 0.05),
        'c_r_k': nrm((DEPTH, C_HEADS, C_HD), 0.1),
        'c_gn_g': gain((DEPTH, C_W)),
        'c_gn_b': nrm((DEPTH, C_W), 0.02),
        'c_out': nrm((DEPTH, C_W, D_MODEL), C_W ** -0.5),
        'd_conv_w': nrm((DEPTH, CONV_K, D_W), CONV_K ** -0.5),
        'd_conv_b': nrm((DEPTH, D_W), 0.02),
        'd_ln_g': gain((DEPTH, D_W)),
        'd_ln_b': nrm((DEPTH, D_W), 0.02),
        'd_out': nrm((DEPTH, D_W, D_MODEL), D_W ** -0.5),
        'w_mix_out': nrm((DEPTH, D_MODEL, D_MODEL), D_MODEL ** -0.5),
        'norm_ffn': gain((DEPTH, D_MODEL)),
        'f_gate': nrm((DEPTH, D_MODEL, FFN_HIDDEN), D_MODEL ** -0.5),
        'f_up': nrm((DEPTH, D_MODEL, FFN_HIDDEN), D_MODEL ** -0.5),
        'f_down': nrm((DEPTH, FFN_HIDDEN, D_MODEL), FFN_HIDDEN ** -0.5),
    }


def reference(x_prompt, x_sample, cache_k, cache_v, page_table, state_wkv, state_shift, state_conv,
              norm_mix, w_in, a_ln_g, a_ln_b, a_ws, a_bs, a_out, b_qn, b_kn, b_bias, b_out,
              c_mu, c_w0, c_w_up, c_a0, c_a_up, c_g_up, c_k_k, c_k_a, c_r_k, c_gn_g, c_gn_b, c_out,
              d_conv_w, d_conv_b, d_ln_g, d_ln_b, d_out, w_mix_out, norm_ffn, f_gate, f_up, f_down):
    n_pages = page_table.shape[1]
    bp = x_prompt.shape[0]
    bs_ = x_sample.shape[0]
    dt = x_prompt.dtype
    yp, ys = x_prompt, x_sample
    kp_l, vp_l, ks_l, vs_l, wp_l, ws_l, sp_l, ss_l, cp_l, cs_l, gv_l = [], [], [], [], [], [], [], [], [], [], []
    for l in range(DEPTH):
        lp = {
            'norm_mix': norm_mix[l], 'w_in': w_in[l],
            'a_ln_g': a_ln_g[l], 'a_ln_b': a_ln_b[l], 'a_ws': a_ws[l], 'a_bs': a_bs[l], 'a_out': a_out[l],
            'b_qn': b_qn[l], 'b_kn': b_kn[l], 'b_bias': b_bias[l], 'b_out': b_out[l],
            'c_mu': c_mu[l], 'c_w0': c_w0[l], 'c_w_up': c_w_up[l], 'c_a0': c_a0[l], 'c_a_up': c_a_up[l],
            'c_g_up': c_g_up[l], 'c_k_k': c_k_k[l], 'c_k_a': c_k_a[l], 'c_r_k': c_r_k[l],
            'c_gn_g': c_gn_g[l], 'c_gn_b': c_gn_b[l], 'c_out': c_out[l],
            'd_conv_w': d_conv_w[l], 'd_conv_b': d_conv_b[l], 'd_ln_g': d_ln_g[l], 'd_ln_b': d_ln_b[l], 'd_out': d_out[l],
            'w_mix_out': w_mix_out[l], 'norm_ffn': norm_ffn[l],
            'f_gate': f_gate[l], 'f_up': f_up[l], 'f_down': f_down[l],
        }
        yp, kp, vp, wp, sp, cp, _ = trunk_layer(
            yp, lp, sb_prompt,
            jnp.zeros((bp, C_SHIFT), dt), jnp.zeros((bp, C_HEADS, C_HD, C_HD), F32), jnp.zeros((bp, CONV_K - 1, D_W), dt))
        k_past = cache_k[l][page_table].reshape(bs_, n_pages * PAGE_SIZE, B_HEADS, B_HD)
        v_past = cache_v[l][page_table].reshape(bs_, n_pages * PAGE_SIZE, B_HEADS, B_HD)
        attend_s = functools.partial(sb_sample, k_past=k_past, v_past=v_past)
        ys, ksn, vsn, wsn, ssn, csn, gvs = trunk_layer(ys, lp, attend_s, state_shift[l], state_wkv[l], state_conv[l])
        kp_l.append(kp); vp_l.append(vp); ks_l.append(ksn); vs_l.append(vsn)
        wp_l.append(wp); ws_l.append(wsn); sp_l.append(sp); ss_l.append(ssn)
        cp_l.append(cp); cs_l.append(csn); gv_l.append(gvs)
    k_prompt = jnp.stack(kp_l)
    v_prompt = jnp.stack(vp_l)
    k_sample = jnp.stack(ks_l)
    v_sample = jnp.stack(vs_l)
    wkv_prompt = jnp.stack(wp_l)
    wkv_sample = jnp.stack(ws_l)
    shift_prompt = jnp.stack(sp_l)
    shift_sample = jnp.stack(ss_l)
    conv_prompt = jnp.stack(cp_l)
    conv_sample = jnp.stack(cs_l)
    gmlp_v_sample = jnp.stack(gv_l)
    return (yp, ys, k_prompt, v_prompt, k_sample, v_sample, wkv_prompt, wkv_sample,
            shift_prompt, shift_sample, conv_prompt, conv_sample, gmlp_v_sample)
```

```cpp
#include <hip/hip_runtime.h>
#include <cstdio>
#include <cstdint>

#define LAS __attribute__((address_space(3)))
typedef unsigned short bf16;
typedef short bf16x8 __attribute__((ext_vector_type(8)));
typedef float f32x4 __attribute__((ext_vector_type(4)));
typedef float f32x16 __attribute__((ext_vector_type(16)));
typedef float f32x2 __attribute__((ext_vector_type(2)));
typedef unsigned u32x4 __attribute__((ext_vector_type(4)));
typedef unsigned u32x2 __attribute__((ext_vector_type(2)));
typedef const __attribute__((address_space(4))) float cfloat;

constexpr int D = 2048, SEQ = 4096, NL = 2, NSB = 8, NST = 4, NPAGES = 128, NPHYS = 1280;
constexpr int BW = 512, FF = 5632, INW = 13568, NPRE = 5376, NGATE = 8192, CSHIFT = 1792;
constexpr int MP = 8192, MS = 32, MR = 8224, MPAD = 8448;
constexpr int PA0 = 0, PB0 = 1024, PC0 = 2560, PD0 = 4352;
constexpr float LOG2E = 1.4426950408889634f;

constexpr size_t O_Y = 0, O_KP = 16842752, O_VP = 25231360, O_KS = 33619968, O_VS = 33652736, O_WP = 33685504, O_WS = 33816576,
                 O_SHP = 34340864, O_SHS = 34348032, O_CP = 34376704, O_CS = 34438144, O_GV = 34683904, O_END = 34716672;

constexpr size_t al(size_t x) { return (x + 1048575) & ~(size_t)1048575; }
constexpr size_t WS_CTL = 0, CTL_BYTES = 1048576;
constexpr size_t SZ_WIN = (size_t)INW * D * 2, SZ_WBO = (size_t)4 * D * BW * 2, SZ_WMIX = (size_t)D * D * 2, SZ_WGU = (size_t)2 * FF * D * 2, SZ_WDN = (size_t)D * FF * 2, SZ_LW = (size_t)512 * 256 * 2;
constexpr size_t WS_WIN = al(WS_CTL + CTL_BYTES);
constexpr size_t WS_WBO = al(WS_WIN + NL * SZ_WIN);
constexpr size_t WS_WMIX = al(WS_WBO + NL * SZ_WBO);
constexpr size_t WS_WGU = al(WS_WMIX + NL * SZ_WMIX);
constexpr size_t WS_WDN = al(WS_WGU + NL * SZ_WGU);
constexpr size_t WS_LW = al(WS_WDN + NL * SZ_WDN);
constexpr size_t WS_H = al(WS_LW + NL * SZ_LW);
constexpr size_t WS_P = al(WS_H + (size_t)MPAD * D * 2);
constexpr size_t WS_G = al(WS_P + (size_t)MPAD * NPRE * 2);
constexpr size_t WS_ACT = al(WS_G + (size_t)MPAD * NGATE * 2);
constexpr size_t WS_MF = al(WS_ACT + (size_t)4 * MPAD * BW * 2);
constexpr size_t WS_MB = al(WS_MF + 1048576);
constexpr size_t WS_X1 = al(WS_MB + (size_t)MPAD * D * 2);
constexpr size_t WS_HID = al(WS_X1 + (size_t)MPAD * D * 4);
constexpr size_t WS_XL = al(WS_HID + (size_t)MPAD * FF * 2);
constexpr size_t WS_QB = al(WS_XL + (size_t)MPAD * D * 4);
constexpr size_t WS_KB = al(WS_QB + (size_t)MP * BW * 2);
constexpr size_t WS_VT = al(WS_KB + (size_t)MP * BW * 2);
constexpr size_t WS_QS = al(WS_VT + (size_t)MP * BW * 2);
constexpr size_t WS_OSEG = al(WS_QS + (size_t)MS * BW * 4);
constexpr size_t WS_TSEG = al(WS_OSEG + (size_t)8 * 64 * 16 * 128 * 4);
constexpr size_t SZ_RW = (size_t)MR * BW * 4;
constexpr size_t WS_R = al(WS_TSEG + 8 * 64 * 16 * 4);
constexpr size_t SZ_RWL = al(SZ_RW);
constexpr size_t WS_W = WS_R + NL * SZ_RWL, WS_KX = WS_W + NL * SZ_RWL, WS_V = WS_KX + NL * SZ_RWL, WS_KK = al(WS_V + SZ_RW), WS_KKA = WS_KK + NL * SZ_RWL, WS_GG = WS_KKA + NL * SZ_RWL;
constexpr size_t WS_OL = al(WS_GG + SZ_RW), WS_PR = al(WS_OL + SZ_RW);
constexpr size_t WS_RK = al(WS_PR + SZ_RW);
constexpr size_t SZ_CH = (size_t)16 * 64 * 4096 * 4;
constexpr size_t WS_PC = al(WS_RK + (size_t)MR * 8 * 4), WS_LC = al(WS_PC + SZ_CH), WS_SS = al(WS_LC + SZ_CH);
constexpr size_t WS_OPART = al(WS_SS + SZ_CH);
constexpr size_t WS_TPART = al(WS_OPART + (size_t)8 * 16 * 2 * 8 * 8 * 64 * 16);
constexpr size_t WS_END = al(WS_TPART + (size_t)8 * 16 * 8 * 64 * 4);

constexpr int CW_BAR = 4096;
constexpr int CW_RS = 16384;
constexpr int CW_Q = 8192;

constexpr int LDS_BYTES = 147456, LDS_CTL_OFF = 143360;

__device__ __forceinline__ unsigned f2bf(float f) { unsigned u = __builtin_bit_cast(unsigned, f); return (u + 0x7fffu + ((u >> 16) & 1u)) >> 16; }
typedef __bf16 bf16x2_t __attribute__((ext_vector_type(2)));
__device__ __forceinline__ unsigned pk2(float lo, float hi) { const f32x2 v = {lo, hi}; const bf16x2_t b = __builtin_convertvector(v, bf16x2_t); return __builtin_bit_cast(unsigned, b); }
__device__ __forceinline__ float wave_sum(float v) {
#pragma unroll
    for (int o = 1; o < 64; o <<= 1) v += __shfl_xor(v, o);
    return v;
}
__device__ __forceinline__ float ex2(float x) { return __builtin_amdgcn_exp2f(x); }
__device__ __forceinline__ float rcpf_(float x) { return __builtin_amdgcn_rcpf(x); }
__device__ __forceinline__ float sigmoidf_(float x) { return rcpf_(1.0f + ex2(-x * LOG2E)); }
__device__ __forceinline__ float gelu_tanh(float x) {
    const float u = 0.7978845608028654f * (x + 0.044715f * x * x * x);
    const float t = 1.0f - 2.0f * rcpf_(1.0f + ex2(2.0f * LOG2E * u));
    return 0.5f * x * (1.0f + t);
}
__device__ __forceinline__ f32x4 ldb4(const bf16* p) { const u32x2 w = *(const u32x2*)p; return (f32x4){__builtin_bit_cast(float, w.x << 16), __builtin_bit_cast(float, w.x & 0xffff0000u), __builtin_bit_cast(float, w.y << 16), __builtin_bit_cast(float, w.y & 0xffff0000u)}; }
#define LDS_WAIT() asm volatile("s_waitcnt lgkmcnt(0)" ::: "memory")
#define VM_WAIT() asm volatile("s_waitcnt vmcnt(0)" ::: "memory")

namespace pg8 {
typedef unsigned short bf16_t;
constexpr int BM = 256, BK = 64, HALF = 128, HTB = HALF * BK * 2, STAGE_BYTES = 8 * HTB, NXCD = 8, WGM = 8;
__host__ __device__ __forceinline__ int lds_byte(int r, int c) { const int st = (r >> 4) * 2 + (c >> 5), rr = r & 15, cc = c & 31, ob = rr * 64 + cc * 2; return st * 1024 + (ob ^ (((ob >> 9) & 1) << 5)); }
__host__ __device__ __forceinline__ void stage_rc(int b, int& R, int& C) { const int st = b / 1024, sb = b % 1024, swz = sb ^ (((sb >> 9) & 1) << 5); R = (st >> 1) * 16 + swz / 64; C = (st & 1) * 32 + (swz % 64) / 2; }
__host__ __device__ __forceinline__ int perm32(int rho) { const int n = rho >> 4, i = rho & 15; return 8 * (i >> 2) + 4 * n + (i & 3); }
struct Unit { int pm, pn, pb; };
struct Gemm { const bf16_t* A; const bf16_t* Bt; int M, N, K; size_t sA, sB; };
struct StaticOrder {
    int nM, nN, nwg, G, c;
    __host__ __device__ void init(int M, int N, int G_, int c_) { nM = M / BM; nN = N / BM; nwg = nM * nN; G = G_; c = c_; }
    __host__ __device__ void initn(int nM_, int nN_, int G_, int c_) { nM = nM_; nN = nN_; nwg = nM * nN; G = G_; c = c_; }
    __host__ __device__ bool next(int i, Unit& u) const {
        const long L = (long)i * G + c; if (L >= nwg) return false;
        int wgid = (int)L; { const int q = nwg / NXCD, r = nwg % NXCD, xcd = wgid % NXCD, off = wgid / NXCD; wgid = (xcd < r ? xcd * (q + 1) : r * (q + 1) + (xcd - r) * q) + off; }
        const int nig = WGM * nN, gid = wgid / nig, fm = gid * WGM, gsz = (nM - fm) < WGM ? (nM - fm) : WGM;
        u.pm = fm + ((wgid % nig) % gsz); u.pn = (wgid % nig) / gsz; u.pb = 0; return true;
    }
};
struct MergeOrder {
    StaticOrder so;
    __host__ __device__ bool next(int i, Unit& u) const { if (!so.next(i >> 2, u)) return false; u.pb = i & 3; return true; }
};
__device__ __forceinline__ unsigned cvt_pk_bf16(float lo, float hi) { return pk2(lo, hi); }

template <class Epi, class Sched, bool ALIGN_EPI, int NB = 2>
__device__ __forceinline__ void gemm_phase(const int tid, LAS unsigned char* lds, const Gemm g, const Sched& S, const Epi& E) {
    const int wid = __builtin_amdgcn_readfirstlane(tid >> 6), lane = tid & 63, wr = wid >> 2, wc = wid & 3, fr = lane & 15, fq = lane >> 4;
    const int K = g.K, nt = K / BK;
    unsigned voffA[2], voffB[2];
#pragma unroll
    for (int i = 0; i < 2; ++i) { int R, C; stage_rc(tid * 16 + i * 8192, R, C); const int Rb = (R & ~31) + perm32(R & 31);
        voffA[i] = (unsigned)(R * K + C) * 2u; voffB[i] = (unsigned)(Rb * K + C) * 2u; }
    const size_t kstep = (size_t)(BK * 2);
    const size_t hstep = (size_t)HALF * K * 2;
    const size_t tstep = 2 * hstep;
    const size_t bstep = (NB == 2) ? tstep : hstep;
    const unsigned ldsw = (unsigned)wid * 1024u;
    const int aoff = lds_byte(wr * 64 + fr, fq * 8), boff = lds_byte(wc * 32 + fr, fq * 8);
#define PG8_SA(b, h) (((b) * 2 + (h)) * HTB)
#define PG8_SB(b, h) ((4 + (b) * 2 + (h)) * HTB)
#define PG8_STAGE(bufoff, gbase, voff) do { _Pragma("unroll") for (int _i = 0; _i < 2; ++_i) \
        __builtin_amdgcn_global_load_lds((const unsigned*)((const char*)(gbase) + (voff)[_i]), (LAS unsigned*)(lds + (bufoff) + ldsw + _i * 8192), 16, 0, 0); } while (0)
#define PG8_LDA(dst, b, h) do { _Pragma("unroll") for (int m = 0; m < 4; ++m) _Pragma("unroll") for (int k = 0; k < 2; ++k) dst[m][k] = *(const LAS bf16x8*)(lds + PG8_SA(b, h) + aoff + m * 2048 + k * 1024); } while (0)
#define PG8_LDB(dst, b, h) do { _Pragma("unroll") for (int n = 0; n < 2; ++n) _Pragma("unroll") for (int k = 0; k < 2; ++k) dst[n][k] = *(const LAS bf16x8*)(lds + PG8_SB(b, h) + boff + n * 2048 + k * 1024); } while (0)
#define PG8_MMA(ai, bj, At, Bt) do { __builtin_amdgcn_s_setprio(1); _Pragma("unroll") for (int m = 0; m < 4; ++m) _Pragma("unroll") for (int n = 0; n < 2; ++n) _Pragma("unroll") for (int k = 0; k < 2; ++k) \
        acc[ai][bj][m][n] = __builtin_amdgcn_mfma_f32_16x16x32_bf16(Bt[n][k], At[m][k], acc[ai][bj][m][n], 0, 0, 0); __builtin_amdgcn_s_setprio(0); } while (0)
#define PG8_WAIT_V(n) asm volatile("s_waitcnt vmcnt(" #n ")" ::: "memory")
#define PG8_WAIT_L(n) asm volatile("s_waitcnt lgkmcnt(" #n ")" ::: "memory")
#define PG8_BAR __builtin_amdgcn_s_barrier()
#define PG8_SCHED __builtin_amdgcn_sched_barrier(0)
    Unit cur, nxt; int ui = 0;
    if (!S.next(0, cur)) return;
    f32x4 acc[2][NB][4][2];
    f32x4 xreg[NB == 1 ? 2 : 1][NB == 1 ? 4 : 1][NB == 1 ? 2 : 1];
#pragma unroll
    for (int a = 0; a < 2; ++a)
#pragma unroll
        for (int b = 0; b < NB; ++b)
#pragma unroll
            for (int m = 0; m < 4; ++m)
#pragma unroll
                for (int n = 0; n < 2; ++n) acc[a][b][m][n] = (f32x4){0.f, 0.f, 0.f, 0.f};
    bf16x8 At[4][2], B0[2][2], B1[NB == 2 ? 2 : 1][2];
    const char* cA = (const char*)(g.A + (size_t)cur.pb * g.sA) + (size_t)cur.pm * tstep; const char* cB = (const char*)(g.Bt + (size_t)cur.pb * g.sB) + (size_t)cur.pn * bstep;
    if constexpr (NB == 2) {
        PG8_STAGE(PG8_SB(0, 0), cB, voffB); PG8_STAGE(PG8_SB(0, 1), cB + hstep, voffB); PG8_STAGE(PG8_SA(0, 0), cA, voffA); PG8_STAGE(PG8_SA(0, 1), cA + hstep, voffA);
        if (wr == 1) PG8_BAR;
        PG8_WAIT_V(2); PG8_BAR;
        PG8_STAGE(PG8_SB(1, 0), cB + kstep, voffB); PG8_STAGE(PG8_SA(1, 0), cA + kstep, voffA); PG8_STAGE(PG8_SB(1, 1), cB + hstep + kstep, voffB);
        PG8_WAIT_V(6); PG8_BAR;
    } else {
        PG8_STAGE(PG8_SB(0, 0), cB, voffB); PG8_STAGE(PG8_SA(0, 0), cA, voffA); PG8_STAGE(PG8_SA(0, 1), cA + hstep, voffA);
        if (wr == 1) PG8_BAR;
        PG8_WAIT_V(2); PG8_BAR;
        PG8_STAGE(PG8_SB(1, 0), cB + kstep, voffB); PG8_STAGE(PG8_SA(1, 0), cA + kstep, voffA);
        PG8_WAIT_V(4); PG8_BAR;
    }
    for (;;) {
        const bool has_next = S.next(ui + 1, nxt);
        const char* nA = has_next ? (const char*)(g.A + (size_t)nxt.pb * g.sA) + (size_t)nxt.pm * tstep : cA; const char* nB = has_next ? (const char*)(g.Bt + (size_t)nxt.pb * g.sB) + (size_t)nxt.pn * bstep : cB;
        for (int t = 0; t < nt; t += 2) {
            const bool last = (t == nt - 2);
            const char* a1 = cA + (size_t)(t + 1) * kstep;
            const char* a2 = last ? nA : cA + (size_t)(t + 2) * kstep; const char* b2 = last ? nB : cB + (size_t)(t + 2) * kstep;
            const char* a3 = a2 + kstep; const char* b3 = b2 + kstep;
            if constexpr (NB == 2) {
            PG8_LDB(B0, 0, 0); PG8_LDB(B1, 0, 1); PG8_SCHED; PG8_LDA(At, 0, 0); PG8_STAGE(PG8_SA(1, 1), a1 + hstep, voffA);
            PG8_WAIT_V(8); PG8_WAIT_L(0); PG8_BAR; PG8_MMA(0, 0, At, B0); PG8_MMA(0, 1, At, B1); PG8_BAR; PG8_SCHED;
            PG8_LDA(At, 0, 1); PG8_STAGE(PG8_SB(0, 0), b2, voffB); PG8_STAGE(PG8_SB(0, 1), b2 + hstep, voffB); PG8_STAGE(PG8_SA(0, 0), a2, voffA);
            PG8_WAIT_V(8); PG8_WAIT_L(0); PG8_BAR; PG8_MMA(1, 0, At, B0); PG8_MMA(1, 1, At, B1); PG8_BAR; PG8_SCHED;
            PG8_LDB(B0, 1, 0); PG8_LDB(B1, 1, 1); PG8_SCHED; PG8_LDA(At, 1, 0); PG8_STAGE(PG8_SA(0, 1), a2 + hstep, voffA);
            PG8_WAIT_V(8); PG8_WAIT_L(0); PG8_BAR; PG8_MMA(0, 0, At, B0); PG8_MMA(0, 1, At, B1); PG8_BAR; PG8_SCHED;
            PG8_LDA(At, 1, 1); PG8_STAGE(PG8_SB(1, 0), b3, voffB); PG8_STAGE(PG8_SB(1, 1), b3 + hstep, voffB); PG8_STAGE(PG8_SA(1, 0), a3, voffA);
            PG8_WAIT_V(8); PG8_WAIT_L(0); PG8_BAR; PG8_MMA(1, 0, At, B0); PG8_MMA(1, 1, At, B1); PG8_BAR; PG8_SCHED;
            } else {
            PG8_LDB(B0, 0, 0); PG8_SCHED; PG8_LDA(At, 0, 0); PG8_STAGE(PG8_SA(1, 1), a1 + hstep, voffA);
            PG8_WAIT_V(6); PG8_WAIT_L(0); PG8_BAR; PG8_MMA(0, 0, At, B0); PG8_BAR; PG8_SCHED;
            PG8_LDA(At, 0, 1); PG8_STAGE(PG8_SB(0, 0), b2, voffB); PG8_STAGE(PG8_SA(0, 0), a2, voffA);
            PG8_WAIT_V(6); PG8_WAIT_L(0); PG8_BAR; PG8_MMA(1, 0, At, B0); PG8_BAR; PG8_SCHED;
            PG8_LDB(B0, 1, 0); PG8_SCHED; PG8_LDA(At, 1, 0); PG8_STAGE(PG8_SA(0, 1), a2 + hstep, voffA);
            PG8_WAIT_V(6); PG8_WAIT_L(0); PG8_BAR; PG8_MMA(0, 0, At, B0); PG8_BAR; PG8_SCHED;
            PG8_LDA(At, 1, 1); PG8_STAGE(PG8_SB(1, 0), b3, voffB); PG8_STAGE(PG8_SA(1, 0), a3, voffA);
            PG8_WAIT_V(6); PG8_WAIT_L(0); PG8_BAR; PG8_MMA(1, 0, At, B0); PG8_BAR; PG8_SCHED;
            }
        }
        if constexpr (ALIGN_EPI) { if (wr == 0) PG8_BAR; }
        if constexpr (NB == 2) E(acc, cur, wr, wc, fr, fq); else E(acc, xreg, cur, wr, wc, fr, fq);
        if (!has_next) break;
#pragma unroll
        for (int a = 0; a < 2; ++a)
#pragma unroll
            for (int b = 0; b < NB; ++b)
#pragma unroll
                for (int m = 0; m < 4; ++m)
#pragma unroll
                    for (int n = 0; n < 2; ++n) acc[a][b][m][n] = (f32x4){0.f, 0.f, 0.f, 0.f};
        cur = nxt; cA = nA; cB = nB; ++ui;
        if constexpr (ALIGN_EPI) { if (wr == 1) PG8_BAR; }
    }
    PG8_WAIT_V(0);
    if constexpr (!ALIGN_EPI) { if (wr == 0) PG8_BAR; }
    PG8_BAR;
#undef PG8_SA
#undef PG8_SB
#undef PG8_STAGE
#undef PG8_LDA
#undef PG8_LDB
#undef PG8_MMA
#undef PG8_WAIT_V
#undef PG8_WAIT_L
#undef PG8_BAR
#undef PG8_SCHED
}

struct EpiIn {
    bf16_t* P; bf16_t* G; const float* rs;
    __device__ __forceinline__ void operator()(const f32x4 (&acc)[2][2][4][2], const Unit& u, int wr, int wc, int fr, int fq) const {
        const int row0 = u.pm * BM + wr * 64 + fr;
        float scv[2][4];
#pragma unroll
        for (int ai = 0; ai < 2; ++ai)
#pragma unroll
            for (int m = 0; m < 4; ++m) scv[ai][m] = rs ? rs[row0 + ai * HALF + m * 16] : 0.f;
#pragma unroll
        for (int ai = 0; ai < 2; ++ai)
#pragma unroll
            for (int m = 0; m < 4; ++m) scv[ai][m] = rs ? 1.0f / sqrtf(scv[ai][m] * (1.0f / D) + 1e-6f) : 1.0f;
        if (u.pn < 21) {
            const int col0 = u.pn * BM + wc * 32 + 8 * fq;
#pragma unroll
            for (int ai = 0; ai < 2; ++ai)
#pragma unroll
                for (int m = 0; m < 4; ++m) { bf16_t* rowp = P + (size_t)(row0 + ai * HALF + m * 16) * NPRE + col0;
                    const float sc = scv[ai][m];
#pragma unroll
                    for (int bj = 0; bj < 2; ++bj) { const f32x4 v0 = acc[ai][bj][m][0] * sc, v1 = acc[ai][bj][m][1] * sc;
                        u32x4 w; w.x = cvt_pk_bf16(v0[0], v0[1]); w.y = cvt_pk_bf16(v0[2], v0[3]); w.z = cvt_pk_bf16(v1[0], v1[1]); w.w = cvt_pk_bf16(v1[2], v1[3]);
                        *(u32x4*)(rowp + bj * HALF) = w; } }
        } else {
            const int col0 = (u.pn - 21) * BM + wc * 32 + 8 * fq;
#pragma unroll
            for (int ai = 0; ai < 2; ++ai)
#pragma unroll
                for (int m = 0; m < 4; ++m) { bf16_t* rowp = G + (size_t)(row0 + ai * HALF + m * 16) * NGATE + col0;
                    const float sc = scv[ai][m];
#pragma unroll
                    for (int bj = 0; bj < 2; ++bj) { const f32x4 v0 = acc[ai][bj][m][0] * sc, v1 = acc[ai][bj][m][1] * sc;
                        u32x4 w; w.x = cvt_pk_bf16(sigmoidf_(v0[0]), sigmoidf_(v0[1])); w.y = cvt_pk_bf16(sigmoidf_(v0[2]), sigmoidf_(v0[3]));
                        w.z = cvt_pk_bf16(sigmoidf_(v1[0]), sigmoidf_(v1[1])); w.w = cvt_pk_bf16(sigmoidf_(v1[2]), sigmoidf_(v1[3]));
                        *(u32x4*)(rowp + bj * HALF) = w; } }
        }
    }
};
__device__ __forceinline__ f32x4 bf4lo(u32x4 g) { return (f32x4){__builtin_bit_cast(float, g.x << 16), __builtin_bit_cast(float, g.x & 0xffff0000u), __builtin_bit_cast(float, g.y << 16), __builtin_bit_cast(float, g.y & 0xffff0000u)}; }
__device__ __forceinline__ f32x4 bf4hi(u32x4 g) { return (f32x4){__builtin_bit_cast(float, g.z << 16), __builtin_bit_cast(float, g.z & 0xffff0000u), __builtin_bit_cast(float, g.w << 16), __builtin_bit_cast(float, g.w & 0xffff0000u)}; }
struct EpiMerge {
    const bf16_t* G; bf16_t* MB;
    __device__ __forceinline__ void operator()(const f32x4 (&acc)[2][1][4][2], f32x4 (&mr)[2][4][2], const Unit& u, int wr, int wc, int fr, int fq) const {
        const int row0 = u.pm * BM + wr * 64 + fr, col0 = u.pn * HALF + wc * 32 + 8 * fq;
        u32x4 gv[2][4];
#pragma unroll
        for (int ai = 0; ai < 2; ++ai)
#pragma unroll
            for (int m = 0; m < 4; ++m) gv[ai][m] = *(const u32x4*)(G + (size_t)(row0 + ai * HALF + m * 16) * NGATE + (size_t)u.pb * D + col0);
#pragma unroll
        for (int ai = 0; ai < 2; ++ai)
#pragma unroll
            for (int m = 0; m < 4; ++m) {
                const f32x4 p0 = acc[ai][0][m][0] * bf4lo(gv[ai][m]), p1 = acc[ai][0][m][1] * bf4hi(gv[ai][m]);
                if (u.pb == 0) { mr[ai][m][0] = p0; mr[ai][m][1] = p1; } else { mr[ai][m][0] += p0; mr[ai][m][1] += p1; }
                if (u.pb == 3) { const f32x4 v0 = mr[ai][m][0], v1 = mr[ai][m][1];
                    u32x4 w; w.x = cvt_pk_bf16(v0[0], v0[1]); w.y = cvt_pk_bf16(v0[2], v0[3]); w.z = cvt_pk_bf16(v1[0], v1[1]); w.w = cvt_pk_bf16(v1[2], v1[3]);
                    *(u32x4*)(MB + (size_t)(row0 + ai * HALF + m * 16) * D + col0) = w; } }
    }
};
struct EpiRes {
    const float* r0; float* out; bf16_t* Hn; const float* gn; float* rs;
    __device__ __forceinline__ void operator()(const f32x4 (&acc)[2][2][4][2], const Unit& u, int wr, int wc, int fr, int fq) const {
        const int row0 = u.pm * BM + wr * 64 + fr, col0 = u.pn * BM + wc * 32 + 8 * fq;
        f32x4 gv[2][2];
        if (Hn) {
#pragma unroll
            for (int bj = 0; bj < 2; ++bj) { gv[bj][0] = *(const f32x4*)(gn + col0 + bj * HALF); gv[bj][1] = *(const f32x4*)(gn + col0 + bj * HALF + 4); } }
#pragma unroll
        for (int aih = 0; aih < 4; ++aih) { const int ai = aih >> 1, m0 = (aih & 1) * 2;
            f32x4 rv[4][2][2];
#pragma unroll
            for (int m = m0; m < m0 + 2; ++m) { const float* rp = r0 + (size_t)(row0 + ai * HALF + m * 16) * D + col0;
#pragma unroll
                for (int bj = 0; bj < 2; ++bj) { rv[m][bj][0] = *(const f32x4*)(rp + bj * HALF); rv[m][bj][1] = *(const f32x4*)(rp + bj * HALF + 4); } }
#pragma unroll
            for (int m = m0; m < m0 + 2; ++m) { const int row = row0 + ai * HALF + m * 16;
                float ss = 0.f;
#pragma unroll
                for (int bj = 0; bj < 2; ++bj) { const f32x4 v0 = acc[ai][bj][m][0] + rv[m][bj][0], v1 = acc[ai][bj][m][1] + rv[m][bj][1];
                    float* op = out + (size_t)row * D + col0 + bj * HALF; *(f32x4*)op = v0; *(f32x4*)(op + 4) = v1;
                    if (Hn) { ss += (v0[0] * v0[0] + v0[1] * v0[1]) + (v0[2] * v0[2] + v0[3] * v0[3]) + (v1[0] * v1[0] + v1[1] * v1[1]) + (v1[2] * v1[2] + v1[3] * v1[3]);
                        const f32x4 h0 = v0 * gv[bj][0], h1 = v1 * gv[bj][1];
                        u32x4 w; w.x = cvt_pk_bf16(h0[0], h0[1]); w.y = cvt_pk_bf16(h0[2], h0[3]); w.z = cvt_pk_bf16(h1[0], h1[1]); w.w = cvt_pk_bf16(h1[2], h1[3]);
                        *(u32x4*)(Hn + (size_t)row * D + col0 + bj * HALF) = w; } }
                if (Hn) { ss += __shfl_xor(ss, 16); ss += __shfl_xor(ss, 32); if (fq == 0) (void)__hip_atomic_fetch_add(rs + row, ss, __ATOMIC_RELAXED, __HIP_MEMORY_SCOPE_AGENT); }
            }
        }
    }
};
struct EpiGU {
    bf16_t* HID; const float* rs;
    __device__ __forceinline__ void operator()(const f32x4 (&acc)[2][2][4][2], const Unit& u, int wr, int wc, int fr, int fq) const {
        const int row0 = u.pm * BM + wr * 64 + fr, col0 = u.pn * HALF + wc * 32 + 8 * fq;
        float scv[2][4];
#pragma unroll
        for (int ai = 0; ai < 2; ++ai)
#pragma unroll
            for (int m = 0; m < 4; ++m) scv[ai][m] = rs[row0 + ai * HALF + m * 16];
#pragma unroll
        for (int ai = 0; ai < 2; ++ai)
#pragma unroll
            for (int m = 0; m < 4; ++m) { const size_t row = (size_t)(row0 + ai * HALF + m * 16);
                const float sc = 1.0f / sqrtf(scv[ai][m] * (1.0f / D) + 1e-6f);
                const f32x4 g0 = acc[ai][0][m][0] * sc, g1 = acc[ai][0][m][1] * sc, u0 = acc[ai][1][m][0] * sc, u1 = acc[ai][1][m][1] * sc;
                float o[8];
#pragma unroll
                for (int j = 0; j < 4; ++j) { o[j] = g0[j] * sigmoidf_(g0[j]) * u0[j]; o[4 + j] = g1[j] * sigmoidf_(g1[j]) * u1[j]; }
                u32x4 w; w.x = cvt_pk_bf16(o[0], o[1]); w.y = cvt_pk_bf16(o[2], o[3]); w.z = cvt_pk_bf16(o[4], o[5]); w.w = cvt_pk_bf16(o[6], o[7]);
                *(u32x4*)(HID + row * FF + col0) = w; }
    }
};
}

#define XB_TMO      128
#define XB_XCNT(j)  (256  + 64 * (j))
#define XB_XSUB(j)  (1280 + 64 * (j))
#define XB_XGEN(j)  (2304 + 64 * (j))
#define XB_TOP      3328
#define XB_TOPGEN   3392
#define XCD_BAR_WORDS 3456
#define XB_SPIN_CAP (1u << 18)
__device__ __forceinline__ unsigned xb_ld(unsigned* p)              { return __hip_atomic_load(p, __ATOMIC_RELAXED, __HIP_MEMORY_SCOPE_AGENT); }
__device__ __forceinline__ unsigned xb_add(unsigned* p, unsigned v) { return __hip_atomic_fetch_add(p, v, __ATOMIC_RELAXED, __HIP_MEMORY_SCOPE_AGENT); }
__device__ __forceinline__ unsigned xb_xcc_id() { return (unsigned)__builtin_amdgcn_s_getreg((3 << 11) | 20) & 0xFu; }
#define XB_SPIN(cond, bar) do { unsigned _sp = 0; while (cond) { __builtin_amdgcn_s_sleep(1); \
    if ((++_sp & 255u) == 0u) { if (xb_ld(&(bar)[XB_TMO])) break; if (_sp > XB_SPIN_CAP) { atomicAdd(&(bar)[XB_TMO], 1u); break; } } } } while (0)
struct XcdBarrier { unsigned* bar; unsigned x; volatile LAS unsigned* st; };
__device__ __forceinline__ XcdBarrier xcd_barrier_post(unsigned* bar, volatile LAS unsigned* st) {
    XcdBarrier b; b.bar = bar; b.x = xb_xcc_id(); b.st = st;
    if (threadIdx.x == 0) (void)xb_add(&bar[XB_XCNT(b.x)], 1u);
    return b;
}
__device__ __forceinline__ void xcd_barrier_complete(unsigned* bar, unsigned x, unsigned& nloc, unsigned& nx) {
    const unsigned G = gridDim.x * gridDim.y * gridDim.z;
    unsigned sum, cnt, mine, sp = 0u;
    for (;;) {
        sum = 0u; cnt = 0u; mine = 0u;
#pragma unroll
        for (unsigned j = 0; j < 16; ++j) { const unsigned c = xb_ld(&bar[XB_XCNT(j)]); sum += c; cnt += (c > 0u) ? 1u : 0u; mine = (j == x) ? c : mine; }
        if (sum == G) break;
        __builtin_amdgcn_s_sleep(1);
        if ((++sp & 255u) == 0u) { if (xb_ld(&bar[XB_TMO])) break; if (sp > XB_SPIN_CAP) { atomicAdd(&bar[XB_TMO], 1u); break; } }
    }
    nloc = mine > 0u ? mine : 1u; nx = cnt > 0u ? cnt : 1u;
}
__device__ __forceinline__ void xcd_barrier(const XcdBarrier& b) {
    asm volatile("s_waitcnt vmcnt(0)" ::: "memory");
    __syncthreads();
    if (threadIdx.x == 0) {
        unsigned* bar = b.bar;
        __builtin_amdgcn_s_waitcnt(0);
        unsigned nloc = b.st[0], nx = b.st[1];
        if (nloc == 0u) { xcd_barrier_complete(bar, b.x, nloc, nx); b.st[0] = nloc; b.st[1] = nx; }
        const unsigned old = xb_add(&bar[XB_XSUB(b.x)], 1u);
        const unsigned gen = old / nloc;
        if (old + 1u == (gen + 1u) * nloc) {
            __builtin_amdgcn_fence(__ATOMIC_RELEASE, "agent");
            asm volatile("s_waitcnt vmcnt(0)" ::: "memory");
            const unsigned og = xb_add(&bar[XB_TOP], 1u);
            const unsigned tg = og / nx;
            if (og + 1u == (tg + 1u) * nx) xb_add(&bar[XB_TOPGEN], 1u);
            else XB_SPIN(xb_ld(&bar[XB_TOPGEN]) == tg, bar);
            __builtin_amdgcn_fence(__ATOMIC_ACQUIRE, "agent");
            xb_add(&bar[XB_XGEN(b.x)], 1u);
            asm volatile("s_waitcnt vmcnt(0)" ::: "memory");
        } else {
            XB_SPIN(xb_ld(&bar[XB_XGEN(b.x)]) == gen, bar);
            __builtin_amdgcn_fence(__ATOMIC_ACQUIRE, "agent");
            asm volatile("s_waitcnt vmcnt(0)" ::: "memory");
        }
    }
    __syncthreads();
}

struct Args { const void* in[41]; float* out; unsigned char* ws; int ph_lo, ph_hi, li, pad; };
struct Frame {
    LAS unsigned char* lds;
    int tid, lane, wave, vcu, G;
};
constexpr int NW = 8;

__device__ __forceinline__ void cvt_item(const float* W, int N, bf16* WT, int Kd, int k0, int n0, int drow0, int kd0, LAS float* scr, int lane) {
    const int lr = lane >> 4, lc = (lane & 15) * 4;
    f32x4 v[16];
#pragma unroll
    for (int i = 0; i < 16; ++i) v[i] = *(const f32x4*)(W + (size_t)(k0 + 4 * i + lr) * N + n0 + lc);
#pragma unroll
    for (int i = 0; i < 16; ++i) { LAS float* s = scr + (4 * i + lr) * 65 + lc; s[0] = v[i][0]; s[1] = v[i][1]; s[2] = v[i][2]; s[3] = v[i][3]; }
    LDS_WAIT(); asm volatile("" ::: "memory");
    const int c = lane & 7;
#pragma unroll
    for (int j = 0; j < 8; ++j) { const int n = (lane >> 3) + 8 * j; const LAS float* s = scr + (8 * c) * 65 + n;
        u32x4 o; o.x = pk2(s[0 * 65], s[1 * 65]); o.y = pk2(s[2 * 65], s[3 * 65]); o.z = pk2(s[4 * 65], s[5 * 65]); o.w = pk2(s[6 * 65], s[7 * 65]);
        *(u32x4*)(WT + (size_t)(drow0 + n) * Kd + kd0 + 8 * c) = o; }
    LDS_WAIT(); asm volatile("" ::: "memory");
}
__device__ __forceinline__ void p0_convert(Frame& F, const Args& a) {
    LAS float* scr = (LAS float*)(F.lds + F.wave * 16640);
    const int gw = F.vcu * NW + F.wave, NGW = F.G * NW;
    constexpr int I_IN = 32 * 212, I_BO = 8 * 32, I_MIX = 32 * 32, I_G = 32 * 88, I_DN = 88 * 32, I_LW = 8, I_LG = 16;
    constexpr int PER_L = I_IN + 4 * I_BO + I_MIX + 2 * I_G + I_DN + 2 * I_LW + I_LG;
    for (int it = gw; it < NL * PER_L; it += NGW) {
        const int l = it / PER_L; int r = it % PER_L;
        unsigned char* ws = a.ws;
        if (r < I_IN) { const int kb = r / 212, nb = r % 212; cvt_item((const float*)a.in[9] + (size_t)l * D * INW, INW, (bf16*)(ws + WS_WIN + l * SZ_WIN), D, kb * 64, nb * 64, nb * 64, kb * 64, scr, F.lane); continue; } r -= I_IN;
        if (r < 4 * I_BO) { const int b = r / I_BO, q = r % I_BO, kb = q / 32, nb = q % 32; const int idx = (b == 0) ? 14 : (b == 1) ? 18 : (b == 2) ? 30 : 35;
            cvt_item((const float*)a.in[idx] + (size_t)l * BW * D, D, (bf16*)(ws + WS_WBO + l * SZ_WBO) + (size_t)b * D * BW, BW, kb * 64, nb * 64, nb * 64, kb * 64, scr, F.lane); continue; } r -= 4 * I_BO;
        if (r < I_MIX) { const int kb = r / 32, nb = r % 32; cvt_item((const float*)a.in[36] + (size_t)l * D * D, D, (bf16*)(ws + WS_WMIX + l * SZ_WMIX), D, kb * 64, nb * 64, nb * 64, kb * 64, scr, F.lane); continue; } r -= I_MIX;
        if (r < 2 * I_G) { const int up = r / I_G, q = r % I_G, kb = q / 88, nb = q % 88, n0 = nb * 64;
            cvt_item((const float*)a.in[up ? 39 : 38] + (size_t)l * D * FF, FF, (bf16*)(ws + WS_WGU + l * SZ_WGU), D, kb * 64, n0, (n0 / 128) * 256 + up * 128 + (n0 % 128), kb * 64, scr, F.lane); continue; } r -= 2 * I_G;
        if (r < I_DN) { const int kb = r / 32, nb = r % 32; cvt_item((const float*)a.in[40] + (size_t)l * FF * D, D, (bf16*)(ws + WS_WDN + l * SZ_WDN), FF, kb * 64, nb * 64, nb * 64, kb * 64, scr, F.lane); continue; } r -= I_DN;
        bf16* lw = (bf16*)(ws + WS_LW + l * SZ_LW);
        if (r < I_LW) { cvt_item((const float*)a.in[21] + (size_t)l * 64 * 512, 512, lw, 256, 0, r * 64, r * 64, 0, scr, F.lane); continue; } r -= I_LW;
        if (r < I_LW) { cvt_item((const float*)a.in[23] + (size_t)l * 64 * 512, 512, lw, 256, 0, r * 64, r * 64, 64, scr, F.lane); continue; } r -= I_LW;
        { const int kb = r / 8, nb = r % 8; cvt_item((const float*)a.in[24] + (size_t)l * 128 * 512, 512, lw, 256, kb * 64, nb * 64, nb * 64, 128 + kb * 64, scr, F.lane); }
    }
}

__device__ __forceinline__ void norm_phase(Frame& F, const float* s0, const float* s1, const float* gain, bf16* H) {
    const int gw = F.vcu * NW + F.wave, NGW = F.G * NW;
    f32x4 gv[8];
#pragma unroll
    for (int j = 0; j < 8; ++j) gv[j] = *(const f32x4*)(gain + (j * 64 + F.lane) * 4);
    for (int m = gw; m < MPAD; m += NGW) {
        u32x2* o = (u32x2*)(H + (size_t)m * D) + F.lane;
        if (m >= MR) {
#pragma unroll
            for (int j = 0; j < 8; ++j) o[64 * j] = (u32x2){0u, 0u};
            continue; }
        const f32x4* xr = (const f32x4*)((m < MP) ? s0 + (size_t)m * D : s1 + (size_t)(m - MP) * D) + F.lane;
        f32x4 v[8]; float ss = 0.f;
#pragma unroll
        for (int j = 0; j < 8; ++j) { v[j] = xr[64 * j]; ss += (v[j][0] * v[j][0] + v[j][1] * v[j][1]) + (v[j][2] * v[j][2] + v[j][3] * v[j][3]); }
        const float rs = 1.0f / sqrtf(wave_sum(ss) * (1.0f / D) + 1e-6f);
#pragma unroll
        for (int j = 0; j < 8; ++j) { const f32x4 y = v[j] * rs * gv[j]; o[64 * j] = (u32x2){pk2(y[0], y[1]), pk2(y[2], y[3])}; }
    }
}

__device__ __forceinline__ void gmlp_item(Frame& F, const Args& a, int l, int chunk, int g, const bf16* P, bf16* ACTA) {
    LAS bf16* Vt = (LAS bf16*)F.lds;
    const int lane = F.lane, w = F.wave;
    const float* lng = (const float*)a.in[10] + l * 512; const float* lnb = (const float*)a.in[11] + l * 512;
    const float* ws_ = (const float*)a.in[12] + (size_t)(l * 4 + g) * 128 * 128; const float* bs = (const float*)a.in[13] + (l * 4 + g) * 128;
    const int row0 = chunk * 128;
    f32x4 uv[8]; float btv[8];
    { const int li_ = lane & 15, q_ = lane >> 4, c0_ = 128 * g + 16 * w + 4 * q_;
#pragma unroll
      for (int tt = 0; tt < 8; ++tt) { const int t = 16 * tt + li_; uv[tt] = ldb4(P + (size_t)(row0 + t) * NPRE + PA0 + c0_); btv[tt] = bs[t]; } }
    const int myj = g >> 1, mylo = (g & 1) * 32;
    const f32x4 lgv = *(const f32x4*)(lng + myj * 256 + 4 * lane), lbv = *(const f32x4*)(lnb + myj * 256 + 4 * lane);
#pragma unroll 1
    for (int i0 = 0; i0 < 16; i0 += 8) {
        f32x4 xa[8], xb[8];
#pragma unroll
        for (int i = 0; i < 8; ++i) { const bf16* pr = P + (size_t)(row0 + w * 16 + i0 + i) * NPRE + PA0 + 512; xa[i] = ldb4(pr + 4 * lane); xb[i] = ldb4(pr + 256 + 4 * lane); }
#pragma unroll
        for (int i = 0; i < 8; ++i) {
            const int s = w * 16 + i0 + i; f32x4 x0 = xa[i], x1 = xb[i];
#pragma unroll
            for (int j = 0; j < 4; ++j) { x0[j] = gelu_tanh(x0[j]); x1[j] = gelu_tanh(x1[j]); }
            const float mean = wave_sum((x0[0] + x0[1]) + (x0[2] + x0[3]) + (x1[0] + x1[1]) + (x1[2] + x1[3])) * (1.f / 512.f);
            x0 -= mean; x1 -= mean;
            const float var = wave_sum((x0[0] * x0[0] + x0[1] * x0[1]) + (x0[2] * x0[2] + x0[3] * x0[3]) + (x1[0] * x1[0] + x1[1] * x1[1]) + (x1[2] * x1[2] + x1[3] * x1[3])) * (1.f / 512.f);
            const float rstd = 1.0f / sqrtf(var + 1e-5f);
            const f32x4 xm = myj ? x1 : x0;
            if ((lane >> 5) == (g & 1)) {
                const int cl = 4 * (lane - mylo);
#pragma unroll
                for (int j = 0; j < 4; ++j) Vt[(cl + j) * 136 + s] = (bf16)f2bf(xm[j] * rstd * lgv[j] + lbv[j]);
            }
        }
    }
    LDS_WAIT(); __syncthreads();
    const int li = lane & 15, q = lane >> 4;
    f32x4 acc[8];
#pragma unroll
    for (int tt = 0; tt < 8; ++tt) acc[tt] = (f32x4){0.f, 0.f, 0.f, 0.f};
#pragma unroll
    for (int ks = 0; ks < 4; ++ks) {
        const bf16x8 af = *(const LAS bf16x8*)(Vt + (16 * w + li) * 136 + 32 * ks + 8 * q);
        const int s0 = 32 * ks + 8 * q;
        f32x4 wl[8][2];
#pragma unroll
        for (int tt = 0; tt < 8; ++tt) { if (32 * ks > 16 * tt + 15) continue; const int t = 16 * tt + li; wl[tt][0] = *(const f32x4*)(ws_ + t * 128 + s0); wl[tt][1] = *(const f32x4*)(ws_ + t * 128 + s0 + 4); }
#pragma unroll
        for (int tt = 0; tt < 8; ++tt) {
            if (32 * ks > 16 * tt + 15) continue;
            const int t = 16 * tt + li;
            float wv[8] = {wl[tt][0][0], wl[tt][0][1], wl[tt][0][2], wl[tt][0][3], wl[tt][1][0], wl[tt][1][1], wl[tt][1][2], wl[tt][1][3]};
#pragma unroll
            for (int j = 0; j < 8; ++j) if (s0 + j > t) wv[j] = 0.f;
            u32x4 bw; bw.x = pk2(wv[0], wv[1]); bw.y = pk2(wv[2], wv[3]); bw.z = pk2(wv[4], wv[5]); bw.w = pk2(wv[6], wv[7]);
            acc[tt] = __builtin_amdgcn_mfma_f32_16x16x32_bf16(af, __builtin_bit_cast(bf16x8, bw), acc[tt], 0, 0, 0);
        }
    }
    {
        const int c0 = 128 * g + 16 * w + 4 * q;
#pragma unroll
        for (int tt = 0; tt < 8; ++tt) {
            const int t = 16 * tt + li; float o[4];
#pragma unroll
            for (int j = 0; j < 4; ++j) o[j] = gelu_tanh(uv[tt][j]) * (acc[tt][j] + btv[tt]);
            *(u32x2*)(ACTA + (size_t)(row0 + t) * BW + c0) = (u32x2){pk2(o[0], o[1]), pk2(o[2], o[3])};
        }
    }
    __syncthreads();
}
__device__ __forceinline__ void gmlp_sample_item(Frame& F, const Args& a, int l, const bf16* P, bf16* ACTA) {
    const int lane = F.lane, sb = F.wave;
    const float* lng = (const float*)a.in[10] + l * 512; const float* lnb = (const float*)a.in[11] + l * 512;
    float vn[4][8], uu[4][8];
#pragma unroll
    for (int t = 0; t < 4; ++t) {
        const bf16* pr = P + (size_t)(MP + sb * 4 + t) * NPRE + PA0;
        f32x4 u0 = ldb4(pr + 4 * lane), u1 = ldb4(pr + 256 + 4 * lane), x0 = ldb4(pr + 512 + 4 * lane), x1 = ldb4(pr + 768 + 4 * lane);
#pragma unroll
        for (int j = 0; j < 4; ++j) { x0[j] = gelu_tanh(x0[j]); x1[j] = gelu_tanh(x1[j]); uu[t][j] = gelu_tanh(u0[j]); uu[t][4 + j] = gelu_tanh(u1[j]); }
        const float mean = wave_sum((x0[0] + x0[1]) + (x0[2] + x0[3]) + (x1[0] + x1[1]) + (x1[2] + x1[3])) * (1.f / 512.f);
        x0 -= mean; x1 -= mean;
        const float var = wave_sum((x0[0] * x0[0] + x0[1] * x0[1]) + (x0[2] * x0[2] + x0[3] * x0[3]) + (x1[0] * x1[0] + x1[1] * x1[1]) + (x1[2] * x1[2] + x1[3] * x1[3])) * (1.f / 512.f);
        const float rstd = 1.0f / sqrtf(var + 1e-5f);
        const f32x4 g0 = *(const f32x4*)(lng + 4 * lane), g1 = *(const f32x4*)(lng + 256 + 4 * lane), b0 = *(const f32x4*)(lnb + 4 * lane), b1 = *(const f32x4*)(lnb + 256 + 4 * lane);
        f32x4 y0 = x0 * rstd * g0 + b0, y1 = x1 * rstd * g1 + b1;
        float* gv = a.out + O_GV + (size_t)((l * NSB + sb) * NST + t) * 512;
        *(f32x4*)(gv + 4 * lane) = y0; *(f32x4*)(gv + 256 + 4 * lane) = y1;
#pragma unroll
        for (int j = 0; j < 4; ++j) { vn[t][j] = y0[j]; vn[t][4 + j] = y1[j]; }
    }
#pragma unroll
    for (int t = 0; t < 4; ++t) {
        float o[8];
#pragma unroll
        for (int hf = 0; hf < 2; ++hf) {
            const int g = hf * 2 + (lane >> 5);
            const float* wg = (const float*)a.in[12] + (size_t)(l * 4 + g) * 128 * 128; const float bt = ((const float*)a.in[13])[(l * 4 + g) * 128 + t];
#pragma unroll
            for (int j = 0; j < 4; ++j) { float s = bt;
#pragma unroll
                for (int s2 = 0; s2 <= t; ++s2) s += wg[t * 128 + s2] * vn[s2][hf * 4 + j];
                o[hf * 4 + j] = uu[t][hf * 4 + j] * s; }
        }
        bf16* op = ACTA + (size_t)(MP + sb * 4 + t) * BW;
        *(u32x2*)(op + 4 * lane) = (u32x2){pk2(o[0], o[1]), pk2(o[2], o[3])}; *(u32x2*)(op + 256 + 4 * lane) = (u32x2){pk2(o[4], o[5]), pk2(o[6], o[7])};
    }
}
__device__ __forceinline__ void bprep_item(Frame& F, const Args& a, int l, int item, const bf16* P, bf16* QB, bf16* KB, bf16* VT, float* QS) {
    const int lane = F.lane, w = F.wave; const bool samp = (item == 256); const int row0 = item * 32;
    LAS float* vs = (LAS float*)F.lds;
    const float* qn = (const float*)a.in[15] + l * 128; const float* kn = (const float*)a.in[16] + l * 128;
    const f32x4 qg = *(const f32x4*)(qn + 4 * (lane & 31)), kg = *(const f32x4*)(kn + 4 * (lane & 31));
    const float qs = 0.08838834764831845f * LOG2E;
    f32x4 xall[4][6];
#pragma unroll
    for (int i = 0; i < 4; ++i) { const bf16* pr = P + (size_t)(row0 + w * 4 + i) * NPRE + PB0;
#pragma unroll
        for (int j = 0; j < 6; ++j) xall[i][j] = ldb4(pr + j * 256 + 4 * lane); }
#pragma unroll
    for (int i = 0; i < 4; ++i) {
        const int r = w * 4 + i, row = row0 + r;
        f32x4 x[6];
#pragma unroll
        for (int j = 0; j < 6; ++j) x[j] = xall[i][j];
        float* ko; float* vo;
        if (!samp) { ko = a.out + O_KP + ((size_t)l * MP + row) * 512; vo = a.out + O_VP + ((size_t)l * MP + row) * 512; }
        else { ko = a.out + O_KS + ((size_t)l * MS + r) * 512; vo = a.out + O_VS + ((size_t)l * MS + r) * 512; }
#pragma unroll
        for (int j = 0; j < 4; ++j) {
            float ss = (x[j][0] * x[j][0] + x[j][1] * x[j][1]) + (x[j][2] * x[j][2] + x[j][3] * x[j][3]);
#pragma unroll
            for (int o = 1; o < 32; o <<= 1) ss += __shfl_xor(ss, o);
            const float rs = 1.0f / sqrtf(ss * (1.f / 128.f) + 1e-6f);
            if (j < 2) { const f32x4 y = x[j] * rs * qg * qs;
                if (!samp) *(u32x2*)(QB + (size_t)row * BW + j * 256 + 4 * lane) = (u32x2){pk2(y[0], y[1]), pk2(y[2], y[3])};
                else *(f32x4*)(QS + (size_t)r * BW + j * 256 + 4 * lane) = y; }
            else { const f32x4 y = x[j] * rs * kg; *(f32x4*)(ko + (j - 2) * 256 + 4 * lane) = y;
                if (!samp) *(u32x2*)(KB + (size_t)row * BW + (j - 2) * 256 + 4 * lane) = (u32x2){pk2(y[0], y[1]), pk2(y[2], y[3])}; }
        }
#pragma unroll
        for (int j = 4; j < 6; ++j) { *(f32x4*)(vo + (j - 4) * 256 + 4 * lane) = x[j];
            if (!samp) { LAS float* s = vs + r * 513 + (j - 4) * 256 + 4 * lane; s[0] = x[j][0]; s[1] = x[j][1]; s[2] = x[j][2]; s[3] = x[j][3]; } }
    }
    if (!samp) {
        LDS_WAIT(); __syncthreads();
        const int n = F.tid, b = row0 / SEQ, t0 = row0 % SEQ, h = n >> 7, d = n & 127;
        bf16* vp = VT + ((size_t)((b * 4 + h) * 128 + d)) * SEQ + t0;
#pragma unroll
        for (int c = 0; c < 4; ++c) { const LAS float* s = vs + (8 * c) * 513 + n;
            u32x4 o; o.x = pk2(s[0], s[513]); o.y = pk2(s[2 * 513], s[3 * 513]); o.z = pk2(s[4 * 513], s[5 * 513]); o.w = pk2(s[6 * 513], s[7 * 513]);
            *(u32x4*)(vp + 8 * c) = o; }
        LDS_WAIT(); __syncthreads();
    }
}
__device__ __forceinline__ void cprep_item(Frame& F, const Args& a, int l, int item, const bf16* P, unsigned char* ws) {
    const int lane = F.lane, w = F.wave, tid = F.tid; const bool samp = (item == 256); const int row0 = item * 32;
    LAS bf16* act = (LAS bf16*)F.lds;
    const float* mu = (const float*)a.in[19] + l * CSHIFT;
    const float* sh0 = (const float*)a.in[6] + (size_t)l * NSB * CSHIFT;
    {
        const int r = tid >> 4, cg = tid & 15, row = row0 + r;
        const bool first = samp ? ((r & 3) == 0) : ((row % SEQ) == 0);
        const bf16* pc = P + (size_t)row * NPRE + PC0 + 1536 + cg * 16;
        const float* ps = sh0 + (size_t)(r >> 2) * CSHIFT + 1536 + cg * 16;
        unsigned o[8];
#pragma unroll
        for (int j = 0; j < 4; ++j) {
            const f32x4 c = ldb4(pc + 4 * j); f32x4 p = first ? (samp ? *(const f32x4*)(ps + 4 * j) : (f32x4){0.f, 0.f, 0.f, 0.f}) : ldb4(pc - NPRE + 4 * j); const f32x4 m = *(const f32x4*)(mu + 1536 + cg * 16 + 4 * j);
            f32x4 x = c + (p - c) * m;
#pragma unroll
            for (int e = 0; e < 4; ++e) { if (cg < 4) x[e] = 1.0f - 2.0f * rcpf_(1.0f + ex2(2.0f * LOG2E * x[e])); else if (cg >= 8) x[e] = sigmoidf_(x[e]); }
            o[2 * j] = pk2(x[0], x[1]); o[2 * j + 1] = pk2(x[2], x[3]);
        }
        LAS u32x4* dst = (LAS u32x4*)(act + r * 264 + cg * 16);
        dst[0] = (u32x4){o[0], o[1], o[2], o[3]}; dst[1] = (u32x4){o[4], o[5], o[6], o[7]};
    }
    LDS_WAIT(); __syncthreads();
    const int li = lane & 15, q = lane >> 4;
    const bf16* lw = (const bf16*)(ws + WS_LW + l * SZ_LW);
    const float* w0 = (const float*)a.in[20] + l * 512; const float* a0 = (const float*)a.in[22] + l * 512;
    const float* k_k = (const float*)a.in[25] + l * 512; const float* k_a = (const float*)a.in[26] + l * 512; const float* r_k = (const float*)a.in[27] + l * 512;
    float* Rr = (float*)(ws + WS_R + l * SZ_RWL); float* Ww = (float*)(ws + WS_W + l * SZ_RWL); float* KX = (float*)(ws + WS_KX + l * SZ_RWL); float* Vv = (float*)(ws + WS_V);
    float* KK = (float*)(ws + WS_KK + l * SZ_RWL); float* KKA = (float*)(ws + WS_KKA + l * SZ_RWL); float* GG = (float*)(ws + WS_GG); float* RK = (float*)(ws + WS_RK);
    int lwo = (64 * w + li) * 256 + 8 * q, aco = li * 264 + 8 * q, c00 = 64 * w + 4 * q;
    asm volatile("" : "+v"(lwo), "+v"(aco), "+v"(c00));
    f32x4 xsv[2][4][3];
    int rows[2];
#define CPREP_LOAD_XS(mt) do { const int r = 16 * (mt) + li, row = row0 + r; rows[mt] = row; \
        const bool first = samp ? ((r & 3) == 0) : ((row % SEQ) == 0); \
        const bf16* pc = P + (size_t)row * NPRE + PC0; \
        const float* ps = sh0 + (size_t)(r >> 2) * CSHIFT; \
        _Pragma("unroll") for (int ct = 0; ct < 4; ++ct) _Pragma("unroll") for (int j = 0; j < 3; ++j) { const int c0 = c00 + 16 * ct; const f32x4 c = ldb4(pc + j * 512 + c0); \
            const f32x4 p = first ? (samp ? *(const f32x4*)(ps + j * 512 + c0) : (f32x4){0.f, 0.f, 0.f, 0.f}) : ldb4(pc - NPRE + j * 512 + c0); xsv[mt][ct][j] = c + (p - c) * *(const f32x4*)(mu + j * 512 + c0); } } while (0)
    CPREP_LOAD_XS(0);
    f32x4 aw[2][4], aa[2][4], ag[2][4];
#pragma unroll
    for (int mt = 0; mt < 2; ++mt)
#pragma unroll
        for (int ct = 0; ct < 4; ++ct) { aw[mt][ct] = (f32x4){0.f, 0.f, 0.f, 0.f}; aa[mt][ct] = aw[mt][ct]; ag[mt][ct] = aw[mt][ct]; }
#pragma unroll
    for (int hb = 0; hb < 4; ++hb) {
        bf16x8 af[2][4];
#pragma unroll
        for (int k2 = 0; k2 < 2; ++k2)
#pragma unroll
            for (int ct = 0; ct < 4; ++ct) af[k2][ct] = *(const bf16x8*)(lw + lwo + ct * 16 * 256 + 32 * (hb * 2 + k2));
#pragma unroll
        for (int k2 = 0; k2 < 2; ++k2) { const int ks = hb * 2 + k2;
#pragma unroll
            for (int mt = 0; mt < 2; ++mt) { const bf16x8 bfr = *(const LAS bf16x8*)(act + aco + mt * 16 * 264 + 32 * ks);
#pragma unroll
                for (int ct = 0; ct < 4; ++ct) {
                    if (ks < 2) aw[mt][ct] = __builtin_amdgcn_mfma_f32_16x16x32_bf16(af[k2][ct], bfr, aw[mt][ct], 0, 0, 0);
                    else if (ks < 4) aa[mt][ct] = __builtin_amdgcn_mfma_f32_16x16x32_bf16(af[k2][ct], bfr, aa[mt][ct], 0, 0, 0);
                    else ag[mt][ct] = __builtin_amdgcn_mfma_f32_16x16x32_bf16(af[k2][ct], bfr, ag[mt][ct], 0, 0, 0);
                } } }
        asm volatile("" ::: "memory");
    }
#pragma unroll
    for (int mt = 0; mt < 2; ++mt) {
        if (mt == 1) { asm volatile("" ::: "memory"); CPREP_LOAD_XS(1); }
        const int row = rows[mt];
        f32x4 kkv[4], av[4]; float ss = 0.f, rk = 0.f;
#pragma unroll
        for (int ct = 0; ct < 4; ++ct) {
            const int c0 = c00 + 16 * ct;
            f32x4 xs[3];
#pragma unroll
            for (int j = 0; j < 3; ++j) xs[j] = xsv[mt][ct][j];
            const f32x4 w0v = *(const f32x4*)(w0 + c0), a0v = *(const f32x4*)(a0 + c0), kkw = *(const f32x4*)(k_k + c0), kaw = *(const f32x4*)(k_a + c0), rkw = *(const f32x4*)(r_k + c0);
            f32x4 dec;
#pragma unroll
            for (int e = 0; e < 4; ++e) {
                const float x = -(w0v[e] + aw[mt][ct][e]);
                const float sp = fmaxf(x, 0.f) + 0.6931471805599453f * __builtin_amdgcn_logf(1.0f + ex2(-fabsf(x) * LOG2E));
                dec[e] = ex2(-LOG2E * ex2(LOG2E * (-sp - 0.5f)));
                av[ct][e] = sigmoidf_(a0v[e] + aa[mt][ct][e]);
            }
            kkv[ct] = xs[1] * kkw;
            const f32x4 kxv = xs[1] * (1.0f + (av[ct] - 1.0f) * kaw);
            ss += (kkv[ct][0] * kkv[ct][0] + kkv[ct][1] * kkv[ct][1]) + (kkv[ct][2] * kkv[ct][2] + kkv[ct][3] * kkv[ct][3]);
            const f32x4 t = xs[0] * kxv * rkw; rk += (t[0] + t[1]) + (t[2] + t[3]);
            const size_t o = (size_t)row * BW + c0;
            *(f32x4*)(Rr + o) = xs[0]; *(f32x4*)(Ww + o) = dec; *(f32x4*)(KX + o) = kxv; *(f32x4*)(Vv + o) = xs[2]; *(f32x4*)(GG + o) = ag[mt][ct];
        }
        ss += __shfl_xor(ss, 16); ss += __shfl_xor(ss, 32); rk += __shfl_xor(rk, 16); rk += __shfl_xor(rk, 32);
        const float rn = 1.0f / sqrtf(fmaxf(ss, 1e-24f));
#pragma unroll
        for (int ct = 0; ct < 4; ++ct) { const size_t o = (size_t)row * BW + c00 + 16 * ct; const f32x4 kk = kkv[ct] * rn; *(f32x4*)(KK + o) = kk; *(f32x4*)(KKA + o) = kk * av[ct]; }
        if (q == 0) RK[(size_t)row * 8 + w] = rk;
    }
#undef CPREP_LOAD_XS
    if (!samp) { if ((row0 + 32) % SEQ == 0) { const int b = row0 / SEQ; const bf16* src = P + (size_t)(row0 + 31) * NPRE + PC0; float* dst = a.out + O_SHP + (size_t)(l * 2 + b) * CSHIFT;
            for (int i = tid; i < CSHIFT; i += 512) dst[i] = __builtin_bit_cast(float, (unsigned)src[i] << 16); } }
    else { for (int i = tid; i < NSB * CSHIFT; i += 512) { const int sb = i / CSHIFT, c = i % CSHIFT; a.out[O_SHS + (size_t)(l * NSB + sb) * CSHIFT + c] = __builtin_bit_cast(float, (unsigned)P[(size_t)(MP + sb * 4 + 3) * NPRE + PC0 + c] << 16); } }
    __syncthreads();
}
__device__ __forceinline__ void dconv_item(Frame& F, const Args& a, int l, int item, const bf16* P, bf16* ACTD) {
    const int tid = F.tid, lane = F.lane, w = F.wave;
    LAS float* z = (LAS float*)F.lds;
    LAS float* red = (LAS float*)(F.lds + 62 * 512 * 4);
    const bool samp = item >= 256; const int sb = item - 256;
    const int rowbase = samp ? MP + sb * 4 : item * 32;
    const int t0 = samp ? 0 : (item * 32) % SEQ, ntok = samp ? 4 : 32;
    const float* conv0 = (const float*)a.in[7] + (size_t)(l * NSB + (samp ? sb : 0)) * 30 * 512;
    const int c = tid;
    const float* cw = (const float*)a.in[31] + (size_t)l * 31 * 512; const float cb = ((const float*)a.in[32])[l * 512 + c];
    const float lg = ((const float*)a.in[33])[l * 512 + c], lb = ((const float*)a.in[34])[l * 512 + c];
    float wv[31];
#pragma unroll
    for (int j = 0; j < 31; ++j) wv[j] = cw[j * 512 + c];
    {
        const int rs = tid >> 7, c4 = (tid & 127) * 4, nrow = 30 + ntok;
#pragma unroll
        for (int hb = 0; hb < 2; ++hb) {
            f32x4 va[8], ga[8];
#pragma unroll
            for (int jj = 0; jj < 8; ++jj) { const int i = rs + 4 * (hb * 8 + jj), t = t0 - 30 + i;
                va[jj] = (f32x4){0.f, 0.f, 0.f, 0.f}; ga[jj] = va[jj];
                if (i < nrow) {
                    if (t < 0) { if (samp) va[jj] = *(const f32x4*)(conv0 + (size_t)i * 512 + c4); }
                    else { const bf16* pr = P + (size_t)(rowbase - 30 + i) * NPRE + PD0 + c4; va[jj] = ldb4(pr); ga[jj] = ldb4(pr + 512); } } }
#pragma unroll
            for (int jj = 0; jj < 8; ++jj) { const int i = rs + 4 * (hb * 8 + jj), t = t0 - 30 + i;
                if (i < nrow) { f32x4 zv = va[jj];
                    if (t >= 0) { zv[0] *= sigmoidf_(ga[jj][0]); zv[1] *= sigmoidf_(ga[jj][1]); zv[2] *= sigmoidf_(ga[jj][2]); zv[3] *= sigmoidf_(ga[jj][3]); }
                    *(LAS f32x4*)(z + i * 512 + c4) = zv; } }
        }
    }
    LDS_WAIT(); __syncthreads();
    if (samp) { float* dst = a.out + O_CS + (size_t)(l * NSB + sb) * 30 * 512; for (int i = 0; i < 30; ++i) dst[(size_t)i * 512 + c] = z[(4 + i) * 512 + c]; }
    else if (t0 + 32 == SEQ) { float* dst = a.out + O_CP + (size_t)(l * 2 + (item * 32) / SEQ) * 30 * 512; for (int i = 0; i < 30; ++i) dst[(size_t)i * 512 + c] = z[(32 + i) * 512 + c]; }
    float y[32];
#pragma unroll
    for (int t = 0; t < 32; ++t) y[t] = cb;
#pragma unroll
    for (int i = 0; i < 62; ++i) {
        if (i < 30 + ntok) { const float zi = z[i * 512 + c];
#pragma unroll
            for (int t = 0; t < 32; ++t) { if (i - t >= 0 && i - t <= 30) y[t] = fmaf(zi, wv[i - t], y[t]); } }
    }
    {
        float u1[16], u2[16];
        { const bool hb = (lane & 32) != 0;
#pragma unroll
          for (int j = 0; j < 16; ++j) { const float ka = hb ? y[16 + j] : y[j], sa = hb ? y[j] : y[16 + j]; u1[j] = ka + __shfl_xor(sa, 32); u2[j] = ka * ka + __shfl_xor(sa * sa, 32); } }
        float v1[8], v2[8];
        { const bool hb = (lane & 16) != 0;
#pragma unroll
          for (int j = 0; j < 8; ++j) { v1[j] = (hb ? u1[8 + j] : u1[j]) + __shfl_xor(hb ? u1[j] : u1[8 + j], 16); v2[j] = (hb ? u2[8 + j] : u2[j]) + __shfl_xor(hb ? u2[j] : u2[8 + j], 16); } }
        float w1[4], w2[4];
        { const bool hb = (lane & 8) != 0;
#pragma unroll
          for (int j = 0; j < 4; ++j) { w1[j] = (hb ? v1[4 + j] : v1[j]) + __shfl_xor(hb ? v1[j] : v1[4 + j], 8); w2[j] = (hb ? v2[4 + j] : v2[j]) + __shfl_xor(hb ? v2[j] : v2[4 + j], 8); } }
        float x1[2], x2[2];
        { const bool hb = (lane & 4) != 0;
#pragma unroll
          for (int j = 0; j < 2; ++j) { x1[j] = (hb ? w1[2 + j] : w1[j]) + __shfl_xor(hb ? w1[j] : w1[2 + j], 4); x2[j] = (hb ? w2[2 + j] : w2[j]) + __shfl_xor(hb ? w2[j] : w2[2 + j], 4); } }
        float z1, z2;
        { const bool hb = (lane & 2) != 0; z1 = (hb ? x1[1] : x1[0]) + __shfl_xor(hb ? x1[0] : x1[1], 2); z2 = (hb ? x2[1] : x2[0]) + __shfl_xor(hb ? x2[0] : x2[1], 2); }
        z1 += __shfl_xor(z1, 1); z2 += __shfl_xor(z2, 1);
        const int trow = ((lane >> 5) & 1) * 16 + ((lane >> 4) & 1) * 8 + ((lane >> 3) & 1) * 4 + ((lane >> 2) & 1) * 2 + ((lane >> 1) & 1);
        if ((lane & 1) == 0) { red[(trow * 8 + w) * 2] = z1; red[(trow * 8 + w) * 2 + 1] = z2; }
    }
    LDS_WAIT(); __syncthreads();
    if (tid < 32) { float s1 = 0.f, s2 = 0.f;
#pragma unroll
        for (int j = 0; j < 8; ++j) { s1 += red[(tid * 8 + j) * 2]; s2 += red[(tid * 8 + j) * 2 + 1]; }
        const float mean = s1 * (1.f / 512.f), var = fmaxf(s2 * (1.f / 512.f) - mean * mean, 0.f);
        red[512 + tid * 2] = mean; red[512 + tid * 2 + 1] = 1.0f / sqrtf(var + 1e-5f); }
    LDS_WAIT(); __syncthreads();
#pragma unroll
    for (int t = 0; t < 32; ++t) { if (t < ntok) { const float v = (y[t] - red[512 + t * 2]) * red[512 + t * 2 + 1] * lg + lb; ACTD[(size_t)(rowbase + t) * BW + c] = (bf16)f2bf(v * sigmoidf_(v)); } }
    __syncthreads();
}

template <bool SK>
__device__ __forceinline__ void scan_task(const float* R, const float* W, const float* KX, const float* KK, const float* KKA, const float* V, float* OUT, float* STT, const float* S0, float* SOUT, int nstep, int lane) {
    float s[64];
    if (S0) {
#pragma unroll
        for (int k4 = 0; k4 < 16; ++k4) { const f32x4 v = *(const f32x4*)(S0 + lane * 64 + 4 * k4); s[4 * k4] = v[0]; s[4 * k4 + 1] = v[1]; s[4 * k4 + 2] = v[2]; s[4 * k4 + 3] = v[3]; }
    } else {
#pragma unroll
        for (int k = 0; k < 64; ++k) s[k] = SK ? 0.f : (k == lane ? 1.f : 0.f);
    }
    float pf0 = 0.f, pf1 = 0.f, pf2 = 0.f, pf3 = 0.f, pf4 = 0.f;
    for (int t = 0; t < nstep; ++t) {
        asm volatile("" :: "v"(pf0), "v"(pf1), "v"(pf2), "v"(pf3), "v"(pf4));
        { const int tp = (t + 2 < nstep) ? t + 2 : t; const size_t po = (size_t)tp * BW + lane;
          pf0 = KK[po]; pf1 = W[po]; pf2 = KKA[po]; pf3 = KX[po]; pf4 = R[po]; }
        cfloat* kk = (cfloat*)(KK + (size_t)t * BW); cfloat* w = (cfloat*)(W + (size_t)t * BW); cfloat* kka = (cfloat*)(KKA + (size_t)t * BW);
        cfloat* kx = (cfloat*)(KX + (size_t)t * BW); cfloat* r = (cfloat*)(R + (size_t)t * BW);
        float d0 = 0.f, d1 = 0.f;
#pragma unroll
        for (int k = 0; k < 64; k += 2) { d0 = fmaf(s[k], kk[k], d0); d1 = fmaf(s[k + 1], kk[k + 1], d1); }
        const float nd = -(d0 + d1);
        const float vt = SK ? V[(size_t)t * BW + lane] : 0.f;
        float o0 = 0.f, o1 = 0.f;
#pragma unroll
        for (int k = 0; k < 64; k += 2) {
            float x = s[k] * w[k]; x = fmaf(nd, kka[k], x); if (SK) x = fmaf(vt, kx[k], x); s[k] = x; o0 = fmaf(x, r[k], o0);
            float y = s[k + 1] * w[k + 1]; y = fmaf(nd, kka[k + 1], y); if (SK) y = fmaf(vt, kx[k + 1], y); s[k + 1] = y; o1 = fmaf(y, r[k + 1], o1);
        }
        OUT[(size_t)t * BW + lane] = o0 + o1;
    }
    asm volatile("" :: "v"(pf0), "v"(pf1), "v"(pf2), "v"(pf3), "v"(pf4));
    if (STT) {
#pragma unroll
        for (int k = 0; k < 64; ++k) STT[k * 64 + lane] = s[k];
    }
    if (SOUT) {
#pragma unroll
        for (int k4 = 0; k4 < 16; ++k4) *(f32x4*)(SOUT + lane * 64 + 4 * k4) = (f32x4){s[4 * k4], s[4 * k4 + 1], s[4 * k4 + 2], s[4 * k4 + 3]};
    }
}
__device__ __forceinline__ const float* uni_ptr(const float* p) { const unsigned long long v = (unsigned long long)p; const unsigned lo = __builtin_amdgcn_readfirstlane((unsigned)v), hi = __builtin_amdgcn_readfirstlane((unsigned)(v >> 32)); return (const float*)(((unsigned long long)hi << 32) | lo); }
__device__ __forceinline__ void scan_item(Frame& F, int l, int item, unsigned char* ws) {
    const int b = item >> 7, chunk = (item >> 1) & 63, hq = item & 1, h = hq * 4 + (F.wave & 3);
    const size_t ro = ((size_t)(b * SEQ + chunk * 64)) * BW + h * 64; const size_t so = ((size_t)((b * 8 + h) * 64 + chunk)) * 4096;
    const float* R = (const float*)(ws + WS_R + l * SZ_RWL) + ro; const float* W = (const float*)(ws + WS_W + l * SZ_RWL) + ro; const float* KX = (const float*)(ws + WS_KX + l * SZ_RWL) + ro;
    const float* KK = (const float*)(ws + WS_KK + l * SZ_RWL) + ro; const float* KKA = (const float*)(ws + WS_KKA + l * SZ_RWL) + ro; const float* V = (const float*)(ws + WS_V) + ro;
    if (F.wave >> 2) scan_task<true>(uni_ptr(R), uni_ptr(W), uni_ptr(KX), uni_ptr(KK), uni_ptr(KKA), V, (float*)(ws + WS_OL) + ro, (float*)(ws + WS_LC) + so, nullptr, nullptr, 64, F.lane);
    else scan_task<false>(uni_ptr(R), uni_ptr(W), uni_ptr(KX), uni_ptr(KK), uni_ptr(KKA), V, (float*)(ws + WS_PR) + ro, nullptr, nullptr, (float*)(ws + WS_PC) + so, 64, F.lane);
}
__device__ __forceinline__ void scan_sample_item(Frame& F, const Args& a, int l, int sb, unsigned char* ws) {
    const int h = F.wave; const size_t ro = ((size_t)(MP + sb * 4)) * BW + h * 64;
    const float* S0 = (const float*)a.in[5] + ((size_t)((l * NSB + sb) * 8 + h)) * 4096; float* SO = a.out + O_WS + ((size_t)((l * NSB + sb) * 8 + h)) * 4096;
    scan_task<true>(uni_ptr((const float*)(ws + WS_R + l * SZ_RWL) + ro), uni_ptr((const float*)(ws + WS_W + l * SZ_RWL) + ro), uni_ptr((const float*)(ws + WS_KX + l * SZ_RWL) + ro), uni_ptr((const float*)(ws + WS_KK + l * SZ_RWL) + ro), uni_ptr((const float*)(ws + WS_KKA + l * SZ_RWL) + ro),
                    (const float*)(ws + WS_V) + ro, (float*)(ws + WS_OL) + ro, nullptr, S0, SO, 4, F.lane);
}
__device__ __forceinline__ float4 ld4(const float* p) { return *(const float4*)p; }
__device__ __forceinline__ void decode_item(Frame& F, const Args& a, int l, int item, unsigned char* ws) {
    const int sb = item >> 6, seg = item & 63, lane = F.lane, w = F.wave, tid = F.tid;
    LAS float* OM = (LAS float*)F.lds; LAS float* BT = OM + 256 * 16; LAS float* SEGT = BT + 256 * 16;
    const float* QS = (const float*)(ws + WS_QS); const int* pt = (const int*)a.in[4] + sb * NPAGES;
    const float* ck = (const float*)a.in[2] + (size_t)l * NPHYS * 128 * 512; const float* cv = (const float*)a.in[3] + (size_t)l * NPHYS * 128 * 512;
    const float* bias = (const float*)a.in[17] + l * 4;
    f32x4 Qr[4][2];
#pragma unroll
    for (int qi = 0; qi < 4; ++qi)
#pragma unroll
        for (int g = 0; g < 2; ++g) Qr[qi][g] = *(const f32x4*)(QS + (size_t)(sb * 4 + qi) * BW + g * 256 + 4 * lane);
    const int page = pt[seg * 2 + (w >> 2)];
    const size_t rbase = ((size_t)page * 128 + (w & 3) * 32) * 512;
    const int b4 = (lane >> 4) & 1, b3 = (lane >> 3) & 1, b2 = (lane >> 2) & 1;
    const int vidx = b4 * 4 + b3 * 2 + b2, qi_m = vidx >> 1, head_m = (vidx & 1) * 2 + (lane >> 5);
    const float bias_m = bias[head_m] * LOG2E;
    {
        f32x4 ka[4][2], kb[4][2];
#define DEC_LOADK(dst, i0) do { asm volatile("" ::: "memory"); _Pragma("unroll") for (int u = 0; u < 4; ++u) { const float* kr = ck + rbase + (size_t)((i0) + u) * 512; dst[u][0] = *(const f32x4*)(kr + 4 * lane); dst[u][1] = *(const f32x4*)(kr + 256 + 4 * lane); } } while (0)
#define DEC_SCORE(src, i0) do { _Pragma("unroll") for (int u = 0; u < 4; ++u) { \
            float v[8]; \
            _Pragma("unroll") for (int qi = 0; qi < 4; ++qi) { const f32x4 p0 = src[u][0] * Qr[qi][0], p1 = src[u][1] * Qr[qi][1]; v[qi * 2] = (p0[0] + p0[1]) + (p0[2] + p0[3]); v[qi * 2 + 1] = (p1[0] + p1[1]) + (p1[2] + p1[3]); } \
            float r4[4], r2[2], r1; \
            _Pragma("unroll") for (int j = 0; j < 4; ++j) { const float snd = b4 ? v[j] : v[4 + j], kp = b4 ? v[4 + j] : v[j]; r4[j] = kp + __shfl_xor(snd, 16); } \
            _Pragma("unroll") for (int j = 0; j < 2; ++j) { const float snd = b3 ? r4[j] : r4[2 + j], kp = b3 ? r4[2 + j] : r4[j]; r2[j] = kp + __shfl_xor(snd, 8); } \
            { const float snd = b2 ? r2[0] : r2[1], kp = b2 ? r2[1] : r2[0]; r1 = kp + __shfl_xor(snd, 4); } \
            r1 += __shfl_xor(r1, 2); r1 += __shfl_xor(r1, 1); \
            const float e = ex2(r1 + bias_m), om = rcpf_(1.0f + e), bt = e * om; \
            if ((lane & 3) == 0) { const int kl = w * 32 + (i0) + u; OM[kl * 16 + qi_m * 4 + head_m] = om; BT[kl * 16 + qi_m * 4 + head_m] = bt; } } } while (0)
        DEC_LOADK(ka, 0); DEC_LOADK(kb, 4); DEC_SCORE(ka, 0); DEC_LOADK(ka, 8); DEC_SCORE(kb, 4); DEC_LOADK(kb, 12); DEC_SCORE(ka, 8); DEC_LOADK(ka, 16); DEC_SCORE(kb, 12); DEC_LOADK(kb, 20); DEC_SCORE(ka, 16); DEC_LOADK(ka, 24); DEC_SCORE(kb, 20); DEC_LOADK(kb, 28); DEC_SCORE(ka, 24); DEC_SCORE(kb, 28);
#undef DEC_LOADK
#undef DEC_SCORE
    }
    LDS_WAIT(); __syncthreads();
    {
        const int qh = tid & 15, sg = tid >> 4;
        float pr = 1.f;
#pragma unroll
        for (int j = 0; j < 8; ++j) pr *= OM[(sg * 8 + j) * 16 + qh];
        SEGT[sg * 16 + qh] = pr;
        LDS_WAIT(); __syncthreads();
        float suf = 1.f;
        for (int s2 = 31; s2 > sg; --s2) suf *= SEGT[s2 * 16 + qh];
#pragma unroll
        for (int j = 7; j >= 0; --j) { const int kl = sg * 8 + j; const float att = BT[kl * 16 + qh] * suf; suf *= OM[kl * 16 + qh]; BT[kl * 16 + qh] = att; }
        if (sg == 0) ((float*)(ws + WS_TSEG))[(size_t)(sb * 64 + seg) * 16 + qh] = suf;
    }
    LDS_WAIT(); __syncthreads();
    f32x4 O[4][2];
#pragma unroll
    for (int qi = 0; qi < 4; ++qi) { O[qi][0] = (f32x4){0.f, 0.f, 0.f, 0.f}; O[qi][1] = O[qi][0]; }
    const int hh = lane >> 5;
    {
        f32x4 va[4][2], vb[4][2];
#define DEC_LOADV(dst, i0) do { asm volatile("" ::: "memory"); _Pragma("unroll") for (int u = 0; u < 4; ++u) { const float* vr = cv + rbase + (size_t)((i0) + u) * 512; dst[u][0] = *(const f32x4*)(vr + 4 * lane); dst[u][1] = *(const f32x4*)(vr + 256 + 4 * lane); } } while (0)
#define DEC_ACC(src, i0) do { _Pragma("unroll") for (int u = 0; u < 4; ++u) { const int kl = w * 32 + (i0) + u; \
            _Pragma("unroll") for (int qi = 0; qi < 4; ++qi) { const float a0 = BT[kl * 16 + qi * 4 + hh], a1 = BT[kl * 16 + qi * 4 + 2 + hh]; O[qi][0] += src[u][0] * a0; O[qi][1] += src[u][1] * a1; } } } while (0)
        DEC_LOADV(va, 0); DEC_LOADV(vb, 4); DEC_ACC(va, 0); DEC_LOADV(va, 8); DEC_ACC(vb, 4); DEC_LOADV(vb, 12); DEC_ACC(va, 8); DEC_LOADV(va, 16); DEC_ACC(vb, 12); DEC_LOADV(vb, 20); DEC_ACC(va, 16); DEC_LOADV(va, 24); DEC_ACC(vb, 20); DEC_LOADV(vb, 28); DEC_ACC(va, 24); DEC_ACC(vb, 28);
#undef DEC_LOADV
#undef DEC_ACC
    }
    __syncthreads();
    LAS float* RED = (LAS float*)F.lds;
#pragma unroll
    for (int qi = 0; qi < 4; ++qi)
#pragma unroll
        for (int g = 0; g < 2; ++g) { LAS float* d = RED + ((w * 16 + qi * 4 + g * 2 + hh) * 128 + 4 * (lane & 31)); d[0] = O[qi][g][0]; d[1] = O[qi][g][1]; d[2] = O[qi][g][2]; d[3] = O[qi][g][3]; }
    LDS_WAIT(); __syncthreads();
    { f32x4 s = (f32x4){0.f, 0.f, 0.f, 0.f};
#pragma unroll
      for (int j = 0; j < 8; ++j) { const LAS float* p = RED + j * 2048 + tid * 4; s += (f32x4){p[0], p[1], p[2], p[3]}; }
      *(f32x4*)((float*)(ws + WS_OSEG) + (size_t)(sb * 64 + seg) * 2048 + tid * 4) = s; }
    __syncthreads();
}

__device__ __forceinline__ void attn_unit(Frame& F, int b, int h, int qt, int kb_lo, int nkb, const bf16* QB, const bf16* KB, const bf16* VT, bf16* OUT, float bias2, f32x4* part, float* tpart) {
    LAS bf16* Ks = (LAS bf16*)F.lds;
    LAS bf16* Vs = (LAS bf16*)(F.lds + 34816);
    const int w = F.wave, lane = F.lane, li = lane & 15, g = lane >> 4, tid = F.tid;
    const int q0 = qt * 128 + w * 16, qpos = q0 + li;
    bf16x8 qf[4];
    { const bf16* qp = QB + (size_t)(b * SEQ + qpos) * BW + h * 128 + 8 * g;
#pragma unroll
      for (int ks = 0; ks < 4; ++ks) qf[ks] = *(const bf16x8*)(qp + 32 * ks); }
    f32x4 oacc[8];
#pragma unroll
    for (int dt = 0; dt < 8; ++dt) oacc[dt] = (f32x4){0.f, 0.f, 0.f, 0.f};
    float carry = 1.f;
    const int kr0 = tid >> 4, kc0 = (tid & 15) * 8;
    const int vr0 = tid >> 3, vc0 = (tid & 7) * 8;
    const bf16* kg = KB + (size_t)(b * SEQ) * BW + h * 128 + kc0;
    const bf16* vg = VT + (size_t)((b * 4 + h) * 128) * SEQ + vc0;
    u32x4 lk[2], lv[2];
    { const int kb = kb_lo + nkb - 1;
      lk[0] = *(const u32x4*)(kg + (size_t)(kb * 64 + kr0) * BW); lk[1] = *(const u32x4*)(kg + (size_t)(kb * 64 + kr0 + 32) * BW);
      lv[0] = *(const u32x4*)(vg + (size_t)vr0 * SEQ + kb * 64); lv[1] = *(const u32x4*)(vg + (size_t)(vr0 + 64) * SEQ + kb * 64);
      *(LAS u32x4*)(Ks + kr0 * 136 + kc0) = lk[0]; *(LAS u32x4*)(Ks + (kr0 + 32) * 136 + kc0) = lk[1];
      *(LAS u32x4*)(Vs + vr0 * 72 + vc0) = lv[0]; *(LAS u32x4*)(Vs + (vr0 + 64) * 72 + vc0) = lv[1]; }
    LDS_WAIT(); __syncthreads();
    for (int it = 0; it < nkb; ++it) {
        const int kb = kb_lo + nkb - 1 - it, buf = it & 1; const bool more = (it + 1 < nkb);
        if (more) { const int k2 = kb - 1;
            lk[0] = *(const u32x4*)(kg + (size_t)(k2 * 64 + kr0) * BW); lk[1] = *(const u32x4*)(kg + (size_t)(k2 * 64 + kr0 + 32) * BW);
            lv[0] = *(const u32x4*)(vg + (size_t)vr0 * SEQ + k2 * 64); lv[1] = *(const u32x4*)(vg + (size_t)(vr0 + 64) * SEQ + k2 * 64); }
        if (kb * 64 < q0 + 15) {
            const LAS bf16* Kb = Ks + buf * (64 * 136); const LAS bf16* Vb = Vs + buf * (128 * 72);
            f32x4 s[4];
#pragma unroll
            for (int st = 0; st < 4; ++st) { s[st] = (f32x4){bias2, bias2, bias2, bias2};
#pragma unroll
                for (int ks = 0; ks < 4; ++ks) { const bf16x8 af = *(const LAS bf16x8*)(Kb + (16 * st + li) * 136 + 32 * ks + 8 * g); s[st] = __builtin_amdgcn_mfma_f32_16x16x32_bf16(af, qf[ks], s[st], 0, 0, 0); } }
            float om[4][4], bt[4][4], lt[4], X[4], GT[4];
            if (kb * 64 + 63 >= q0) {
                const int kbase = kb * 64 + 4 * g;
#pragma unroll
                for (int st = 0; st < 4; ++st)
#pragma unroll
                    for (int r = 0; r < 4; ++r) { const float e = ex2(s[st][r]); float o = rcpf_(1.0f + e), bb = e * o;
                        if (kbase + 16 * st + r >= qpos) { o = 1.f; bb = 0.f; }
                        om[st][r] = o; bt[st][r] = bb; }
            } else {
#pragma unroll
                for (int st = 0; st < 4; ++st)
#pragma unroll
                    for (int r = 0; r < 4; ++r) { const float e = ex2(s[st][r]); const float o = rcpf_(1.0f + e); om[st][r] = o; bt[st][r] = e * o; }
            }
#pragma unroll
            for (int st = 0; st < 4; ++st) {
                const float sp2 = om[st][3], sp1 = sp2 * om[st][2], sp0 = sp1 * om[st][1]; lt[st] = sp0 * om[st][0];
                bt[st][2] *= sp2; bt[st][1] *= sp1; bt[st][0] *= sp0;
                const float xa = __shfl_xor(lt[st], 16), xb = __shfl_xor(lt[st], 32), xc = __shfl_xor(lt[st], 48);
                X[st] = (g == 0) ? xa * xb * xc : (g == 1) ? xb * xc : (g == 2) ? xa : 1.f;
                GT[st] = lt[st] * xa * xb * xc;
            }
            const float Y3 = carry, Y2 = Y3 * GT[3], Y1 = Y2 * GT[2], Y0 = Y1 * GT[1];
            carry = Y0 * GT[0];
            const float f[4] = {Y0 * X[0], Y1 * X[1], Y2 * X[2], Y3 * X[3]};
            bf16x8 pf[2];
#pragma unroll
            for (int ks = 0; ks < 2; ++ks) { u32x4 pw; pw.x = pk2(bt[2 * ks][0] * f[2 * ks], bt[2 * ks][1] * f[2 * ks]); pw.y = pk2(bt[2 * ks][2] * f[2 * ks], bt[2 * ks][3] * f[2 * ks]);
                pw.z = pk2(bt[2 * ks + 1][0] * f[2 * ks + 1], bt[2 * ks + 1][1] * f[2 * ks + 1]); pw.w = pk2(bt[2 * ks + 1][2] * f[2 * ks + 1], bt[2 * ks + 1][3] * f[2 * ks + 1]); pf[ks] = __builtin_bit_cast(bf16x8, pw); }
#pragma unroll
            for (int dt = 0; dt < 8; ++dt)
#pragma unroll
                for (int ks = 0; ks < 2; ++ks) { const LAS bf16* vp = Vb + (16 * dt + li) * 72 + 32 * ks + 4 * g;
                    const u32x2 a0 = *(const LAS u32x2*)vp, a1 = *(const LAS u32x2*)(vp + 16); const u32x4 av = (u32x4){a0.x, a0.y, a1.x, a1.y};
                    oacc[dt] = __builtin_amdgcn_mfma_f32_16x16x32_bf16(__builtin_bit_cast(bf16x8, av), pf[ks], oacc[dt], 0, 0, 0); }
        }
        if (more) { const int nb = buf ^ 1;
            *(LAS u32x4*)(Ks + nb * (64 * 136) + kr0 * 136 + kc0) = lk[0]; *(LAS u32x4*)(Ks + nb * (64 * 136) + (kr0 + 32) * 136 + kc0) = lk[1];
            *(LAS u32x4*)(Vs + nb * (128 * 72) + vr0 * 72 + vc0) = lv[0]; *(LAS u32x4*)(Vs + nb * (128 * 72) + (vr0 + 64) * 72 + vc0) = lv[1]; }
        LDS_WAIT(); __syncthreads();
    }
    if (part) {
#pragma unroll
        for (int dt = 0; dt < 8; ++dt) part[(w * 8 + dt) * 64 + lane] = oacc[dt];
        if (tpart) tpart[w * 64 + lane] = carry;
    } else {
        bf16* op = OUT + (size_t)(b * SEQ + qpos) * BW + h * 128 + 4 * g;
#pragma unroll
        for (int dt = 0; dt < 8; ++dt) *(u32x2*)(op + 16 * dt) = (u32x2){pk2(oacc[dt][0], oacc[dt][1]), pk2(oacc[dt][2], oacc[dt][3])};
    }
}
__device__ __forceinline__ void attn_combine_item(Frame& F, int item, unsigned char* ws, bf16* OUT) {
    const int bh = item >> 4, q16 = item & 15, qt = 16 + q16, b = bh >> 2, h = bh & 3, w = F.wave, lane = F.lane, li = lane & 15, g = lane >> 4;
    const size_t base = (size_t)(bh * 16 + q16);
    const float* pl = (const float*)(ws + WS_OPART) + (base * 2 + 0) * 16384 + (size_t)(w * 8 * 64 + lane) * 4;
    const float* pr = (const float*)(ws + WS_OPART) + (base * 2 + 1) * 16384 + (size_t)(w * 8 * 64 + lane) * 4;
    const float t = ((const float*)(ws + WS_TPART))[base * 512 + w * 64 + lane];
    bf16* op = OUT + (size_t)(b * SEQ + qt * 128 + w * 16 + li) * BW + h * 128 + 4 * g;
#pragma unroll
    for (int dt = 0; dt < 8; ++dt) { const f32x4 a = *(const f32x4*)(pr + dt * 256), c = *(const f32x4*)(pl + dt * 256); const f32x4 o = a + c * t; *(u32x2*)(op + 16 * dt) = (u32x2){pk2(o[0], o[1]), pk2(o[2], o[3])}; }
}
#define CARRY_BAR() do { asm volatile("s_waitcnt lgkmcnt(0)" ::: "memory"); __builtin_amdgcn_s_barrier(); asm volatile("" ::: "memory"); } while (0)
__device__ __forceinline__ void carry_item(Frame& F, const Args& a, int l, int bh, unsigned char* ws) {
    const int lane = F.lane, w = F.wave, bi = w & 1, bj = (w >> 1) & 1, kh = w >> 2, l31 = lane & 31, hi = lane >> 5;
    LAS float* St = (LAS float*)F.lds;
    LAS float* Pp = (LAS float*)(F.lds + 16384);
    const float* PC = (const float*)(ws + WS_PC) + (size_t)bh * 64 * 4096; const float* LC = (const float*)(ws + WS_LC) + (size_t)bh * 64 * 4096; float* SS = (float*)(ws + WS_SS) + (size_t)bh * 64 * 4096;
    for (int i = F.tid; i < 4096; i += 512) { St[i] = 0.f; SS[i] = 0.f; }
    const int lo_p = (32 * kh + hi) * 64 + 32 * bi + l31, lo_s = (32 * kh + hi) * 64 + 32 * bj + l31, lo_o = (32 * bi + 4 * hi) * 64 + 32 * bj + l31;
    float afn[16], ltn[16];
#pragma unroll
    for (int kk2 = 0; kk2 < 16; ++kk2) afn[kk2] = PC[lo_p + kk2 * 128];
#pragma unroll
    for (int r = 0; r < 16; ++r) ltn[r] = (kh == 0) ? LC[lo_o + ((r & 3) + 8 * (r >> 2)) * 64] : 0.f;
    CARRY_BAR();
    for (int c = 0; c < 64; ++c) {
        float af[16], lt[16];
#pragma unroll
        for (int i = 0; i < 16; ++i) { af[i] = afn[i]; lt[i] = ltn[i]; }
        if (c < 63) {
            const float* Pn = PC + (size_t)(c + 1) * 4096; const float* Ln = LC + (size_t)(c + 1) * 4096;
#pragma unroll
            for (int kk2 = 0; kk2 < 16; ++kk2) afn[kk2] = Pn[lo_p + kk2 * 128];
            if (kh == 0) {
#pragma unroll
                for (int r = 0; r < 16; ++r) ltn[r] = Ln[lo_o + ((r & 3) + 8 * (r >> 2)) * 64];
            }
        }
        float bfv[16];
#pragma unroll
        for (int kk2 = 0; kk2 < 16; ++kk2) bfv[kk2] = St[lo_s + kk2 * 128];
        f32x16 acc0, acc1;
#pragma unroll
        for (int r = 0; r < 16; ++r) { acc0[r] = 0.f; acc1[r] = 0.f; }
#pragma unroll
        for (int kk2 = 0; kk2 < 16; kk2 += 2) { acc0 = __builtin_amdgcn_mfma_f32_32x32x2f32(af[kk2], bfv[kk2], acc0, 0, 0, 0); acc1 = __builtin_amdgcn_mfma_f32_32x32x2f32(af[kk2 + 1], bfv[kk2 + 1], acc1, 0, 0, 0); }
        if (kh == 1) {
#pragma unroll
            for (int r = 0; r < 16; ++r) Pp[(bj * 2 + bi) * 1024 + r * 64 + lane] = acc0[r] + acc1[r];
        }
        CARRY_BAR();
        if (kh == 0) {
            float* so = SS + (size_t)(c + 1) * 4096;
#pragma unroll
            for (int r = 0; r < 16; ++r) { const int jo = ((r & 3) + 8 * (r >> 2)) * 64;
                const float nv = (acc0[r] + acc1[r]) + Pp[(bj * 2 + bi) * 1024 + r * 64 + lane] + lt[r];
                St[lo_o + jo] = nv;
                if (c < 63) so[lo_o + jo] = nv;
                else { const int j = 32 * bi + (r & 3) + 8 * (r >> 2) + 4 * hi, v = 32 * bj + l31; a.out[O_WP + ((size_t)(l * 16 + bh)) * 4096 + v * 64 + j] = nv; } }
        }
        CARRY_BAR();
    }
}

__device__ __forceinline__ void fixup_item(Frame& F, const Args& a, int l, int item, unsigned char* ws, bf16* ACTC) {
    const int b = item >> 7, chunk = (item >> 1) & 63, h = (item & 1) * 4 + (F.wave >> 1), th = F.wave & 1, lane = F.lane, l31 = lane & 31, hi = lane >> 5;
    LAS float* pr = (LAS float*)(F.lds + F.wave * 8704);
    LAS float* stt = pr + 2080;
    const size_t ro = ((size_t)(b * SEQ + chunk * 64 + 32 * th)) * BW + h * 64;
    const float* PR = (const float*)(ws + WS_PR) + ro; const float* OL = (const float*)(ws + WS_OL) + ro;
    const float* St = (const float*)(ws + WS_SS) + ((size_t)((b * 8 + h) * 64 + chunk)) * 4096;
    f32x16 acc[2];
    const float gg = ((const float*)a.in[28])[l * 512 + h * 64 + lane], gb = ((const float*)a.in[29])[l * 512 + h * 64 + lane];
    const float* Vv = (const float*)(ws + WS_V) + ro; const float* GG = (const float*)(ws + WS_GG) + ro; const float* RK = (const float*)(ws + WS_RK) + ((size_t)(b * SEQ + chunk * 64 + 32 * th)) * 8 + h;
    float b0[32], b1[32];
    {
        float prv[32];
#pragma unroll
        for (int t = 0; t < 32; ++t) prv[t] = PR[(size_t)t * BW + lane];
#pragma unroll
        for (int vj = 0; vj < 2; ++vj)
#pragma unroll
            for (int r = 0; r < 16; ++r) acc[vj][r] = OL[(size_t)((r & 3) + 8 * (r >> 2) + 4 * hi) * BW + 32 * vj + l31];
        if (chunk > 0) {
#pragma unroll
            for (int j = 0; j < 32; ++j) { const int m = 2 * j + hi; b0[j] = St[m * 64 + l31]; b1[j] = St[m * 64 + 32 + l31]; }
        }
#pragma unroll
        for (int t = 0; t < 32; ++t) pr[t * 65 + lane] = prv[t];
    }
    LDS_WAIT();
    if (chunk > 0) {
#pragma unroll
        for (int j = 0; j < 32; ++j) { const int m = 2 * j + hi; const float a0 = pr[l31 * 65 + m];
            acc[0] = __builtin_amdgcn_mfma_f32_32x32x2f32(a0, b0[j], acc[0], 0, 0, 0); acc[1] = __builtin_amdgcn_mfma_f32_32x32x2f32(a0, b1[j], acc[1], 0, 0, 0); }
    }
    float vv[32], gv[32], rk[32];
#pragma unroll
    for (int t = 0; t < 32; ++t) { vv[t] = Vv[(size_t)t * BW + lane]; gv[t] = GG[(size_t)t * BW + lane]; rk[t] = RK[(size_t)t * 8]; }
#pragma unroll
    for (int vj = 0; vj < 2; ++vj)
#pragma unroll
        for (int r = 0; r < 16; ++r) pr[((r & 3) + 8 * (r >> 2) + 4 * hi) * 65 + 32 * vj + l31] = acc[vj][r];
    LDS_WAIT();
    if (lane < 32) { float s1 = 0.f;
#pragma unroll 16
        for (int v = 0; v < 64; ++v) s1 += pr[lane * 65 + v];
        const float mean = s1 * (1.f / 64.f); float s2 = 0.f;
#pragma unroll 16
        for (int v = 0; v < 64; ++v) { const float d = pr[lane * 65 + v] - mean; s2 = fmaf(d, d, s2); }
        stt[lane * 2] = mean; stt[lane * 2 + 1] = 1.0f / sqrtf(s2 * (1.f / 64.f) + 64e-5f); }
    LDS_WAIT();
    bf16* op = ACTC + (size_t)(b * SEQ + chunk * 64 + 32 * th) * BW + h * 64 + lane;
#pragma unroll
    for (int t = 0; t < 32; ++t) {
        const float y = ((pr[t * 65 + lane] - stt[t * 2]) * stt[t * 2 + 1] * gg + gb + rk[t] * vv[t]) * gv[t];
        op[(size_t)t * BW] = (bf16)f2bf(y); }
    LDS_WAIT();
}
__device__ __forceinline__ void cpost_sample_item(Frame& F, const Args& a, int l, int part, unsigned char* ws, bf16* ACTC) {
    const int h = F.wave, lane = F.lane;
    const float gg = ((const float*)a.in[28])[l * 512 + h * 64 + lane], gb = ((const float*)a.in[29])[l * 512 + h * 64 + lane];
    float xo[8], vv[8], gv[8], rk[8];
#pragma unroll
    for (int j = 0; j < 8; ++j) { const int r = part * 8 + j; const size_t o = (size_t)(MP + r) * BW + h * 64 + lane;
        xo[j] = ((const float*)(ws + WS_OL))[o]; vv[j] = ((const float*)(ws + WS_V))[o]; gv[j] = ((const float*)(ws + WS_GG))[o]; rk[j] = ((const float*)(ws + WS_RK))[(size_t)(MP + r) * 8 + h]; }
#pragma unroll
    for (int j = 0; j < 8; ++j) { const int r = part * 8 + j; const size_t o = (size_t)(MP + r) * BW + h * 64 + lane;
        float x = xo[j];
        const float mean = wave_sum(x) * (1.f / 64.f); x -= mean;
        const float rstd = 1.0f / sqrtf(wave_sum(x * x) * (1.f / 64.f) + 64e-5f);
        ACTC[o] = (bf16)f2bf((x * rstd * gg + gb + rk[j] * vv[j]) * gv[j]); }
}
__device__ __forceinline__ void decode_combine_item(Frame& F, const Args& a, int l, int qi, unsigned char* ws, bf16* ACTB) {
    const int sb = F.wave, lane = F.lane, hh = lane >> 5;
    const float* QS = (const float*)(ws + WS_QS); const float* OSEG = (const float*)(ws + WS_OSEG); const float* TSEG = (const float*)(ws + WS_TSEG);
    const float* bias = (const float*)a.in[17] + l * 4; const float bz[2] = {bias[hh] * LOG2E, bias[2 + hh] * LOG2E};
    const float* kn = a.out + O_KS + ((size_t)l * MS + sb * 4) * 512; const float* vn = a.out + O_VS + ((size_t)l * MS + sb * 4) * 512;
    float one = 1.f; asm volatile("" : "+v"(one));
    f32x4 O[2] = {(f32x4){0.f, 0.f, 0.f, 0.f}, (f32x4){0.f, 0.f, 0.f, 0.f}}; float carry[2] = {one, one};
    f32x4 q[2];
#pragma unroll
    for (int g = 0; g < 2; ++g) q[g] = *(const f32x4*)(QS + (size_t)(sb * 4 + qi) * BW + g * 256 + 4 * lane);
    for (int j = qi - 1; j >= 0; --j) {
#pragma unroll
        for (int g = 0; g < 2; ++g) {
            const f32x4 kv = *(const f32x4*)(kn + (size_t)j * 512 + g * 256 + 4 * lane), p = kv * q[g];
            float d = (p[0] + p[1]) + (p[2] + p[3]);
#pragma unroll
            for (int o = 1; o < 32; o <<= 1) d += __shfl_xor(d, o);
            const float e = ex2(d + bz[g]), om = rcpf_(1.0f + e), att = e * om * carry[g];
            O[g] += *(const f32x4*)(vn + (size_t)j * 512 + g * 256 + 4 * lane) * att; carry[g] *= om;
        }
    }
#pragma unroll 1
    for (int hs = 1; hs >= 0; --hs) {
        float tv[2][32];
#pragma unroll
        for (int g = 0; g < 2; ++g)
#pragma unroll
            for (int sg = 0; sg < 32; ++sg) tv[g][sg] = TSEG[(size_t)(sb * 64 + hs * 32 + sg) * 16 + qi * 4 + g * 2 + hh];
#pragma unroll
        for (int g = 0; g < 2; ++g) { float c = carry[g];
#pragma unroll
            for (int sg = 31; sg >= 0; --sg) { const float t = tv[g][sg]; tv[g][sg] = c; c *= t; }
            carry[g] = c; }
#pragma unroll
        for (int sb8 = 0; sb8 < 4; ++sb8) {
            f32x4 ov[2][8];
#pragma unroll
            for (int g = 0; g < 2; ++g)
#pragma unroll
                for (int j = 0; j < 8; ++j) { const int seg = hs * 32 + sb8 * 8 + j; ov[g][j] = *(const f32x4*)(OSEG + ((size_t)(sb * 64 + seg) * 16 + qi * 4 + g * 2 + hh) * 128 + 4 * (lane & 31)); }
#pragma unroll
            for (int g = 0; g < 2; ++g)
#pragma unroll
                for (int j = 0; j < 8; ++j) O[g] += ov[g][j] * tv[g][sb8 * 8 + j];
        }
    }
    bf16* op = ACTB + (size_t)(MP + sb * 4 + qi) * BW;
#pragma unroll
    for (int g = 0; g < 2; ++g) *(u32x2*)(op + g * 256 + 4 * lane) = (u32x2){pk2(O[g][0], O[g][1]), pk2(O[g][2], O[g][3])};
}

template <int MODE>
__device__ __forceinline__ void skinny_rows(Frame& F, const bf16* A, size_t sA, const bf16* Bt, size_t sB, int K, const bf16* G, bf16* MB, const float* res, float* out, bf16* Hn, const float* gn, float* rs) {
    constexpr int NBR = (MODE == 0) ? 4 : 1;
    const int u = F.vcu; if (u >= 256) return;
    const int rt = u & 1, ct = u >> 1, lane = F.lane, li = lane & 15, q = lane >> 4, w = F.wave;
    LAS f32x4* red = (LAS f32x4*)F.lds;
    f32x4 acc[NBR];
    const int nks = K / 32;
#pragma unroll
    for (int b = 0; b < NBR; ++b) {
        acc[b] = (f32x4){0.f, 0.f, 0.f, 0.f};
        const bf16* ap = A + (size_t)b * sA + (size_t)(MP + 16 * rt + li) * K + 8 * q;
        const bf16* bp = Bt + (size_t)b * sB + (size_t)(16 * ct + li) * K + 8 * q;
#pragma unroll 4
        for (int ks = w; ks < nks; ks += 8) {
            const bf16x8 av = *(const bf16x8*)(ap + 32 * ks), bv = *(const bf16x8*)(bp + 32 * ks);
            acc[b] = __builtin_amdgcn_mfma_f32_16x16x32_bf16(bv, av, acc[b], 0, 0, 0);
        }
        red[(w * NBR + b) * 64 + lane] = acc[b];
    }
    LDS_WAIT(); __syncthreads();
    if (w == 0) {
        const int row = MP + 16 * rt + li, col = 16 * ct + 4 * q;
        f32x4 tot = (f32x4){0.f, 0.f, 0.f, 0.f};
#pragma unroll
        for (int b = 0; b < NBR; ++b) {
            f32x4 v = red[b * 64 + lane];
#pragma unroll
            for (int j = 1; j < 8; ++j) v += red[(j * NBR + b) * 64 + lane];
            if (MODE == 0) { const u32x2 gw = *(const u32x2*)(G + (size_t)row * NGATE + (size_t)b * D + col);
                const f32x4 gf = (f32x4){__builtin_bit_cast(float, gw.x << 16), __builtin_bit_cast(float, gw.x & 0xffff0000u), __builtin_bit_cast(float, gw.y << 16), __builtin_bit_cast(float, gw.y & 0xffff0000u)};
                tot += v * gf; }
            else tot += v;
        }
        if (MODE == 0) *(u32x2*)(MB + (size_t)row * D + col) = (u32x2){pk2(tot[0], tot[1]), pk2(tot[2], tot[3])};
        else { const f32x4 v = *(const f32x4*)(res + (size_t)(row - MP) * D + col) + tot; *(f32x4*)(out + (size_t)(row - MP) * D + col) = v;
            if (Hn) { const f32x4 h = v * *(const f32x4*)(gn + col); *(u32x2*)(Hn + (size_t)row * D + col) = (u32x2){pk2(h[0], h[1]), pk2(h[2], h[3])};
                float ss = (v[0] * v[0] + v[1] * v[1]) + (v[2] * v[2] + v[3] * v[3]); ss += __shfl_xor(ss, 16); ss += __shfl_xor(ss, 32);
                if (q == 0) (void)__hip_atomic_fetch_add(rs + row, ss, __ATOMIC_RELAXED, __HIP_MEMORY_SCOPE_AGENT); } }
    }
    __syncthreads();
}

constexpr int NPH = 1 + NL * 11;
__global__ void __launch_bounds__(512, 2) mk_fwd(Args args) {
    extern __shared__ __attribute__((aligned(16))) unsigned char lds_raw[];
    Frame F; F.lds = (LAS unsigned char*)lds_raw; F.tid = threadIdx.x; F.lane = F.tid & 63; F.wave = __builtin_amdgcn_readfirstlane(F.tid >> 6);
    F.G = gridDim.x; { const int bx = blockIdx.x; F.vcu = (F.G % 8 == 0) ? (bx % 8) * (F.G / 8) + bx / 8 : bx; }
    unsigned char* ws = args.ws;
    volatile LAS unsigned* MISC = (volatile LAS unsigned*)(F.lds + LDS_CTL_OFF);
    for (int u = F.tid; u < (LDS_BYTES - LDS_CTL_OFF) / 4; u += 512) ((LAS unsigned*)(F.lds + LDS_CTL_OFF))[u] = 0u;
    __syncthreads();
    const bool single = (args.ph_hi - args.ph_lo) > 1;
    XcdBarrier bar; bar.bar = (unsigned*)(ws + WS_CTL) + CW_BAR; bar.x = 0; bar.st = nullptr;
    if (single) bar = xcd_barrier_post((unsigned*)(ws + WS_CTL) + CW_BAR, MISC + 8);
    const int lo = args.ph_lo, hi = args.ph_hi; const int sel = args.li ? args.li : 0xff;
#ifndef PH_MASK
#define PH_MASK 0xFFFu
#endif
#define IN(k) (lo <= (k) && (k) < hi)
#define EN(x) (((PH_MASK) >> (x)) & 1u)
#define SEAM(k) do { if (IN(k) && IN((k) + 1)) xcd_barrier(bar); } while (0)

#define PH_PTRS unsigned char* wsp = ws; int lp = l; asm volatile("" : "+s"(wsp), "+s"(lp)); Frame Fp = F; asm volatile("" : "+v"(Fp.tid), "+v"(Fp.lane), "+s"(Fp.wave), "+s"(Fp.vcu)); \
    bf16* H = (bf16*)(wsp + WS_H); bf16* P = (bf16*)(wsp + WS_P); bf16* G = (bf16*)(wsp + WS_G); bf16* ACT = (bf16*)(wsp + WS_ACT); float* MF = (float*)(wsp + WS_MF); bf16* MB = (bf16*)(wsp + WS_MB); \
    float* X1 = (float*)(wsp + WS_X1); bf16* HID = (bf16*)(wsp + WS_HID); float* XL = (float*)(wsp + WS_XL); bf16* QB = (bf16*)(wsp + WS_QB); bf16* KB = (bf16*)(wsp + WS_KB); bf16* VT = (bf16*)(wsp + WS_VT); float* QS = (float*)(wsp + WS_QS); \
    (void)H; (void)P; (void)G; (void)ACT; (void)MF; (void)MB; (void)X1; (void)HID; (void)XL; (void)QB; (void)KB; (void)VT; (void)QS;

    if (IN(0) && EN(11)) { const int l = 0; PH_PTRS; p0_convert(Fp, args); norm_phase(Fp, (const float*)args.in[0], (const float*)args.in[1], (const float*)args.in[8], H); }
    SEAM(0);
    for (int l = 0; l < NL; ++l) {
        const int pb = 1 + l * 11;
        if (IN(pb + 0) && EN(0)) { PH_PTRS;
            pg8::Gemm g{H, (const bf16*)(wsp + WS_WIN + lp * SZ_WIN), MPAD, INW, D, 0, 0}; pg8::StaticOrder S; S.init(MPAD, INW, F.G, (int)blockIdx.x);
            pg8::EpiIn E{P, G, lp > 0 ? (const float*)((unsigned*)(wsp + WS_CTL) + CW_RS + ((lp - 1) * 2 + 1) * MPAD) : nullptr};
            pg8::gemm_phase<pg8::EpiIn, pg8::StaticOrder, true>(Fp.tid, Fp.lds, g, S, E);
        }
        SEAM(pb + 0);
        if (IN(pb + 1) && EN(1)) {
            constexpr int N_C = 257, N_A = 257, N_D = 264, N_B = 257;
            unsigned* qctr = (unsigned*)(ws + WS_CTL) + CW_Q + 64 * (l * 16 + 0);
            volatile LAS int* qslot = (volatile LAS int*)(F.lds + LDS_CTL_OFF + 64);
            int it = F.vcu;
            while (it < N_C + N_A + N_D + N_B) {
                int nx = 0; if (F.tid == 0) nx = 256 + (int)__hip_atomic_fetch_add(qctr, 1u, __ATOMIC_RELAXED, __HIP_MEMORY_SCOPE_AGENT);
                int r = it; PH_PTRS;
                if (r < N_C) { if (sel & 1) cprep_item(Fp, args, lp, r, P, wsp); }
                else if ((r -= N_C) < N_A) { if (sel & 4) { if (r < 256) gmlp_item(Fp, args, lp, r >> 2, r & 3, P, ACT); else gmlp_sample_item(Fp, args, lp, P, ACT); } }
                else if ((r -= N_A) < N_D) { if (sel & 2) dconv_item(Fp, args, lp, r, P, ACT + (size_t)3 * MPAD * BW); }
                else { r -= N_D; if (sel & 8) bprep_item(Fp, args, lp, r, P, QB, KB, VT, QS); }
                if (F.tid == 0) *qslot = nx;
                __syncthreads(); it = __builtin_amdgcn_readfirstlane(*qslot); __syncthreads();
            }
        }
        SEAM(pb + 1);
        if (IN(pb + 2) && EN(2)) {
            for (int it = F.vcu; it < 256 + 8; it += F.G) {
                PH_PTRS;
                if (it < 256) { if (sel & 1) scan_item(Fp, lp, it, wsp); }
                else if (sel & 1) scan_sample_item(Fp, args, lp, it - 256, wsp);
            }
        }
        SEAM(pb + 2);
        if (IN(pb + 3) && EN(3)) {
            const int u = F.vcu;
            if (u < 256) {
                { PH_PTRS; const int bh = u >> 5, qt = u & 31; if (qt < 2 && (sel & 1)) carry_item(Fp, args, lp, bh * 2 + qt, wsp); }
                {
                    unsigned* actr = (unsigned*)(ws + WS_CTL) + CW_Q + 64 * (l * 16 + 2 + (u >> 5));
                    volatile LAS int* qslot = (volatile LAS int*)(F.lds + LDS_CTL_OFF + 64);
                    for (;;) {
                        if (F.tid == 0) *qslot = (int)__hip_atomic_fetch_add(actr, 1u, __ATOMIC_RELAXED, __HIP_MEMORY_SCOPE_AGENT);
                        __syncthreads(); const int qi = __builtin_amdgcn_readfirstlane(*qslot); __syncthreads();
                        if (qi >= 112) break;
                        const int blk = qi / 7, pos = qi % 7;
                        PH_PTRS; const int bh = u >> 5;
                        if (pos == 0 || pos == 3 || pos == 5) {
                            if (!(sel & 2)) continue;
                            const int pi = 3 * blk + (pos == 0 ? 0 : pos == 3 ? 1 : 2);
                            const float b2 = ((const float*)args.in[17])[lp * 4 + (bh & 3)] * LOG2E;
                            bf16* AO = ACT + (size_t)1 * MPAD * BW;
                            int qt, kb_lo, nkb; f32x4* part = nullptr; float* tp = nullptr;
                            if (pi < 8) { qt = 15 - pi; kb_lo = 0; nkb = 2 * qt + 2; }
                            else if (pi >= 40) { qt = 47 - pi; kb_lo = 0; nkb = 2 * qt + 2; }
                            else { qt = 31 - ((pi - 8) >> 1); const int right = (pi - 8) & 1, q16 = qt - 16; kb_lo = right ? qt + 1 : 0; nkb = qt + 1;
                                part = (f32x4*)(wsp + WS_OPART) + ((size_t)((bh * 16 + q16) * 2 + right)) * 4096;
                                if (right) tp = (float*)(wsp + WS_TPART) + (size_t)(bh * 16 + q16) * 512; }
                            attn_unit(Fp, bh >> 2, bh & 3, qt, kb_lo, nkb, QB, KB, VT, AO, b2, part, tp);
                        } else {
                            if (!(sel & 4)) continue;
                            const int di = 4 * blk + (pos == 1 ? 0 : pos == 2 ? 1 : pos == 4 ? 2 : 3);
                            decode_item(Fp, args, lp, bh * 64 + di, wsp);
                        }
                    }
                }
            }
        }
        SEAM(pb + 3);
        if (IN(pb + 4) && EN(4)) {
            for (int it = F.vcu; it < 256 + 8; it += F.G) {
                PH_PTRS;
                if (it < 256) { fixup_item(Fp, args, lp, it, wsp, ACT + (size_t)2 * MPAD * BW); __syncthreads(); }
                else if (it < 260) cpost_sample_item(Fp, args, lp, it - 256, wsp, ACT + (size_t)2 * MPAD * BW);
                else decode_combine_item(Fp, args, lp, it - 260, wsp, ACT + (size_t)1 * MPAD * BW);
            }
            { const int ci = 255 - F.vcu; if (ci < 128) { PH_PTRS; attn_combine_item(Fp, ci, wsp, ACT + (size_t)1 * MPAD * BW); } }
        }
        SEAM(pb + 4);
        if (IN(pb + 5) && EN(5)) { PH_PTRS;
            pg8::Gemm g{ACT, (const bf16*)(wsp + WS_WBO + lp * SZ_WBO), MP, D, BW, (size_t)MPAD * BW, (size_t)D * BW}; pg8::MergeOrder S; S.so.initn(MP / 256, D / 128, F.G, (int)blockIdx.x);
            pg8::EpiMerge E{G, MB};
            pg8::gemm_phase<pg8::EpiMerge, pg8::MergeOrder, true, 1>(Fp.tid, Fp.lds, g, S, E);
            skinny_rows<0>(Fp, ACT, (size_t)MPAD * BW, (const bf16*)(wsp + WS_WBO + lp * SZ_WBO), (size_t)D * BW, BW, G, MB, nullptr, nullptr, nullptr, nullptr, nullptr);
        }
        SEAM(pb + 5);
        if (IN(pb + 6) && EN(6)) { PH_PTRS;
            const float* xin0 = lp == 0 ? (const float*)args.in[0] : XL; const float* xin1 = lp == 0 ? (const float*)args.in[1] : XL + (size_t)MP * D;
            pg8::Gemm g{MB, (const bf16*)(wsp + WS_WMIX + lp * SZ_WMIX), MP, D, D, 0, 0}; pg8::StaticOrder S; S.init(MP, D, F.G, (int)blockIdx.x);
            float* rsp = (float*)((unsigned*)(wsp + WS_CTL) + CW_RS + (lp * 2 + 0) * MPAD); const float* gnp = (const float*)args.in[37] + lp * D;
            pg8::EpiRes E{xin0, X1, H, gnp, rsp};
            pg8::gemm_phase<pg8::EpiRes, pg8::StaticOrder, true>(Fp.tid, Fp.lds, g, S, E);
            skinny_rows<1>(Fp, MB, 0, (const bf16*)(wsp + WS_WMIX + lp * SZ_WMIX), 0, D, nullptr, nullptr, xin1, X1 + (size_t)MP * D, H, gnp, rsp);
        }
        SEAM(pb + 6);
        if (IN(pb + 8) && EN(8)) { PH_PTRS;
            pg8::Gemm g{H, (const bf16*)(wsp + WS_WGU + lp * SZ_WGU), MPAD, 2 * FF, D, 0, 0}; pg8::StaticOrder S; S.init(MPAD, 2 * FF, F.G, (int)blockIdx.x);
            pg8::EpiGU E{HID, (const float*)((unsigned*)(wsp + WS_CTL) + CW_RS + (lp * 2 + 0) * MPAD)};
            pg8::gemm_phase<pg8::EpiGU, pg8::StaticOrder, true>(Fp.tid, Fp.lds, g, S, E);
        }
        SEAM(pb + 8);
        if (IN(pb + 9) && EN(9)) { PH_PTRS;
            float* yout = lp == NL - 1 ? args.out + O_Y : XL;
            pg8::Gemm g{HID, (const bf16*)(wsp + WS_WDN + lp * SZ_WDN), MP, D, FF, 0, 0}; pg8::StaticOrder S; S.init(MP, D, F.G, (int)blockIdx.x);
            const bool nxt = lp + 1 < NL; float* rsp = (float*)((unsigned*)(wsp + WS_CTL) + CW_RS + (lp * 2 + 1) * MPAD); const float* gnp = (const float*)args.in[8] + (nxt ? lp + 1 : 0) * D;
            pg8::EpiRes E{X1, yout, nxt ? H : nullptr, gnp, rsp};
            pg8::gemm_phase<pg8::EpiRes, pg8::StaticOrder, true>(Fp.tid, Fp.lds, g, S, E);
            skinny_rows<1>(Fp, HID, 0, (const bf16*)(wsp + WS_WDN + lp * SZ_WDN), 0, FF, nullptr, nullptr, X1 + (size_t)MP * D, yout + (size_t)MP * D, nxt ? H : nullptr, gnp, rsp);
        }
        if (l + 1 < NL) SEAM(pb + 9);
    }
#undef IN
#undef SEAM
}

#ifndef MK_PER_PHASE
#define MK_PER_PHASE 0
#endif
extern "C" void kernel_launch(void* const* d_in, const int* in_sizes, int n_in, void* d_out, int out_size, void* d_ws, size_t ws_size, hipStream_t stream) {
    static int grid = 0;
    if (grid == 0) {
        if (n_in != 41 || (size_t)out_size != O_END || ws_size < WS_END) { fprintf(stderr, "kernel_launch: unexpected shapes: n_in %d out %d ws %zu (need %zu)\n", n_in, out_size, ws_size, (size_t)WS_END); grid = -1; return; }
        int dev = 0, cus = 0, per_cu = 0;
        if (hipGetDevice(&dev) != hipSuccess || hipDeviceGetAttribute(&cus, hipDeviceAttributeMultiprocessorCount, dev) != hipSuccess) { grid = -1; return; }
        if (hipFuncSetAttribute((const void*)mk_fwd, hipFuncAttributeMaxDynamicSharedMemorySize, LDS_BYTES) != hipSuccess) { fprintf(stderr, "kernel_launch: hipFuncSetAttribute failed\n"); grid = -1; return; }
        if (hipOccupancyMaxActiveBlocksPerMultiprocessor(&per_cu, (const void*)mk_fwd, 512, LDS_BYTES) != hipSuccess || per_cu < 1) fprintf(stderr, "kernel_launch: occupancy query reports %d\n", per_cu);
        (void)hipGetLastError();
        grid = cus;
        if (grid != 256) fprintf(stderr, "kernel_launch: %d CUs (built for 256)\n", grid);
    }
    if (grid < 0) return;
    (void)hipMemsetAsync((char*)d_ws + WS_CTL, 0, CTL_BYTES, stream);
    Args a{};
    for (int i = 0; i < 41; ++i) a.in[i] = d_in[i];
    a.out = (float*)d_out; a.ws = (unsigned char*)d_ws; a.li = 0; a.pad = 0;
#ifndef MAX_PH
#define MAX_PH NPH
#endif
#if MK_PER_PHASE
    for (int p = 0; p < MAX_PH; ++p) { a.ph_lo = p; a.ph_hi = p + 1; hipLaunchKernelGGL(mk_fwd, dim3(grid), dim3(512), LDS_BYTES, stream, a); }
#else
    a.ph_lo = 0; a.ph_hi = MAX_PH;
    hipLaunchKernelGGL(mk_fwd, dim3(grid), dim3(512), LDS_BYTES, stream, a);
#endif
#ifdef PROBE_PH
    for (int r = 0; r < PROBE_N; ++r) { a.ph_lo = (PROBE_PH < 0) ? 0 : 1 + (NL - 1) * 11 + PROBE_PH; a.ph_hi = a.ph_lo + 1; a.li = PROBE_SEL; hipLaunchKernelGGL(mk_fwd, dim3(grid), dim3(512), LDS_BYTES, stream, a); }
#endif
    const hipError_t le = hipPeekAtLastError();
    if (le != hipSuccess) fprintf(stderr, "kernel_launch: launch failed: %s\n", hipGetErrorName(le));
}
```

```cpp
#include <hip/hip_runtime.h>
#include <cstdio>
#include <cstdint>

#define LAS __attribute__((address_space(3)))
typedef unsigned short bf16;
typedef short bf16x8 __attribute__((ext_vector_type(8)));
typedef float f32x4 __attribute__((ext_vector_type(4)));
typedef float f32x16 __attribute__((ext_vector_type(16)));
typedef float f32x2 __attribute__((ext_vector_type(2)));
typedef unsigned u32x4 __attribute__((ext_vector_type(4)));
typedef unsigned u32x2 __attribute__((ext_vector_type(2)));
typedef const __attribute__((address_space(4))) float cfloat;

constexpr int D = 2048, SEQ = 4096, NL = 2, NSB = 8, NST = 4, NPAGES = 128, NPHYS = 1280;
constexpr int BW = 512, FF = 5632, INW = 13568, NPRE = 5376, NGATE = 8192, CSHIFT = 1792;
constexpr int MP = 8192, MS = 32, MR = 8224, MPAD = 8448;
constexpr int PA0 = 0, PB0 = 1024, PC0 = 2560, PD0 = 4352;
constexpr float LOG2E = 1.4426950408889634f;

constexpr size_t O_Y = 0, O_KP = 16842752, O_VP = 25231360, O_KS = 33619968, O_VS = 33652736, O_WP = 33685504, O_WS = 33816576,
                 O_SHP = 34340864, O_SHS = 34348032, O_CP = 34376704, O_CS = 34438144, O_GV = 34683904, O_END = 34716672;

constexpr size_t al(size_t x) { return (x + 1048575) & ~(size_t)1048575; }
constexpr size_t WS_CTL = 0, CTL_BYTES = 1048576;
constexpr size_t SZ_WIN = (size_t)INW * D * 2, SZ_WBO = (size_t)4 * D * BW * 2, SZ_WMIX = (size_t)D * D * 2, SZ_WGU = (size_t)2 * FF * D * 2, SZ_WDN = (size_t)D * FF * 2, SZ_LW = (size_t)512 * 256 * 2;
constexpr size_t WS_WIN = al(WS_CTL + CTL_BYTES);
constexpr size_t WS_WBO = al(WS_WIN + NL * SZ_WIN);
constexpr size_t WS_WMIX = al(WS_WBO + NL * SZ_WBO);
constexpr size_t WS_WGU = al(WS_WMIX + NL * SZ_WMIX);
constexpr size_t WS_WDN = al(WS_WGU + NL * SZ_WGU);
constexpr size_t WS_LW = al(WS_WDN + NL * SZ_WDN);
constexpr size_t WS_H = al(WS_LW + NL * SZ_LW);
constexpr size_t WS_P = al(WS_H + (size_t)MPAD * D * 2);
constexpr size_t WS_G = al(WS_P + (size_t)MPAD * NPRE * 2);
constexpr size_t WS_ACT = al(WS_G + (size_t)MPAD * NGATE * 2);
constexpr size_t WS_MF = al(WS_ACT + (size_t)4 * MPAD * BW * 2);
constexpr size_t WS_MB = al(WS_MF + 1048576);
constexpr size_t WS_X1 = al(WS_MB + (size_t)MPAD * D * 2);
constexpr size_t WS_HID = al(WS_X1 + (size_t)MPAD * D * 4);
constexpr size_t WS_XL = al(WS_HID + (size_t)MPAD * FF * 2);
constexpr size_t WS_QB = al(WS_XL + (size_t)MPAD * D * 4);
constexpr size_t WS_KB = al(WS_QB + (size_t)MP * BW * 2);
constexpr size_t WS_VT = al(WS_KB + (size_t)MP * BW * 2);
constexpr size_t WS_QS = al(WS_VT + (size_t)MP * BW * 2);
constexpr size_t WS_OSEG = al(WS_QS + (size_t)MS * BW * 4);
constexpr size_t WS_TSEG = al(WS_OSEG + (size_t)8 * 64 * 16 * 128 * 4);
constexpr size_t SZ_RW = (size_t)MR * BW * 4;
constexpr size_t WS_R = al(WS_TSEG + 8 * 64 * 16 * 4);
constexpr size_t SZ_RWL = al(SZ_RW);
constexpr size_t WS_W = WS_R + NL * SZ_RWL, WS_KX = WS_W + NL * SZ_RWL, WS_V = WS_KX + NL * SZ_RWL, WS_KK = al(WS_V + SZ_RW), WS_KKA = WS_KK + NL * SZ_RWL, WS_GG = WS_KKA + NL * SZ_RWL;
constexpr size_t WS_OL = al(WS_GG + SZ_RW), WS_PR = al(WS_OL + SZ_RW);
constexpr size_t WS_RK = al(WS_PR + SZ_RW);
constexpr size_t SZ_CH = (size_t)16 * 64 * 4096 * 4;
constexpr size_t WS_PC = al(WS_RK + (size_t)MR * 8 * 4), WS_LC = al(WS_PC + SZ_CH), WS_SS = al(WS_LC + SZ_CH);
constexpr size_t WS_OPART = al(WS_SS + SZ_CH);
constexpr size_t WS_TPART = al(WS_OPART + (size_t)8 * 16 * 2 * 8 * 8 * 64 * 16);
constexpr size_t WS_END = al(WS_TPART + (size_t)8 * 16 * 8 * 64 * 4);

constexpr int CW_BAR = 4096;
constexpr int CW_RS = 16384;
constexpr int CW_Q = 8192;

constexpr int LDS_BYTES = 147456, LDS_CTL_OFF = 143360;

__device__ __forceinline__ unsigned f2bf(float f) { unsigned u = __builtin_bit_cast(unsigned, f); return (u + 0x7fffu + ((u >> 16) & 1u)) >> 16; }
typedef __bf16 bf16x2_t __attribute__((ext_vector_type(2)));
__device__ __forceinline__ unsigned pk2(float lo, float hi) { const f32x2 v = {lo, hi}; const bf16x2_t b = __builtin_convertvector(v, bf16x2_t); return __builtin_bit_cast(unsigned, b); }
__device__ __forceinline__ float wave_sum(float v) {
#pragma unroll
    for (int o = 1; o < 64; o <<= 1) v += __shfl_xor(v, o);
    return v;
}
__device__ __forceinline__ float ex2(float x) { return __builtin_amdgcn_exp2f(x); }
__device__ __forceinline__ float rcpf_(float x) { return __builtin_amdgcn_rcpf(x); }
__device__ __forceinline__ float sigmoidf_(float x) { return rcpf_(1.0f + ex2(-x * LOG2E)); }
__device__ __forceinline__ float gelu_tanh(float x) {
    const float u = 0.7978845608028654f * (x + 0.044715f * x * x * x);
    const float t = 1.0f - 2.0f * rcpf_(1.0f + ex2(2.0f * LOG2E * u));
    return 0.5f * x * (1.0f + t);
}
__device__ __forceinline__ f32x4 ldb4(const bf16* p) { const u32x2 w = *(const u32x2*)p; return (f32x4){__builtin_bit_cast(float, w.x << 16), __builtin_bit_cast(float, w.x & 0xffff0000u), __builtin_bit_cast(float, w.y << 16), __builtin_bit_cast(float, w.y & 0xffff0000u)}; }
#define LDS_WAIT() asm volatile("s_waitcnt lgkmcnt(0)" ::: "memory")
#define VM_WAIT() asm volatile("s_waitcnt vmcnt(0)" ::: "memory")

namespace pg8 {
typedef unsigned short bf16_t;
constexpr int BM = 256, BK = 64, HALF = 128, HTB = HALF * BK * 2, STAGE_BYTES = 8 * HTB, NXCD = 8, WGM = 8;
__host__ __device__ __forceinline__ int lds_byte(int r, int c) { const int st = (r >> 4) * 2 + (c >> 5), rr = r & 15, cc = c & 31, ob = rr * 64 + cc * 2; return st * 1024 + (ob ^ (((ob >> 9) & 1) << 5)); }
__host__ __device__ __forceinline__ void stage_rc(int b, int& R, int& C) { const int st = b / 1024, sb = b % 1024, swz = sb ^ (((sb >> 9) & 1) << 5); R = (st >> 1) * 16 + swz / 64; C = (st & 1) * 32 + (swz % 64) / 2; }
__host__ __device__ __forceinline__ int perm32(int rho) { const int n = rho >> 4, i = rho & 15; return 8 * (i >> 2) + 4 * n + (i & 3); }
struct Unit { int pm, pn, pb; };
struct Gemm { const bf16_t* A; const bf16_t* Bt; int M, N, K; size_t sA, sB; };
struct StaticOrder {
    int nM, nN, nwg, G, c;
    __host__ __device__ void init(int M, int N, int G_, int c_) { nM = M / BM; nN = N / BM; nwg = nM * nN; G = G_; c = c_; }
    __host__ __device__ void initn(int nM_, int nN_, int G_, int c_) { nM = nM_; nN = nN_; nwg = nM * nN; G = G_; c = c_; }
    __host__ __device__ bool next(int i, Unit& u) const {
        const long L = (long)i * G + c; if (L >= nwg) return false;
        int wgid = (int)L; { const int q = nwg / NXCD, r = nwg % NXCD, xcd = wgid % NXCD, off = wgid / NXCD; wgid = (xcd < r ? xcd * (q + 1) : r * (q + 1) + (xcd - r) * q) + off; }
        const int nig = WGM * nN, gid = wgid / nig, fm = gid * WGM, gsz = (nM - fm) < WGM ? (nM - fm) : WGM;
        u.pm = fm + ((wgid % nig) % gsz); u.pn = (wgid % nig) / gsz; u.pb = 0; return true;
    }
};
struct MergeOrder {
    StaticOrder so;
    __host__ __device__ bool next(int i, Unit& u) const { if (!so.next(i >> 2, u)) return false; u.pb = i & 3; return true; }
};
__device__ __forceinline__ unsigned cvt_pk_bf16(float lo, float hi) { return pk2(lo, hi); }

template <class Epi, class Sched, bool ALIGN_EPI, int NB = 2>
__device__ __forceinline__ void gemm_phase(const int tid, LAS unsigned char* lds, const Gemm g, const Sched& S, const Epi& E) {
    const int wid = __builtin_amdgcn_readfirstlane(tid >> 6), lane = tid & 63, wr = wid >> 2, wc = wid & 3, fr = lane & 15, fq = lane >> 4;
    const int K = g.K, nt = K / BK;
    unsigned voffA[2], voffB[2];
#pragma unroll
    for (int i = 0; i < 2; ++i) { int R, C; stage_rc(tid * 16 + i * 8192, R, C); const int Rb = (R & ~31) + perm32(R & 31);
        voffA[i] = (unsigned)(R * K + C) * 2u; voffB[i] = (unsigned)(Rb * K + C) * 2u; }
    const size_t kstep = (size_t)(BK * 2);
    const size_t hstep = (size_t)HALF * K * 2;
    const size_t tstep = 2 * hstep;
    const size_t bstep = (NB == 2) ? tstep : hstep;
    const unsigned ldsw = (unsigned)wid * 1024u;
    const int aoff = lds_byte(wr * 64 + fr, fq * 8), boff = lds_byte(wc * 32 + fr, fq * 8);
#define PG8_SA(b, h) (((b) * 2 + (h)) * HTB)
#define PG8_SB(b, h) ((4 + (b) * 2 + (h)) * HTB)
#define PG8_STAGE(bufoff, gbase, voff) do { _Pragma("unroll") for (int _i = 0; _i < 2; ++_i) \
        __builtin_amdgcn_global_load_lds((const unsigned*)((const char*)(gbase) + (voff)[_i]), (LAS unsigned*)(lds + (bufoff) + ldsw + _i * 8192), 16, 0, 0); } while (0)
#define PG8_LDA(dst, b, h) do { _Pragma("unroll") for (int m = 0; m < 4; ++m) _Pragma("unroll") for (int k = 0; k < 2; ++k) dst[m][k] = *(const LAS bf16x8*)(lds + PG8_SA(b, h) + aoff + m * 2048 + k * 1024); } while (0)
#define PG8_LDB(dst, b, h) do { _Pragma("unroll") for (int n = 0; n < 2; ++n) _Pragma("unroll") for (int k = 0; k < 2; ++k) dst[n][k] = *(const LAS bf16x8*)(lds + PG8_SB(b, h) + boff + n * 2048 + k * 1024); } while (0)
#define PG8_MMA(ai, bj, At, Bt) do { __builtin_amdgcn_s_setprio(1); _Pragma("unroll") for (int m = 0; m < 4; ++m) _Pragma("unroll") for (int n = 0; n < 2; ++n) _Pragma("unroll") for (int k = 0; k < 2; ++k) \
        acc[ai][bj][m][n] = __builtin_amdgcn_mfma_f32_16x16x32_bf16(Bt[n][k], At[m][k], acc[ai][bj][m][n], 0, 0, 0); __builtin_amdgcn_s_setprio(0); } while (0)
#define PG8_WAIT_V(n) asm volatile("s_waitcnt vmcnt(" #n ")" ::: "memory")
#define PG8_WAIT_L(n) asm volatile("s_waitcnt lgkmcnt(" #n ")" ::: "memory")
#define PG8_BAR __builtin_amdgcn_s_barrier()
#define PG8_SCHED __builtin_amdgcn_sched_barrier(0)
    Unit cur, nxt; int ui = 0;
    if (!S.next(0, cur)) return;
    f32x4 acc[2][NB][4][2];
    f32x4 xreg[NB == 1 ? 2 : 1][NB == 1 ? 4 : 1][NB == 1 ? 2 : 1];
#pragma unroll
    for (int a = 0; a < 2; ++a)
#pragma unroll
        for (int b = 0; b < NB; ++b)
#pragma unroll
            for (int m = 0; m < 4; ++m)
#pragma unroll
                for (int n = 0; n < 2; ++n) acc[a][b][m][n] = (f32x4){0.f, 0.f, 0.f, 0.f};
    bf16x8 At[4][2], B0[2][2], B1[NB == 2 ? 2 : 1][2];
    const char* cA = (const char*)(g.A + (size_t)cur.pb * g.sA) + (size_t)cur.pm * tstep; const char* cB = (const char*)(g.Bt + (size_t)cur.pb * g.sB) + (size_t)cur.pn * bstep;
    if constexpr (NB == 2) {
        PG8_STAGE(PG8_SB(0, 0), cB, voffB); PG8_STAGE(PG8_SB(0, 1), cB + hstep, voffB); PG8_STAGE(PG8_SA(0, 0), cA, voffA); PG8_STAGE(PG8_SA(0, 1), cA + hstep, voffA);
        if (wr == 1) PG8_BAR;
        PG8_WAIT_V(2); PG8_BAR;
        PG8_STAGE(PG8_SB(1, 0), cB + kstep, voffB); PG8_STAGE(PG8_SA(1, 0), cA + kstep, voffA); PG8_STAGE(PG8_SB(1, 1), cB + hstep + kstep, voffB);
        PG8_WAIT_V(6); PG8_BAR;
    } else {
        PG8_STAGE(PG8_SB(0, 0), cB, voffB); PG8_STAGE(PG8_SA(0, 0), cA, voffA); PG8_STAGE(PG8_SA(0, 1), cA + hstep, voffA);
        if (wr == 1) PG8_BAR;
        PG8_WAIT_V(2); PG8_BAR;
        PG8_STAGE(PG8_SB(1, 0), cB + kstep, voffB); PG8_STAGE(PG8_SA(1, 0), cA + kstep, voffA);
        PG8_WAIT_V(4); PG8_BAR;
    }
    for (;;) {
        const bool has_next = S.next(ui + 1, nxt);
        const char* nA = has_next ? (const char*)(g.A + (size_t)nxt.pb * g.sA) + (size_t)nxt.pm * tstep : cA; const char* nB = has_next ? (const char*)(g.Bt + (size_t)nxt.pb * g.sB) + (size_t)nxt.pn * bstep : cB;
        for (int t = 0; t < nt; t += 2) {
            const bool last = (t == nt - 2);
            const char* a1 = cA + (size_t)(t + 1) * kstep;
            const char* a2 = last ? nA : cA + (size_t)(t + 2) * kstep; const char* b2 = last ? nB : cB + (size_t)(t + 2) * kstep;
            const char* a3 = a2 + kstep; const char* b3 = b2 + kstep;
            if constexpr (NB == 2) {
            PG8_LDB(B0, 0, 0); PG8_LDB(B1, 0, 1); PG8_SCHED; PG8_LDA(At, 0, 0); PG8_STAGE(PG8_SA(1, 1), a1 + hstep, voffA);
            PG8_WAIT_V(8); PG8_WAIT_L(0); PG8_BAR; PG8_MMA(0, 0, At, B0); PG8_MMA(0, 1, At, B1); PG8_BAR; PG8_SCHED;
            PG8_LDA(At, 0, 1); PG8_STAGE(PG8_SB(0, 0), b2, voffB); PG8_STAGE(PG8_SB(0, 1), b2 + hstep, voffB); PG8_STAGE(PG8_SA(0, 0), a2, voffA);
            PG8_WAIT_V(8); PG8_WAIT_L(0); PG8_BAR; PG8_MMA(1, 0, At, B0); PG8_MMA(1, 1, At, B1); PG8_BAR; PG8_SCHED;
            PG8_LDB(B0, 1, 0); PG8_LDB(B1, 1, 1); PG8_SCHED; PG8_LDA(At, 1, 0); PG8_STAGE(PG8_SA(0, 1), a2 + hstep, voffA);
            PG8_WAIT_V(8); PG8_WAIT_L(0); PG8_BAR; PG8_MMA(0, 0, At, B0); PG8_MMA(0, 1, At, B1); PG8_BAR; PG8_SCHED;
            PG8_LDA(At, 1, 1); PG8_STAGE(PG8_SB(1, 0), b3, voffB); PG8_STAGE(PG8_SB(1, 1), b3 + hstep, voffB); PG8_STAGE(PG8_SA(1, 0), a3, voffA);
            PG8_WAIT_V(8); PG8_WAIT_L(0); PG8_BAR; PG8_MMA(1, 0, At, B0); PG8_MMA(1, 1, At, B1); PG8_BAR; PG8_SCHED;
            } else {
            PG8_LDB(B0, 0, 0); PG8_SCHED; PG8_LDA(At, 0, 0); PG8_STAGE(PG8_SA(1, 1), a1 + hstep, voffA);
            PG8_WAIT_V(6); PG8_WAIT_L(0); PG8_BAR; PG8_MMA(0, 0, At, B0); PG8_BAR; PG8_SCHED;
            PG8_LDA(At, 0, 1); PG8_STAGE(PG8_SB(0, 0), b2, voffB); PG8_STAGE(PG8_SA(0, 0), a2, voffA);
            PG8_WAIT_V(6); PG8_WAIT_L(0); PG8_BAR; PG8_MMA(1, 0, At, B0); PG8_BAR; PG8_SCHED;
            PG8_LDB(B0, 1, 0); PG8_SCHED; PG8_LDA(At, 1, 0); PG8_STAGE(PG8_SA(0, 1), a2 + hstep, voffA);
            PG8_WAIT_V(6); PG8_WAIT_L(0); PG8_BAR; PG8_MMA(0, 0, At, B0); PG8_BAR; PG8_SCHED;
            PG8_LDA(At, 1, 1); PG8_STAGE(PG8_SB(1, 0), b3, voffB); PG8_STAGE(PG8_SA(1, 0), a3, voffA);
            PG8_WAIT_V(6); PG8_WAIT_L(0); PG8_BAR; PG8_MMA(1, 0, At, B0); PG8_BAR; PG8_SCHED;
            }
        }
        if constexpr (ALIGN_EPI) { if (wr == 0) PG8_BAR; }
        if constexpr (NB == 2) E(acc, cur, wr, wc, fr, fq); else E(acc, xreg, cur, wr, wc, fr, fq);
        if (!has_next) break;
#pragma unroll
        for (int a = 0; a < 2; ++a)
#pragma unroll
            for (int b = 0; b < NB; ++b)
#pragma unroll
                for (int m = 0; m < 4; ++m)
#pragma unroll
                    for (int n = 0; n < 2; ++n) acc[a][b][m][n] = (f32x4){0.f, 0.f, 0.f, 0.f};
        cur = nxt; cA = nA; cB = nB; ++ui;
        if constexpr (ALIGN_EPI) { if (wr == 1) PG8_BAR; }
    }
    PG8_WAIT_V(0);
    if constexpr (!ALIGN_EPI) { if (wr == 0) PG8_BAR; }
    PG8_BAR;
#undef PG8_SA
#undef PG8_SB
#undef PG8_STAGE
#undef PG8_LDA
#undef PG8_LDB
#undef PG8_MMA
#undef PG8_WAIT_V
#undef PG8_WAIT_L
#undef PG8_BAR
#undef PG8_SCHED
}

struct EpiIn {
    bf16_t* P; bf16_t* G; const float* rs;
    __device__ __forceinline__ void operator()(const f32x4 (&acc)[2][2][4][2], const Unit& u, int wr, int wc, int fr, int fq) const {
        const int row0 = u.pm * BM + wr * 64 + fr;
        float scv[2][4];
#pragma unroll
        for (int ai = 0; ai < 2; ++ai)
#pragma unroll
            for (int m = 0; m < 4; ++m) scv[ai][m] = rs ? rs[row0 + ai * HALF + m * 16] : 0.f;
#pragma unroll
        for (int ai = 0; ai < 2; ++ai)
#pragma unroll
            for (int m = 0; m < 4; ++m) scv[ai][m] = rs ? 1.0f / sqrtf(scv[ai][m] * (1.0f / D) + 1e-6f) : 1.0f;
        if (u.pn < 21) {
            const int col0 = u.pn * BM + wc * 32 + 8 * fq;
#pragma unroll
            for (int ai = 0; ai < 2; ++ai)
#pragma unroll
                for (int m = 0; m < 4; ++m) { bf16_t* rowp = P + (size_t)(row0 + ai * HALF + m * 16) * NPRE + col0;
                    const float sc = scv[ai][m];
#pragma unroll
                    for (int bj = 0; bj < 2; ++bj) { const f32x4 v0 = acc[ai][bj][m][0] * sc, v1 = acc[ai][bj][m][1] * sc;
                        u32x4 w; w.x = cvt_pk_bf16(v0[0], v0[1]); w.y = cvt_pk_bf16(v0[2], v0[3]); w.z = cvt_pk_bf16(v1[0], v1[1]); w.w = cvt_pk_bf16(v1[2], v1[3]);
                        *(u32x4*)(rowp + bj * HALF) = w; } }
        } else {
            const int col0 = (u.pn - 21) * BM + wc * 32 + 8 * fq;
#pragma unroll
            for (int ai = 0; ai < 2; ++ai)
#pragma unroll
                for (int m = 0; m < 4; ++m) { bf16_t* rowp = G + (size_t)(row0 + ai * HALF + m * 16) * NGATE + col0;
                    const float sc = scv[ai][m];
#pragma unroll
                    for (int bj = 0; bj < 2; ++bj) { const f32x4 v0 = acc[ai][bj][m][0] * sc, v1 = acc[ai][bj][m][1] * sc;
                        u32x4 w; w.x = cvt_pk_bf16(sigmoidf_(v0[0]), sigmoidf_(v0[1])); w.y = cvt_pk_bf16(sigmoidf_(v0[2]), sigmoidf_(v0[3]));
                        w.z = cvt_pk_bf16(sigmoidf_(v1[0]), sigmoidf_(v1[1])); w.w = cvt_pk_bf16(sigmoidf_(v1[2]), sigmoidf_(v1[3]));
                        *(u32x4*)(rowp + bj * HALF) = w; } }
        }
    }
};
__device__ __forceinline__ f32x4 bf4lo(u32x4 g) { return (f32x4){__builtin_bit_cast(float, g.x << 16), __builtin_bit_cast(float, g.x & 0xffff0000u), __builtin_bit_cast(float, g.y << 16), __builtin_bit_cast(float, g.y & 0xffff0000u)}; }
__device__ __forceinline__ f32x4 bf4hi(u32x4 g) { return (f32x4){__builtin_bit_cast(float, g.z << 16), __builtin_bit_cast(float, g.z & 0xffff0000u), __builtin_bit_cast(float, g.w << 16), __builtin_bit_cast(float, g.w & 0xffff0000u)}; }
struct EpiMerge {
    const bf16_t* G; bf16_t* MB;
    __device__ __forceinline__ void operator()(const f32x4 (&acc)[2][1][4][2], f32x4 (&mr)[2][4][2], const Unit& u, int wr, int wc, int fr, int fq) const {
        const int row0 = u.pm * BM + wr * 64 + fr, col0 = u.pn * HALF + wc * 32 + 8 * fq;
        u32x4 gv[2][4];
#pragma unroll
        for (int ai = 0; ai < 2; ++ai)
#pragma unroll
            for (int m = 0; m < 4; ++m) gv[ai][m] = *(const u32x4*)(G + (size_t)(row0 + ai * HALF + m * 16) * NGATE + (size_t)u.pb * D + col0);
#pragma unroll
        for (int ai = 0; ai < 2; ++ai)
#pragma unroll
            for (int m = 0; m < 4; ++m) {
                const f32x4 p0 = acc[ai][0][m][0] * bf4lo(gv[ai][m]), p1 = acc[ai][0][m][1] * bf4hi(gv[ai][m]);
                if (u.pb == 0) { mr[ai][m][0] = p0; mr[ai][m][1] = p1; } else { mr[ai][m][0] += p0; mr[ai][m][1] += p1; }
                if (u.pb == 3) { const f32x4 v0 = mr[ai][m][0], v1 = mr[ai][m][1];
                    u32x4 w; w.x = cvt_pk_bf16(v0[0], v0[1]); w.y = cvt_pk_bf16(v0[2], v0[3]); w.z = cvt_pk_bf16(v1[0], v1[1]); w.w = cvt_pk_bf16(v1[2], v1[3]);
                    *(u32x4*)(MB + (size_t)(row0 + ai * HALF + m * 16) * D + col0) = w; } }
    }
};
struct EpiRes {
    const float* r0; float* out; bf16_t* Hn; const float* gn; float* rs;
    __device__ __forceinline__ void operator()(const f32x4 (&acc)[2][2][4][2], const Unit& u, int wr, int wc, int fr, int fq) const {
        const int row0 = u.pm * BM + wr * 64 + fr, col0 = u.pn * BM + wc * 32 + 8 * fq;
        f32x4 gv[2][2];
        if (Hn) {
#pragma unroll
            for (int bj = 0; bj < 2; ++bj) { gv[bj][0] = *(const f32x4*)(gn + col0 + bj * HALF); gv[bj][1] = *(const f32x4*)(gn + col0 + bj * HALF + 4); } }
#pragma unroll
        for (int aih = 0; aih < 4; ++aih) { const int ai = aih >> 1, m0 = (aih & 1) * 2;
            f32x4 rv[4][2][2];
#pragma unroll
            for (int m = m0; m < m0 + 2; ++m) { const float* rp = r0 + (size_t)(row0 + ai * HALF + m * 16) * D + col0;
#pragma unroll
                for (int bj = 0; bj < 2; ++bj) { rv[m][bj][0] = *(const f32x4*)(rp + bj * HALF); rv[m][bj][1] = *(const f32x4*)(rp + bj * HALF + 4); } }
#pragma unroll
            for (int m = m0; m < m0 + 2; ++m) { const int row = row0 + ai * HALF + m * 16;
                float ss = 0.f;
#pragma unroll
                for (int bj = 0; bj < 2; ++bj) { const f32x4 v0 = acc[ai][bj][m][0] + rv[m][bj][0], v1 = acc[ai][bj][m][1] + rv[m][bj][1];
                    float* op = out + (size_t)row * D + col0 + bj * HALF; *(f32x4*)op = v0; *(f32x4*)(op + 4) = v1;
                    if (Hn) { ss += (v0[0] * v0[0] + v0[1] * v0[1]) + (v0[2] * v0[2] + v0[3] * v0[3]) + (v1[0] * v1[0] + v1[1] * v1[1]) + (v1[2] * v1[2] + v1[3] * v1[3]);
                        const f32x4 h0 = v0 * gv[bj][0], h1 = v1 * gv[bj][1];
                        u32x4 w; w.x = cvt_pk_bf16(h0[0], h0[1]); w.y = cvt_pk_bf16(h0[2], h0[3]); w.z = cvt_pk_bf16(h1[0], h1[1]); w.w = cvt_pk_bf16(h1[2], h1[3]);
                        *(u32x4*)(Hn + (size_t)row * D + col0 + bj * HALF) = w; } }
                if (Hn) { ss += __shfl_xor(ss, 16); ss += __shfl_xor(ss, 32); if (fq == 0) (void)__hip_atomic_fetch_add(rs + row, ss, __ATOMIC_RELAXED, __HIP_MEMORY_SCOPE_AGENT); }
            }
        }
    }
};
struct EpiGU {
    bf16_t* HID; const float* rs;
    __device__ __forceinline__ void operator()(const f32x4 (&acc)[2][2][4][2], const Unit& u, int wr, int wc, int fr, int fq) const {
        const int row0 = u.pm * BM + wr * 64 + fr, col0 = u.pn * HALF + wc * 32 + 8 * fq;
        float scv[2][4];
#pragma unroll
        for (int ai = 0; ai < 2; ++ai)
#pragma unroll
            for (int m = 0; m < 4; ++m) scv[ai][m] = rs[row0 + ai * HALF + m * 16];
#pragma unroll
        for (int ai = 0; ai < 2; ++ai)
#pragma unroll
            for (int m = 0; m < 4; ++m) { const size_t row = (size_t)(row0 + ai * HALF + m * 16);
                const float sc = 1.0f / sqrtf(scv[ai][m] * (1.0f / D) + 1e-6f);
                const f32x4 g0 = acc[ai][0][m][0] * sc, g1 = acc[ai][0][m][1] * sc, u0 = acc[ai][1][m][0] * sc, u1 = acc[ai][1][m][1] * sc;
                float o[8];
#pragma unroll
                for (int j = 0; j < 4; ++j) { o[j] = g0[j] * sigmoidf_(g0[j]) * u0[j]; o[4 + j] = g1[j] * sigmoidf_(g1[j]) * u1[j]; }
                u32x4 w; w.x = cvt_pk_bf16(o[0], o[1]); w.y = cvt_pk_bf16(o[2], o[3]); w.z = cvt_pk_bf16(o[4], o[5]); w.w = cvt_pk_bf16(o[6], o[7]);
                *(u32x4*)(HID + row * FF + col0) = w; }
    }
};
}

#define XB_TMO      128
#define XB_XCNT(j)  (256  + 64 * (j))
#define XB_XSUB(j)  (1280 + 64 * (j))
#define XB_XGEN(j)  (2304 + 64 * (j))
#define XB_TOP      3328
#define XB_TOPGEN   3392
#define XCD_BAR_WORDS 3456
#define XB_SPIN_CAP (1u << 18)
__device__ __forceinline__ unsigned xb_ld(unsigned* p)              { return __hip_atomic_load(p, __ATOMIC_RELAXED, __HIP_MEMORY_SCOPE_AGENT); }
__device__ __forceinline__ unsigned xb_add(unsigned* p, unsigned v) { return __hip_atomic_fetch_add(p, v, __ATOMIC_RELAXED, __HIP_MEMORY_SCOPE_AGENT); }
__device__ __forceinline__ unsigned xb_xcc_id() { return (unsigned)__builtin_amdgcn_s_getreg((3 << 11) | 20) & 0xFu; }
#define XB_SPIN(cond, bar) do { unsigned _sp = 0; while (cond) { __builtin_amdgcn_s_sleep(1); \
    if ((++_sp & 255u) == 0u) { if (xb_ld(&(bar)[XB_TMO])) break; if (_sp > XB_SPIN_CAP) { atomicAdd(&(bar)[XB_TMO], 1u); break; } } } } while (0)
struct XcdBarrier { unsigned* bar; unsigned x; volatile LAS unsigned* st; };
__device__ __forceinline__ XcdBarrier xcd_barrier_post(unsigned* bar, volatile LAS unsigned* st) {
    XcdBarrier b; b.bar = bar; b.x = xb_xcc_id(); b.st = st;
    if (threadIdx.x == 0) (void)xb_add(&bar[XB_XCNT(b.x)], 1u);
    return b;
}
__device__ __forceinline__ void xcd_barrier_complete(unsigned* bar, unsigned x, unsigned& nloc, unsigned& nx) {
    const unsigned G = gridDim.x * gridDim.y * gridDim.z;
    unsigned sum, cnt, mine, sp = 0u;
    for (;;) {
        sum = 0u; cnt = 0u; mine = 0u;
#pragma unroll
        for (unsigned j = 0; j < 16; ++j) { const unsigned c = xb_ld(&bar[XB_XCNT(j)]); sum += c; cnt += (c > 0u) ? 1u : 0u; mine = (j == x) ? c : mine; }
        if (sum == G) break;
        __builtin_amdgcn_s_sleep(1);
        if ((++sp & 255u) == 0u) { if (xb_ld(&bar[XB_TMO])) break; if (sp > XB_SPIN_CAP) { atomicAdd(&bar[XB_TMO], 1u); break; } }
    }
    nloc = mine > 0u ? mine : 1u; nx = cnt > 0u ? cnt : 1u;
}
__device__ __forceinline__ void xcd_barrier(const XcdBarrier& b) {
    asm volatile("s_waitcnt vmcnt(0)" ::: "memory");
    __syncthreads();
    if (threadIdx.x == 0) {
        unsigned* bar = b.bar;
        __builtin_amdgcn_s_waitcnt(0);
        unsigned nloc = b.st[0], nx = b.st[1];
        if (nloc == 0u) { xcd_barrier_complete(bar, b.x, nloc, nx); b.st[0] = nloc; b.st[1] = nx; }
        const unsigned old = xb_add(&bar[XB_XSUB(b.x)], 1u);
        const unsigned gen = old / nloc;
        if (old + 1u == (gen + 1u) * nloc) {
            __builtin_amdgcn_fence(__ATOMIC_RELEASE, "agent");
            asm volatile("s_waitcnt vmcnt(0)" ::: "memory");
            const unsigned og = xb_add(&bar[XB_TOP], 1u);
            const unsigned tg = og / nx;
            if (og + 1u == (tg + 1u) * nx) xb_add(&bar[XB_TOPGEN], 1u);
            else XB_SPIN(xb_ld(&bar[XB_TOPGEN]) == tg, bar);
            __builtin_amdgcn_fence(__ATOMIC_ACQUIRE, "agent");
            xb_add(&bar[XB_XGEN(b.x)], 1u);
            asm volatile("s_waitcnt vmcnt(0)" ::: "memory");
        } else {
            XB_SPIN(xb_ld(&bar[XB_XGEN(b.x)]) == gen, bar);
            __builtin_amdgcn_fence(__ATOMIC_ACQUIRE, "agent");
            asm volatile("s_waitcnt vmcnt(0)" ::: "memory");
        }
    }
    __syncthreads();
}

struct Args { const void* in[41]; float* out; unsigned char* ws; int ph_lo, ph_hi, li, pad; };
struct Frame {
    LAS unsigned char* lds;
    int tid, lane, wave, vcu, G;
};
constexpr int NW = 8;

__device__ __forceinline__ void cvt_item(const float* W, int N, bf16* WT, int Kd, int k0, int n0, int drow0, int kd0, LAS float* scr, int lane) {
    const int lr = lane >> 4, lc = (lane & 15) * 4;
    f32x4 v[16];
#pragma unroll
    for (int i = 0; i < 16; ++i) v[i] = __builtin_nontemporal_load((const f32x4*)(W + (size_t)(k0 + 4 * i + lr) * N + n0 + lc));
#pragma unroll
    for (int i = 0; i < 16; ++i) { LAS float* s = scr + (4 * i + lr) * 65 + lc; s[0] = v[i][0]; s[1] = v[i][1]; s[2] = v[i][2]; s[3] = v[i][3]; }
    LDS_WAIT(); asm volatile("" ::: "memory");
    const int c = lane & 7;
#pragma unroll
    for (int j = 0; j < 8; ++j) { const int n = (lane >> 3) + 8 * j; const LAS float* s = scr + (8 * c) * 65 + n;
        u32x4 o; o.x = pk2(s[0 * 65], s[1 * 65]); o.y = pk2(s[2 * 65], s[3 * 65]); o.z = pk2(s[4 * 65], s[5 * 65]); o.w = pk2(s[6 * 65], s[7 * 65]);
        *(u32x4*)(WT + (size_t)(drow0 + n) * Kd + kd0 + 8 * c) = o; }
    LDS_WAIT(); asm volatile("" ::: "memory");
}
__device__ __forceinline__ void p0_convert(Frame& F, const Args& a) {
    LAS float* scr = (LAS float*)(F.lds + F.wave * 16640);
    const int gw = F.vcu * NW + F.wave, NGW = F.G * NW;
    constexpr int I_IN = 32 * 212, I_BO = 8 * 32, I_MIX = 32 * 32, I_G = 32 * 88, I_DN = 88 * 32, I_LW = 8, I_LG = 16;
    constexpr int PER_L = I_IN + 4 * I_BO + I_MIX + 2 * I_G + I_DN + 2 * I_LW + I_LG;
    for (int it = gw; it < NL * PER_L; it += NGW) {
        const int l = it / PER_L; int r = it % PER_L;
        unsigned char* ws = a.ws;
        if (r < I_IN) { const int kb = r / 212, nb = r % 212; cvt_item((const float*)a.in[9] + (size_t)l * D * INW, INW, (bf16*)(ws + WS_WIN + l * SZ_WIN), D, kb * 64, nb * 64, nb * 64, kb * 64, scr, F.lane); continue; } r -= I_IN;
        if (r < 4 * I_BO) { const int b = r / I_BO, q = r % I_BO, kb = q / 32, nb = q % 32; const int idx = (b == 0) ? 14 : (b == 1) ? 18 : (b == 2) ? 30 : 35;
            cvt_item((const float*)a.in[idx] + (size_t)l * BW * D, D, (bf16*)(ws + WS_WBO + l * SZ_WBO) + (size_t)b * D * BW, BW, kb * 64, nb * 64, nb * 64, kb * 64, scr, F.lane); continue; } r -= 4 * I_BO;
        if (r < I_MIX) { const int kb = r / 32, nb = r % 32; cvt_item((const float*)a.in[36] + (size_t)l * D * D, D, (bf16*)(ws + WS_WMIX + l * SZ_WMIX), D, kb * 64, nb * 64, nb * 64, kb * 64, scr, F.lane); continue; } r -= I_MIX;
        if (r < 2 * I_G) { const int up = r / I_G, q = r % I_G, kb = q / 88, nb = q % 88, n0 = nb * 64;
            cvt_item((const float*)a.in[up ? 39 : 38] + (size_t)l * D * FF, FF, (bf16*)(ws + WS_WGU + l * SZ_WGU), D, kb * 64, n0, (n0 / 128) * 256 + up * 128 + (n0 % 128), kb * 64, scr, F.lane); continue; } r -= 2 * I_G;
        if (r < I_DN) { const int kb = r / 32, nb = r % 32; cvt_item((const float*)a.in[40] + (size_t)l * FF * D, D, (bf16*)(ws + WS_WDN + l * SZ_WDN), FF, kb * 64, nb * 64, nb * 64, kb * 64, scr, F.lane); continue; } r -= I_DN;
        bf16* lw = (bf16*)(ws + WS_LW + l * SZ_LW);
        if (r < I_LW) { cvt_item((const float*)a.in[21] + (size_t)l * 64 * 512, 512, lw, 256, 0, r * 64, r * 64, 0, scr, F.lane); continue; } r -= I_LW;
        if (r < I_LW) { cvt_item((const float*)a.in[23] + (size_t)l * 64 * 512, 512, lw, 256, 0, r * 64, r * 64, 64, scr, F.lane); continue; } r -= I_LW;
        { const int kb = r / 8, nb = r % 8; cvt_item((const float*)a.in[24] + (size_t)l * 128 * 512, 512, lw, 256, kb * 64, nb * 64, nb * 64, 128 + kb * 64, scr, F.lane); }
    }
}

__device__ __forceinline__ void norm_phase(Frame& F, const float* s0, const float* s1, const float* gain, bf16* H) {
    const int gw = F.vcu * NW + F.wave, NGW = F.G * NW;
    f32x4 gv[8];
#pragma unroll
    for (int j = 0; j < 8; ++j) gv[j] = *(const f32x4*)(gain + (j * 64 + F.lane) * 4);
    for (int m = gw; m < MPAD; m += NGW) {
        u32x2* o = (u32x2*)(H + (size_t)m * D) + F.lane;
        if (m >= MR) {
#pragma unroll
            for (int j = 0; j < 8; ++j) o[64 * j] = (u32x2){0u, 0u};
            continue; }
        const f32x4* xr = (const f32x4*)((m < MP) ? s0 + (size_t)m * D : s1 + (size_t)(m - MP) * D) + F.lane;
        f32x4 v[8]; float ss = 0.f;
#pragma unroll
        for (int j = 0; j < 8; ++j) { v[j] = xr[64 * j]; ss += (v[j][0] * v[j][0] + v[j][1] * v[j][1]) + (v[j][2] * v[j][2] + v[j][3] * v[j][3]); }
        const float rs = 1.0f / sqrtf(wave_sum(ss) * (1.0f / D) + 1e-6f);
#pragma unroll
        for (int j = 0; j < 8; ++j) { const f32x4 y = v[j] * rs * gv[j]; o[64 * j] = (u32x2){pk2(y[0], y[1]), pk2(y[2], y[3])}; }
    }
}

__device__ __forceinline__ void gmlp_item(Frame& F, const Args& a, int l, int chunk, int g, const bf16* P, bf16* ACTA) {
    LAS bf16* Vt = (LAS bf16*)F.lds;
    const int lane = F.lane, w = F.wave;
    const float* lng = (const float*)a.in[10] + l * 512; const float* lnb = (const float*)a.in[11] + l * 512;
    const float* ws_ = (const float*)a.in[12] + (size_t)(l * 4 + g) * 128 * 128; const float* bs = (const float*)a.in[13] + (l * 4 + g) * 128;
    const int row0 = chunk * 128;
    f32x4 uv[8]; float btv[8];
    { const int li_ = lane & 15, q_ = lane >> 4, c0_ = 128 * g + 16 * w + 4 * q_;
#pragma unroll
      for (int tt = 0; tt < 8; ++tt) { const int t = 16 * tt + li_; uv[tt] = ldb4(P + (size_t)(row0 + t) * NPRE + PA0 + c0_); btv[tt] = bs[t]; } }
    const int myj = g >> 1, mylo = (g & 1) * 32;
    const f32x4 lgv = *(const f32x4*)(lng + myj * 256 + 4 * lane), lbv = *(const f32x4*)(lnb + myj * 256 + 4 * lane);
#pragma unroll 1
    for (int i0 = 0; i0 < 16; i0 += 8) {
        f32x4 xa[8], xb[8];
#pragma unroll
        for (int i = 0; i < 8; ++i) { const bf16* pr = P + (size_t)(row0 + w * 16 + i0 + i) * NPRE + PA0 + 512; xa[i] = ldb4(pr + 4 * lane); xb[i] = ldb4(pr + 256 + 4 * lane); }
#pragma unroll
        for (int i = 0; i < 8; ++i) {
            const int s = w * 16 + i0 + i; f32x4 x0 = xa[i], x1 = xb[i];
#pragma unroll
            for (int j = 0; j < 4; ++j) { x0[j] = gelu_tanh(x0[j]); x1[j] = gelu_tanh(x1[j]); }
            const float mean = wave_sum((x0[0] + x0[1]) + (x0[2] + x0[3]) + (x1[0] + x1[1]) + (x1[2] + x1[3])) * (1.f / 512.f);
            x0 -= mean; x1 -= mean;
            const float var = wave_sum((x0[0] * x0[0] + x0[1] * x0[1]) + (x0[2] * x0[2] + x0[3] * x0[3]) + (x1[0] * x1[0] + x1[1] * x1[1]) + (x1[2] * x1[2] + x1[3] * x1[3])) * (1.f / 512.f);
            const float rstd = 1.0f / sqrtf(var + 1e-5f);
            const f32x4 xm = myj ? x1 : x0;
            if ((lane >> 5) == (g & 1)) {
                const int cl = 4 * (lane - mylo);
#pragma unroll
                for (int j = 0; j < 4; ++j) Vt[(cl + j) * 136 + s] = (bf16)f2bf(xm[j] * rstd * lgv[j] + lbv[j]);
            }
        }
    }
    LDS_WAIT(); __syncthreads();
    const int li = lane & 15, q = lane >> 4;
    f32x4 acc[8];
#pragma unroll
    for (int tt = 0; tt < 8; ++tt) acc[tt] = (f32x4){0.f, 0.f, 0.f, 0.f};
#pragma unroll
    for (int ks = 0; ks < 4; ++ks) {
        const bf16x8 af = *(const LAS bf16x8*)(Vt + (16 * w + li) * 136 + 32 * ks + 8 * q);
        const int s0 = 32 * ks + 8 * q;
        f32x4 wl[8][2];
#pragma unroll
        for (int tt = 0; tt < 8; ++tt) { if (32 * ks > 16 * tt + 15) continue; const int t = 16 * tt + li; wl[tt][0] = *(const f32x4*)(ws_ + t * 128 + s0); wl[tt][1] = *(const f32x4*)(ws_ + t * 128 + s0 + 4); }
#pragma unroll
        for (int tt = 0; tt < 8; ++tt) {
            if (32 * ks > 16 * tt + 15) continue;
            const int t = 16 * tt + li;
            float wv[8] = {wl[tt][0][0], wl[tt][0][1], wl[tt][0][2], wl[tt][0][3], wl[tt][1][0], wl[tt][1][1], wl[tt][1][2], wl[tt][1][3]};
#pragma unroll
            for (int j = 0; j < 8; ++j) if (s0 + j > t) wv[j] = 0.f;
            u32x4 bw; bw.x = pk2(wv[0], wv[1]); bw.y = pk2(wv[2], wv[3]); bw.z = pk2(wv[4], wv[5]); bw.w = pk2(wv[6], wv[7]);
            acc[tt] = __builtin_amdgcn_mfma_f32_16x16x32_bf16(af, __builtin_bit_cast(bf16x8, bw), acc[tt], 0, 0, 0);
        }
    }
    {
        const int c0 = 128 * g + 16 * w + 4 * q;
#pragma unroll
        for (int tt = 0; tt < 8; ++tt) {
            const int t = 16 * tt + li; float o[4];
#pragma unroll
            for (int j = 0; j < 4; ++j) o[j] = gelu_tanh(uv[tt][j]) * (acc[tt][j] + btv[tt]);
            *(u32x2*)(ACTA + (size_t)(row0 + t) * BW + c0) = (u32x2){pk2(o[0], o[1]), pk2(o[2], o[3])};
        }
    }
    __syncthreads();
}
__device__ __forceinline__ void gmlp_sample_item(Frame& F, const Args& a, int l, const bf16* P, bf16* ACTA) {
    const int lane = F.lane, sb = F.wave;
    const float* lng = (const float*)a.in[10] + l * 512; const float* lnb = (const float*)a.in[11] + l * 512;
    float vn[4][8], uu[4][8];
#pragma unroll
    for (int t = 0; t < 4; ++t) {
        const bf16* pr = P + (size_t)(MP + sb * 4 + t) * NPRE + PA0;
        f32x4 u0 = ldb4(pr + 4 * lane), u1 = ldb4(pr + 256 + 4 * lane), x0 = ldb4(pr + 512 + 4 * lane), x1 = ldb4(pr + 768 + 4 * lane);
#pragma unroll
        for (int j = 0; j < 4; ++j) { x0[j] = gelu_tanh(x0[j]); x1[j] = gelu_tanh(x1[j]); uu[t][j] = gelu_tanh(u0[j]); uu[t][4 + j] = gelu_tanh(u1[j]); }
        const float mean = wave_sum((x0[0] + x0[1]) + (x0[2] + x0[3]) + (x1[0] + x1[1]) + (x1[2] + x1[3])) * (1.f / 512.f);
        x0 -= mean; x1 -= mean;
        const float var = wave_sum((x0[0] * x0[0] + x0[1] * x0[1]) + (x0[2] * x0[2] + x0[3] * x0[3]) + (x1[0] * x1[0] + x1[1] * x1[1]) + (x1[2] * x1[2] + x1[3] * x1[3])) * (1.f / 512.f);
        const float rstd = 1.0f / sqrtf(var + 1e-5f);
        const f32x4 g0 = *(const f32x4*)(lng + 4 * lane), g1 = *(const f32x4*)(lng + 256 + 4 * lane), b0 = *(const f32x4*)(lnb + 4 * lane), b1 = *(const f32x4*)(lnb + 256 + 4 * lane);
        f32x4 y0 = x0 * rstd * g0 + b0, y1 = x1 * rstd * g1 + b1;
        float* gv = a.out + O_GV + (size_t)((l * NSB + sb) * NST + t) * 512;
        *(f32x4*)(gv + 4 * lane) = y0; *(f32x4*)(gv + 256 + 4 * lane) = y1;
#pragma unroll
        for (int j = 0; j < 4; ++j) { vn[t][j] = y0[j]; vn[t][4 + j] = y1[j]; }
    }
#pragma unroll
    for (int t = 0; t < 4; ++t) {
        float o[8];
#pragma unroll
        for (int hf = 0; hf < 2; ++hf) {
            const int g = hf * 2 + (lane >> 5);
            const float* wg = (const float*)a.in[12] + (size_t)(l * 4 + g) * 128 * 128; const float bt = ((const float*)a.in[13])[(l * 4 + g) * 128 + t];
#pragma unroll
            for (int j = 0; j < 4; ++j) { float s = bt;
#pragma unroll
                for (int s2 = 0; s2 <= t; ++s2) s += wg[t * 128 + s2] * vn[s2][hf * 4 + j];
                o[hf * 4 + j] = uu[t][hf * 4 + j] * s; }
        }
        bf16* op = ACTA + (size_t)(MP + sb * 4 + t) * BW;
        *(u32x2*)(op + 4 * lane) = (u32x2){pk2(o[0], o[1]), pk2(o[2], o[3])}; *(u32x2*)(op + 256 + 4 * lane) = (u32x2){pk2(o[4], o[5]), pk2(o[6], o[7])};
    }
}
__device__ __forceinline__ void bprep_item(Frame& F, const Args& a, int l, int item, const bf16* P, bf16* QB, bf16* KB, bf16* VT, float* QS) {
    const int lane = F.lane, w = F.wave; const bool samp = (item == 256); const int row0 = item * 32;
    LAS float* vs = (LAS float*)F.lds;
    const float* qn = (const float*)a.in[15] + l * 128; const float* kn = (const float*)a.in[16] + l * 128;
    const f32x4 qg = *(const f32x4*)(qn + 4 * (lane & 31)), kg = *(const f32x4*)(kn + 4 * (lane & 31));
    const float qs = 0.08838834764831845f * LOG2E;
    f32x4 xall[4][6];
#pragma unroll
    for (int i = 0; i < 4; ++i) { const bf16* pr = P + (size_t)(row0 + w * 4 + i) * NPRE + PB0;
#pragma unroll
        for (int j = 0; j < 6; ++j) xall[i][j] = ldb4(pr + j * 256 + 4 * lane); }
#pragma unroll
    for (int i = 0; i < 4; ++i) {
        const int r = w * 4 + i, row = row0 + r;
        f32x4 x[6];
#pragma unroll
        for (int j = 0; j < 6; ++j) x[j] = xall[i][j];
        float* ko; float* vo;
        if (!samp) { ko = a.out + O_KP + ((size_t)l * MP + row) * 512; vo = a.out + O_VP + ((size_t)l * MP + row) * 512; }
        else { ko = a.out + O_KS + ((size_t)l * MS + r) * 512; vo = a.out + O_VS + ((size_t)l * MS + r) * 512; }
#pragma unroll
        for (int j = 0; j < 4; ++j) {
            float ss = (x[j][0] * x[j][0] + x[j][1] * x[j][1]) + (x[j][2] * x[j][2] + x[j][3] * x[j][3]);
#pragma unroll
            for (int o = 1; o < 32; o <<= 1) ss += __shfl_xor(ss, o);
            const float rs = 1.0f / sqrtf(ss * (1.f / 128.f) + 1e-6f);
            if (j < 2) { const f32x4 y = x[j] * rs * qg * qs;
                if (!samp) *(u32x2*)(QB + (size_t)row * BW + j * 256 + 4 * lane) = (u32x2){pk2(y[0], y[1]), pk2(y[2], y[3])};
                else *(f32x4*)(QS + (size_t)r * BW + j * 256 + 4 * lane) = y; }
            else { const f32x4 y = x[j] * rs * kg; *(f32x4*)(ko + (j - 2) * 256 + 4 * lane) = y;
                if (!samp) *(u32x2*)(KB + (size_t)row * BW + (j - 2) * 256 + 4 * lane) = (u32x2){pk2(y[0], y[1]), pk2(y[2], y[3])}; }
        }
#pragma unroll
        for (int j = 4; j < 6; ++j) { *(f32x4*)(vo + (j - 4) * 256 + 4 * lane) = x[j];
            if (!samp) { LAS float* s = vs + r * 513 + (j - 4) * 256 + 4 * lane; s[0] = x[j][0]; s[1] = x[j][1]; s[2] = x[j][2]; s[3] = x[j][3]; } }
    }
    if (!samp) {
        LDS_WAIT(); __syncthreads();
        const int n = F.tid, b = row0 / SEQ, t0 = row0 % SEQ, h = n >> 7, d = n & 127;
        bf16* vp = VT + ((size_t)((b * 4 + h) * 128 + d)) * SEQ + t0;
#pragma unroll
        for (int c = 0; c < 4; ++c) { const LAS float* s = vs + (8 * c) * 513 + n;
            u32x4 o; o.x = pk2(s[0], s[513]); o.y = pk2(s[2 * 513], s[3 * 513]); o.z = pk2(s[4 * 513], s[5 * 513]); o.w = pk2(s[6 * 513], s[7 * 513]);
            *(u32x4*)(vp + 8 * c) = o; }
        LDS_WAIT(); __syncthreads();
    }
}
__device__ __forceinline__ void cprep_item(Frame& F, const Args& a, int l, int item, const bf16* P, unsigned char* ws) {
    const int lane = F.lane, w = F.wave, tid = F.tid; const bool samp = (item == 256); const int row0 = item * 32;
    LAS bf16* act = (LAS bf16*)F.lds;
    const float* mu = (const float*)a.in[19] + l * CSHIFT;
    const float* sh0 = (const float*)a.in[6] + (size_t)l * NSB * CSHIFT;
    {
        const int r = tid >> 4, cg = tid & 15, row = row0 + r;
        const bool first = samp ? ((r & 3) == 0) : ((row % SEQ) == 0);
        const bf16* pc = P + (size_t)row * NPRE + PC0 + 1536 + cg * 16;
        const float* ps = sh0 + (size_t)(r >> 2) * CSHIFT + 1536 + cg * 16;
        unsigned o[8];
#pragma unroll
        for (int j = 0; j < 4; ++j) {
            const f32x4 c = ldb4(pc + 4 * j); f32x4 p = first ? (samp ? *(const f32x4*)(ps + 4 * j) : (f32x4){0.f, 0.f, 0.f, 0.f}) : ldb4(pc - NPRE + 4 * j); const f32x4 m = *(const f32x4*)(mu + 1536 + cg * 16 + 4 * j);
            f32x4 x = c + (p - c) * m;
#pragma unroll
            for (int e = 0; e < 4; ++e) { if (cg < 4) x[e] = 1.0f - 2.0f * rcpf_(1.0f + ex2(2.0f * LOG2E * x[e])); else if (cg >= 8) x[e] = sigmoidf_(x[e]); }
            o[2 * j] = pk2(x[0], x[1]); o[2 * j + 1] = pk2(x[2], x[3]);
        }
        LAS u32x4* dst = (LAS u32x4*)(act + r * 264 + cg * 16);
        dst[0] = (u32x4){o[0], o[1], o[2], o[3]}; dst[1] = (u32x4){o[4], o[5], o[6], o[7]};
    }
    LDS_WAIT(); __syncthreads();
    const int li = lane & 15, q = lane >> 4;
    const bf16* lw = (const bf16*)(ws + WS_LW + l * SZ_LW);
    const float* w0 = (const float*)a.in[20] + l * 512; const float* a0 = (const float*)a.in[22] + l * 512;
    const float* k_k = (const float*)a.in[25] + l * 512; const float* k_a = (const float*)a.in[26] + l * 512; const float* r_k = (const float*)a.in[27] + l * 512;
    float* Rr = (float*)(ws + WS_R + l * SZ_RWL); float* Ww = (float*)(ws + WS_W + l * SZ_RWL); float* KX = (float*)(ws + WS_KX + l * SZ_RWL); float* Vv = (float*)(ws + WS_V);
    float* KK = (float*)(ws + WS_KK + l * SZ_RWL); float* KKA = (float*)(ws + WS_KKA + l * SZ_RWL); float* GG = (float*)(ws + WS_GG); float* RK = (float*)(ws + WS_RK);
    int lwo = (64 * w + li) * 256 + 8 * q, aco = li * 264 + 8 * q, c00 = 64 * w + 4 * q;
    asm volatile("" : "+v"(lwo), "+v"(aco), "+v"(c00));
    f32x4 xsv[2][4][3];
    int rows[2];
#define CPREP_LOAD_XS(mt) do { const int r = 16 * (mt) + li, row = row0 + r; rows[mt] = row; \
        const bool first = samp ? ((r & 3) == 0) : ((row % SEQ) == 0); \
        const bf16* pc = P + (size_t)row * NPRE + PC0; \
        const float* ps = sh0 + (size_t)(r >> 2) * CSHIFT; \
        _Pragma("unroll") for (int ct = 0; ct < 4; ++ct) _Pragma("unroll") for (int j = 0; j < 3; ++j) { const int c0 = c00 + 16 * ct; const f32x4 c = ldb4(pc + j * 512 + c0); \
            const f32x4 p = first ? (samp ? *(const f32x4*)(ps + j * 512 + c0) : (f32x4){0.f, 0.f, 0.f, 0.f}) : ldb4(pc - NPRE + j * 512 + c0); xsv[mt][ct][j] = c + (p - c) * *(const f32x4*)(mu + j * 512 + c0); } } while (0)
    CPREP_LOAD_XS(0);
    f32x4 aw[2][4], aa[2][4], ag[2][4];
#pragma unroll
    for (int mt = 0; mt < 2; ++mt)
#pragma unroll
        for (int ct = 0; ct < 4; ++ct) { aw[mt][ct] = (f32x4){0.f, 0.f, 0.f, 0.f}; aa[mt][ct] = aw[mt][ct]; ag[mt][ct] = aw[mt][ct]; }
#pragma unroll
    for (int hb = 0; hb < 4; ++hb) {
        bf16x8 af[2][4];
#pragma unroll
        for (int k2 = 0; k2 < 2; ++k2)
#pragma unroll
            for (int ct = 0; ct < 4; ++ct) af[k2][ct] = *(const bf16x8*)(lw + lwo + ct * 16 * 256 + 32 * (hb * 2 + k2));
#pragma unroll
        for (int k2 = 0; k2 < 2; ++k2) { const int ks = hb * 2 + k2;
#pragma unroll
            for (int mt = 0; mt < 2; ++mt) { const bf16x8 bfr = *(const LAS bf16x8*)(act + aco + mt * 16 * 264 + 32 * ks);
#pragma unroll
                for (int ct = 0; ct < 4; ++ct) {
                    if (ks < 2) aw[mt][ct] = __builtin_amdgcn_mfma_f32_16x16x32_bf16(af[k2][ct], bfr, aw[mt][ct], 0, 0, 0);
                    else if (ks < 4) aa[mt][ct] = __builtin_amdgcn_mfma_f32_16x16x32_bf16(af[k2][ct], bfr, aa[mt][ct], 0, 0, 0);
                    else ag[mt][ct] = __builtin_amdgcn_mfma_f32_16x16x32_bf16(af[k2][ct], bfr, ag[mt][ct], 0, 0, 0);
                } } }
        asm volatile("" ::: "memory");
    }
#pragma unroll
    for (int mt = 0; mt < 2; ++mt) {
        if (mt == 1) { asm volatile("" ::: "memory"); CPREP_LOAD_XS(1); }
        const int row = rows[mt];
        f32x4 kkv[4], av[4]; float ss = 0.f, rk = 0.f;
#pragma unroll
        for (int ct = 0; ct < 4; ++ct) {
            const int c0 = c00 + 16 * ct;
            f32x4 xs[3];
#pragma unroll
            for (int j = 0; j < 3; ++j) xs[j] = xsv[mt][ct][j];
            const f32x4 w0v = *(const f32x4*)(w0 + c0), a0v = *(const f32x4*)(a0 + c0), kkw = *(const f32x4*)(k_k + c0), kaw = *(const f32x4*)(k_a + c0), rkw = *(const f32x4*)(r_k + c0);
            f32x4 dec;
#pragma unroll
            for (int e = 0; e < 4; ++e) {
                const float x = -(w0v[e] + aw[mt][ct][e]);
                const float sp = fmaxf(x, 0.f) + 0.6931471805599453f * __builtin_amdgcn_logf(1.0f + ex2(-fabsf(x) * LOG2E));
                dec[e] = ex2(-LOG2E * ex2(LOG2E * (-sp - 0.5f)));
                av[ct][e] = sigmoidf_(a0v[e] + aa[mt][ct][e]);
            }
            kkv[ct] = xs[1] * kkw;
            const f32x4 kxv = xs[1] * (1.0f + (av[ct] - 1.0f) * kaw);
            ss += (kkv[ct][0] * kkv[ct][0] + kkv[ct][1] * kkv[ct][1]) + (kkv[ct][2] * kkv[ct][2] + kkv[ct][3] * kkv[ct][3]);
            const f32x4 t = xs[0] * kxv * rkw; rk += (t[0] + t[1]) + (t[2] + t[3]);
            const size_t o = (size_t)row * BW + c0;
            *(f32x4*)(Rr + o) = xs[0]; *(f32x4*)(Ww + o) = dec; *(f32x4*)(KX + o) = kxv; *(f32x4*)(Vv + o) = xs[2]; *(f32x4*)(GG + o) = ag[mt][ct];
        }
        ss += __shfl_xor(ss, 16); ss += __shfl_xor(ss, 32); rk += __shfl_xor(rk, 16); rk += __shfl_xor(rk, 32);
        const float rn = 1.0f / sqrtf(fmaxf(ss, 1e-24f));
#pragma unroll
        for (int ct = 0; ct < 4; ++ct) { const size_t o = (size_t)row * BW + c00 + 16 * ct; const f32x4 kk = kkv[ct] * rn; *(f32x4*)(KK + o) = kk; *(f32x4*)(KKA + o) = kk * av[ct]; }
        if (q == 0) RK[(size_t)row * 8 + w] = rk;
    }
#undef CPREP_LOAD_XS
    if (!samp) { if ((row0 + 32) % SEQ == 0) { const int b = row0 / SEQ; const bf16* src = P + (size_t)(row0 + 31) * NPRE + PC0; float* dst = a.out + O_SHP + (size_t)(l * 2 + b) * CSHIFT;
            for (int i = tid; i < CSHIFT; i += 512) dst[i] = __builtin_bit_cast(float, (unsigned)src[i] << 16); } }
    else { for (int i = tid; i < NSB * CSHIFT; i += 512) { const int sb = i / CSHIFT, c = i % CSHIFT; a.out[O_SHS + (size_t)(l * NSB + sb) * CSHIFT + c] = __builtin_bit_cast(float, (unsigned)P[(size_t)(MP + sb * 4 + 3) * NPRE + PC0 + c] << 16); } }
    __syncthreads();
}
__device__ __forceinline__ void dconv_item(Frame& F, const Args& a, int l, int item, const bf16* P, bf16* ACTD) {
    const int tid = F.tid, lane = F.lane, w = F.wave;
    LAS float* z = (LAS float*)F.lds;
    LAS float* red = (LAS float*)(F.lds + 62 * 512 * 4);
    const bool samp = item >= 256; const int sb = item - 256;
    const int rowbase = samp ? MP + sb * 4 : item * 32;
    const int t0 = samp ? 0 : (item * 32) % SEQ, ntok = samp ? 4 : 32;
    const float* conv0 = (const float*)a.in[7] + (size_t)(l * NSB + (samp ? sb : 0)) * 30 * 512;
    const int c = tid;
    const float* cw = (const float*)a.in[31] + (size_t)l * 31 * 512; const float cb = ((const float*)a.in[32])[l * 512 + c];
    const float lg = ((const float*)a.in[33])[l * 512 + c], lb = ((const float*)a.in[34])[l * 512 + c];
    float wv[31];
#pragma unroll
    for (int j = 0; j < 31; ++j) wv[j] = cw[j * 512 + c];
    {
        const int rs = tid >> 7, c4 = (tid & 127) * 4, nrow = 30 + ntok;
#pragma unroll
        for (int hb = 0; hb < 2; ++hb) {
            f32x4 va[8], ga[8];
#pragma unroll
            for (int jj = 0; jj < 8; ++jj) { const int i = rs + 4 * (hb * 8 + jj), t = t0 - 30 + i;
                va[jj] = (f32x4){0.f, 0.f, 0.f, 0.f}; ga[jj] = va[jj];
                if (i < nrow) {
                    if (t < 0) { if (samp) va[jj] = *(const f32x4*)(conv0 + (size_t)i * 512 + c4); }
                    else { const bf16* pr = P + (size_t)(rowbase - 30 + i) * NPRE + PD0 + c4; va[jj] = ldb4(pr); ga[jj] = ldb4(pr + 512); } } }
#pragma unroll
            for (int jj = 0; jj < 8; ++jj) { const int i = rs + 4 * (hb * 8 + jj), t = t0 - 30 + i;
                if (i < nrow) { f32x4 zv = va[jj];
                    if (t >= 0) { zv[0] *= sigmoidf_(ga[jj][0]); zv[1] *= sigmoidf_(ga[jj][1]); zv[2] *= sigmoidf_(ga[jj][2]); zv[3] *= sigmoidf_(ga[jj][3]); }
                    *(LAS f32x4*)(z + i * 512 + c4) = zv; } }
        }
    }
    LDS_WAIT(); __syncthreads();
    if (samp) { float* dst = a.out + O_CS + (size_t)(l * NSB + sb) * 30 * 512; for (int i = 0; i < 30; ++i) dst[(size_t)i * 512 + c] = z[(4 + i) * 512 + c]; }
    else if (t0 + 32 == SEQ) { float* dst = a.out + O_CP + (size_t)(l * 2 + (item * 32) / SEQ) * 30 * 512; for (int i = 0; i < 30; ++i) dst[(size_t)i * 512 + c] = z[(32 + i) * 512 + c]; }
    float y[32];
#pragma unroll
    for (int t = 0; t < 32; ++t) y[t] = cb;
#pragma unroll
    for (int i = 0; i < 62; ++i) {
        if (i < 30 + ntok) { const float zi = z[i * 512 + c];
#pragma unroll
            for (int t = 0; t < 32; ++t) { if (i - t >= 0 && i - t <= 30) y[t] = fmaf(zi, wv[i - t], y[t]); } }
    }
    {
        float u1[16], u2[16];
        { const bool hb = (lane & 32) != 0;
#pragma unroll
          for (int j = 0; j < 16; ++j) { const float ka = hb ? y[16 + j] : y[j], sa = hb ? y[j] : y[16 + j]; u1[j] = ka + __shfl_xor(sa, 32); u2[j] = ka * ka + __shfl_xor(sa * sa, 32); } }
        float v1[8], v2[8];
        { const bool hb = (lane & 16) != 0;
#pragma unroll
          for (int j = 0; j < 8; ++j) { v1[j] = (hb ? u1[8 + j] : u1[j]) + __shfl_xor(hb ? u1[j] : u1[8 + j], 16); v2[j] = (hb ? u2[8 + j] : u2[j]) + __shfl_xor(hb ? u2[j] : u2[8 + j], 16); } }
        float w1[4], w2[4];
        { const bool hb = (lane & 8) != 0;
#pragma unroll
          for (int j = 0; j < 4; ++j) { w1[j] = (hb ? v1[4 + j] : v1[j]) + __shfl_xor(hb ? v1[j] : v1[4 + j], 8); w2[j] = (hb ? v2[4 + j] : v2[j]) + __shfl_xor(hb ? v2[j] : v2[4 + j], 8); } }
        float x1[2], x2[2];
        { const bool hb = (lane & 4) != 0;
#pragma unroll
          for (int j = 0; j < 2; ++j) { x1[j] = (hb ? w1[2 + j] : w1[j]) + __shfl_xor(hb ? w1[j] : w1[2 + j], 4); x2[j] = (hb ? w2[2 + j] : w2[j]) + __shfl_xor(hb ? w2[j] : w2[2 + j], 4); } }
        float z1, z2;
        { const bool hb = (lane & 2) != 0; z1 = (hb ? x1[1] : x1[0]) + __shfl_xor(hb ? x1[0] : x1[1], 2); z2 = (hb ? x2[1] : x2[0]) + __shfl_xor(hb ? x2[0] : x2[1], 2); }
        z1 += __shfl_xor(z1, 1); z2 += __shfl_xor(z2, 1);
        const int trow = ((lane >> 5) & 1) * 16 + ((lane >> 4) & 1) * 8 + ((lane >> 3) & 1) * 4 + ((lane >> 2) & 1) * 2 + ((lane >> 1) & 1);
        if ((lane & 1) == 0) { red[(trow * 8 + w) * 2] = z1; red[(trow * 8 + w) * 2 + 1] = z2; }
    }
    LDS_WAIT(); __syncthreads();
    if (tid < 32) { float s1 = 0.f, s2 = 0.f;
#pragma unroll
        for (int j = 0; j < 8; ++j) { s1 += red[(tid * 8 + j) * 2]; s2 += red[(tid * 8 + j) * 2 + 1]; }
        const float mean = s1 * (1.f / 512.f), var = fmaxf(s2 * (1.f / 512.f) - mean * mean, 0.f);
        red[512 + tid * 2] = mean; red[512 + tid * 2 + 1] = 1.0f / sqrtf(var + 1e-5f); }
    LDS_WAIT(); __syncthreads();
#pragma unroll
    for (int t = 0; t < 32; ++t) { if (t < ntok) { const float v = (y[t] - red[512 + t * 2]) * red[512 + t * 2 + 1] * lg + lb; ACTD[(size_t)(rowbase + t) * BW + c] = (bf16)f2bf(v * sigmoidf_(v)); } }
    __syncthreads();
}

template <bool SK>
__device__ __forceinline__ void scan_task(const float* R, const float* W, const float* KX, const float* KK, const float* KKA, const float* V, float* OUT, float* STT, const float* S0, float* SOUT, int nstep, int lane) {
    float s[64];
    if (S0) {
#pragma unroll
        for (int k4 = 0; k4 < 16; ++k4) { const f32x4 v = *(const f32x4*)(S0 + lane * 64 + 4 * k4); s[4 * k4] = v[0]; s[4 * k4 + 1] = v[1]; s[4 * k4 + 2] = v[2]; s[4 * k4 + 3] = v[3]; }
    } else {
#pragma unroll
        for (int k = 0; k < 64; ++k) s[k] = SK ? 0.f : (k == lane ? 1.f : 0.f);
    }
    float pf0 = 0.f, pf1 = 0.f, pf2 = 0.f, pf3 = 0.f, pf4 = 0.f;
    for (int t = 0; t < nstep; ++t) {
        asm volatile("" :: "v"(pf0), "v"(pf1), "v"(pf2), "v"(pf3), "v"(pf4));
        { const int tp = (t + 2 < nstep) ? t + 2 : t; const size_t po = (size_t)tp * BW + lane;
          pf0 = KK[po]; pf1 = W[po]; pf2 = KKA[po]; pf3 = KX[po]; pf4 = R[po]; }
        cfloat* kk = (cfloat*)(KK + (size_t)t * BW); cfloat* w = (cfloat*)(W + (size_t)t * BW); cfloat* kka = (cfloat*)(KKA + (size_t)t * BW);
        cfloat* kx = (cfloat*)(KX + (size_t)t * BW); cfloat* r = (cfloat*)(R + (size_t)t * BW);
        float d0 = 0.f, d1 = 0.f;
#pragma unroll
        for (int k = 0; k < 64; k += 2) { d0 = fmaf(s[k], kk[k], d0); d1 = fmaf(s[k + 1], kk[k + 1], d1); }
        const float nd = -(d0 + d1);
        const float vt = SK ? V[(size_t)t * BW + lane] : 0.f;
        float o0 = 0.f, o1 = 0.f;
#pragma unroll
        for (int k = 0; k < 64; k += 2) {
            float x = s[k] * w[k]; x = fmaf(nd, kka[k], x); if (SK) x = fmaf(vt, kx[k], x); s[k] = x; o0 = fmaf(x, r[k], o0);
            float y = s[k + 1] * w[k + 1]; y = fmaf(nd, kka[k + 1], y); if (SK) y = fmaf(vt, kx[k + 1], y); s[k + 1] = y; o1 = fmaf(y, r[k + 1], o1);
        }
        OUT[(size_t)t * BW + lane] = o0 + o1;
    }
    asm volatile("" :: "v"(pf0), "v"(pf1), "v"(pf2), "v"(pf3), "v"(pf4));
    if (STT) {
#pragma unroll
        for (int k = 0; k < 64; ++k) STT[k * 64 + lane] = s[k];
    }
    if (SOUT) {
#pragma unroll
        for (int k4 = 0; k4 < 16; ++k4) *(f32x4*)(SOUT + lane * 64 + 4 * k4) = (f32x4){s[4 * k4], s[4 * k4 + 1], s[4 * k4 + 2], s[4 * k4 + 3]};
    }
}
__device__ __forceinline__ const float* uni_ptr(const float* p) { const unsigned long long v = (unsigned long long)p; const unsigned lo = __builtin_amdgcn_readfirstlane((unsigned)v), hi = __builtin_amdgcn_readfirstlane((unsigned)(v >> 32)); return (const float*)(((unsigned long long)hi << 32) | lo); }
__device__ __forceinline__ void scan_item(Frame& F, int l, int item, unsigned char* ws) {
    const int b = item >> 7, chunk = (item >> 1) & 63, hq = item & 1, h = hq * 4 + (F.wave & 3);
    const size_t ro = ((size_t)(b * SEQ + chunk * 64)) * BW + h * 64; const size_t so = ((size_t)((b * 8 + h) * 64 + chunk)) * 4096;
    const float* R = (const float*)(ws + WS_R + l * SZ_RWL) + ro; const float* W = (const float*)(ws + WS_W + l * SZ_RWL) + ro; const float* KX = (const float*)(ws + WS_KX + l * SZ_RWL) + ro;
    const float* KK = (const float*)(ws + WS_KK + l * SZ_RWL) + ro; const float* KKA = (const float*)(ws + WS_KKA + l * SZ_RWL) + ro; const float* V = (const float*)(ws + WS_V) + ro;
    if (F.wave >> 2) scan_task<true>(uni_ptr(R), uni_ptr(W), uni_ptr(KX), uni_ptr(KK), uni_ptr(KKA), V, (float*)(ws + WS_OL) + ro, (float*)(ws + WS_LC) + so, nullptr, nullptr, 64, F.lane);
    else scan_task<false>(uni_ptr(R), uni_ptr(W), uni_ptr(KX), uni_ptr(KK), uni_ptr(KKA), V, (float*)(ws + WS_PR) + ro, nullptr, nullptr, (float*)(ws + WS_PC) + so, 64, F.lane);
}
__device__ __forceinline__ void scan_sample_item(Frame& F, const Args& a, int l, int sb, unsigned char* ws) {
    const int h = F.wave; const size_t ro = ((size_t)(MP + sb * 4)) * BW + h * 64;
    const float* S0 = (const float*)a.in[5] + ((size_t)((l * NSB + sb) * 8 + h)) * 4096; float* SO = a.out + O_WS + ((size_t)((l * NSB + sb) * 8 + h)) * 4096;
    scan_task<true>(uni_ptr((const float*)(ws + WS_R + l * SZ_RWL) + ro), uni_ptr((const float*)(ws + WS_W + l * SZ_RWL) + ro), uni_ptr((const float*)(ws + WS_KX + l * SZ_RWL) + ro), uni_ptr((const float*)(ws + WS_KK + l * SZ_RWL) + ro), uni_ptr((const float*)(ws + WS_KKA + l * SZ_RWL) + ro),
                    (const float*)(ws + WS_V) + ro, (float*)(ws + WS_OL) + ro, nullptr, S0, SO, 4, F.lane);
}
__device__ __forceinline__ float4 ld4(const float* p) { return *(const float4*)p; }
__device__ __forceinline__ void decode_item(Frame& F, const Args& a, int l, int item, unsigned char* ws) {
    const int sb = item >> 6, seg = item & 63, lane = F.lane, w = F.wave, tid = F.tid;
    LAS float* OM = (LAS float*)F.lds; LAS float* BT = OM + 256 * 16; LAS float* SEGT = BT + 256 * 16;
    const float* QS = (const float*)(ws + WS_QS); const int* pt = (const int*)a.in[4] + sb * NPAGES;
    const float* ck = (const float*)a.in[2] + (size_t)l * NPHYS * 128 * 512; const float* cv = (const float*)a.in[3] + (size_t)l * NPHYS * 128 * 512;
    const float* bias = (const float*)a.in[17] + l * 4;
    f32x4 Qr[4][2];
#pragma unroll
    for (int qi = 0; qi < 4; ++qi)
#pragma unroll
        for (int g = 0; g < 2; ++g) Qr[qi][g] = *(const f32x4*)(QS + (size_t)(sb * 4 + qi) * BW + g * 256 + 4 * lane);
    const int page = pt[seg * 2 + (w >> 2)];
    const size_t rbase = ((size_t)page * 128 + (w & 3) * 32) * 512;
    const int b4 = (lane >> 4) & 1, b3 = (lane >> 3) & 1, b2 = (lane >> 2) & 1;
    const int vidx = b4 * 4 + b3 * 2 + b2, qi_m = vidx >> 1, head_m = (vidx & 1) * 2 + (lane >> 5);
    const float bias_m = bias[head_m] * LOG2E;
    {
        f32x4 ka[4][2], kb[4][2];
#define DEC_LOADK(dst, i0) do { asm volatile("" ::: "memory"); _Pragma("unroll") for (int u = 0; u < 4; ++u) { const float* kr = ck + rbase + (size_t)((i0) + u) * 512; dst[u][0] = __builtin_nontemporal_load((const f32x4*)(kr + 4 * lane)); dst[u][1] = __builtin_nontemporal_load((const f32x4*)(kr + 256 + 4 * lane)); } } while (0)
#define DEC_SCORE(src, i0) do { _Pragma("unroll") for (int u = 0; u < 4; ++u) { \
            float v[8]; \
            _Pragma("unroll") for (int qi = 0; qi < 4; ++qi) { const f32x4 p0 = src[u][0] * Qr[qi][0], p1 = src[u][1] * Qr[qi][1]; v[qi * 2] = (p0[0] + p0[1]) + (p0[2] + p0[3]); v[qi * 2 + 1] = (p1[0] + p1[1]) + (p1[2] + p1[3]); } \
            float r4[4], r2[2], r1; \
            _Pragma("unroll") for (int j = 0; j < 4; ++j) { const float snd = b4 ? v[j] : v[4 + j], kp = b4 ? v[4 + j] : v[j]; r4[j] = kp + __shfl_xor(snd, 16); } \
            _Pragma("unroll") for (int j = 0; j < 2; ++j) { const float snd = b3 ? r4[j] : r4[2 + j], kp = b3 ? r4[2 + j] : r4[j]; r2[j] = kp + __shfl_xor(snd, 8); } \
            { const float snd = b2 ? r2[0] : r2[1], kp = b2 ? r2[1] : r2[0]; r1 = kp + __shfl_xor(snd, 4); } \
            r1 += __shfl_xor(r1, 2); r1 += __shfl_xor(r1, 1); \
            const float e = ex2(r1 + bias_m), om = rcpf_(1.0f + e), bt = e * om; \
            if ((lane & 3) == 0) { const int kl = w * 32 + (i0) + u; OM[kl * 16 + qi_m * 4 + head_m] = om; BT[kl * 16 + qi_m * 4 + head_m] = bt; } } } while (0)
        DEC_LOADK(ka, 0); DEC_LOADK(kb, 4); DEC_SCORE(ka, 0); DEC_LOADK(ka, 8); DEC_SCORE(kb, 4); DEC_LOADK(kb, 12); DEC_SCORE(ka, 8); DEC_LOADK(ka, 16); DEC_SCORE(kb, 12); DEC_LOADK(kb, 20); DEC_SCORE(ka, 16); DEC_LOADK(ka, 24); DEC_SCORE(kb, 20); DEC_LOADK(kb, 28); DEC_SCORE(ka, 24); DEC_SCORE(kb, 28);
#undef DEC_LOADK
#undef DEC_SCORE
    }
    LDS_WAIT(); __syncthreads();
    {
        const int qh = tid & 15, sg = tid >> 4;
        float pr = 1.f;
#pragma unroll
        for (int j = 0; j < 8; ++j) pr *= OM[(sg * 8 + j) * 16 + qh];
        SEGT[sg * 16 + qh] = pr;
        LDS_WAIT(); __syncthreads();
        float suf = 1.f;
        for (int s2 = 31; s2 > sg; --s2) suf *= SEGT[s2 * 16 + qh];
#pragma unroll
        for (int j = 7; j >= 0; --j) { const int kl = sg * 8 + j; const float att = BT[kl * 16 + qh] * suf; suf *= OM[kl * 16 + qh]; BT[kl * 16 + qh] = att; }
        if (sg == 0) ((float*)(ws + WS_TSEG))[(size_t)(sb * 64 + seg) * 16 + qh] = suf;
    }
    LDS_WAIT(); __syncthreads();
    f32x4 O[4][2];
#pragma unroll
    for (int qi = 0; qi < 4; ++qi) { O[qi][0] = (f32x4){0.f, 0.f, 0.f, 0.f}; O[qi][1] = O[qi][0]; }
    const int hh = lane >> 5;
    {
        f32x4 va[4][2], vb[4][2];
#define DEC_LOADV(dst, i0) do { asm volatile("" ::: "memory"); _Pragma("unroll") for (int u = 0; u < 4; ++u) { const float* vr = cv + rbase + (size_t)((i0) + u) * 512; dst[u][0] = __builtin_nontemporal_load((const f32x4*)(vr + 4 * lane)); dst[u][1] = __builtin_nontemporal_load((const f32x4*)(vr + 256 + 4 * lane)); } } while (0)
#define DEC_ACC(src, i0) do { _Pragma("unroll") for (int u = 0; u < 4; ++u) { const int kl = w * 32 + (i0) + u; \
            _Pragma("unroll") for (int qi = 0; qi < 4; ++qi) { const float a0 = BT[kl * 16 + qi * 4 + hh], a1 = BT[kl * 16 + qi * 4 + 2 + hh]; O[qi][0] += src[u][0] * a0; O[qi][1] += src[u][1] * a1; } } } while (0)
        DEC_LOADV(va, 0); DEC_LOADV(vb, 4); DEC_ACC(va, 0); DEC_LOADV(va, 8); DEC_ACC(vb, 4); DEC_LOADV(vb, 12); DEC_ACC(va, 8); DEC_LOADV(va, 16); DEC_ACC(vb, 12); DEC_LOADV(vb, 20); DEC_ACC(va, 16); DEC_LOADV(va, 24); DEC_ACC(vb, 20); DEC_LOADV(vb, 28); DEC_ACC(va, 24); DEC_ACC(vb, 28);
#undef DEC_LOADV
#undef DEC_ACC
    }
    __syncthreads();
    LAS float* RED = (LAS float*)F.lds;
#pragma unroll
    for (int qi = 0; qi < 4; ++qi)
#pragma unroll
        for (int g = 0; g < 2; ++g) { LAS float* d = RED + ((w * 16 + qi * 4 + g * 2 + hh) * 128 + 4 * (lane & 31)); d[0] = O[qi][g][0]; d[1] = O[qi][g][1]; d[2] = O[qi][g][2]; d[3] = O[qi][g][3]; }
    LDS_WAIT(); __syncthreads();
    { f32x4 s = (f32x4){0.f, 0.f, 0.f, 0.f};
#pragma unroll
      for (int j = 0; j < 8; ++j) { const LAS float* p = RED + j * 2048 + tid * 4; s += (f32x4){p[0], p[1], p[2], p[3]}; }
      *(f32x4*)((float*)(ws + WS_OSEG) + (size_t)(sb * 64 + seg) * 2048 + tid * 4) = s; }
    __syncthreads();
}

__device__ __forceinline__ void attn_unit(Frame& F, int b, int h, int qt, int kb_lo, int nkb, const bf16* QB, const bf16* KB, const bf16* VT, bf16* OUT, float bias2, f32x4* part, float* tpart) {
    LAS bf16* Ks = (LAS bf16*)F.lds;
    LAS bf16* Vs = (LAS bf16*)(F.lds + 34816);
    const int w = F.wave, lane = F.lane, li = lane & 15, g = lane >> 4, tid = F.tid;
    const int q0 = qt * 128 + w * 16, qpos = q0 + li;
    bf16x8 qf[4];
    { const bf16* qp = QB + (size_t)(b * SEQ + qpos) * BW + h * 128 + 8 * g;
#pragma unroll
      for (int ks = 0; ks < 4; ++ks) qf[ks] = *(const bf16x8*)(qp + 32 * ks); }
    f32x4 oacc[8];
#pragma unroll
    for (int dt = 0; dt < 8; ++dt) oacc[dt] = (f32x4){0.f, 0.f, 0.f, 0.f};
    float carry = 1.f;
    const int kr0 = tid >> 4, kc0 = (tid & 15) * 8;
    const int vr0 = tid >> 3, vc0 = (tid & 7) * 8;
    const bf16* kg = KB + (size_t)(b * SEQ) * BW + h * 128 + kc0;
    const bf16* vg = VT + (size_t)((b * 4 + h) * 128) * SEQ + vc0;
    u32x4 lk[2], lv[2];
    { const int kb = kb_lo + nkb - 1;
      lk[0] = *(const u32x4*)(kg + (size_t)(kb * 64 + kr0) * BW); lk[1] = *(const u32x4*)(kg + (size_t)(kb * 64 + kr0 + 32) * BW);
      lv[0] = *(const u32x4*)(vg + (size_t)vr0 * SEQ + kb * 64); lv[1] = *(const u32x4*)(vg + (size_t)(vr0 + 64) * SEQ + kb * 64);
      *(LAS u32x4*)(Ks + kr0 * 136 + kc0) = lk[0]; *(LAS u32x4*)(Ks + (kr0 + 32) * 136 + kc0) = lk[1];
      *(LAS u32x4*)(Vs + vr0 * 72 + vc0) = lv[0]; *(LAS u32x4*)(Vs + (vr0 + 64) * 72 + vc0) = lv[1]; }
    LDS_WAIT(); __syncthreads();
    for (int it = 0; it < nkb; ++it) {
        const int kb = kb_lo + nkb - 1 - it, buf = it & 1; const bool more = (it + 1 < nkb);
        if (more) { const int k2 = kb - 1;
            lk[0] = *(const u32x4*)(kg + (size_t)(k2 * 64 + kr0) * BW); lk[1] = *(const u32x4*)(kg + (size_t)(k2 * 64 + kr0 + 32) * BW);
            lv[0] = *(const u32x4*)(vg + (size_t)vr0 * SEQ + k2 * 64); lv[1] = *(const u32x4*)(vg + (size_t)(vr0 + 64) * SEQ + k2 * 64); }
        if (kb * 64 < q0 + 15) {
            const LAS bf16* Kb = Ks + buf * (64 * 136); const LAS bf16* Vb = Vs + buf * (128 * 72);
            f32x4 s[4];
#pragma unroll
            for (int st = 0; st < 4; ++st) { s[st] = (f32x4){bias2, bias2, bias2, bias2};
#pragma unroll
                for (int ks = 0; ks < 4; ++ks) { const bf16x8 af = *(const LAS bf16x8*)(Kb + (16 * st + li) * 136 + 32 * ks + 8 * g); s[st] = __builtin_amdgcn_mfma_f32_16x16x32_bf16(af, qf[ks], s[st], 0, 0, 0); } }
            float om[4][4], bt[4][4], lt[4], X[4], GT[4];
            if (kb * 64 + 63 >= q0) {
                const int kbase = kb * 64 + 4 * g;
#pragma unroll
                for (int st = 0; st < 4; ++st)
#pragma unroll
                    for (int r = 0; r < 4; ++r) { const float e = ex2(s[st][r]); float o = rcpf_(1.0f + e), bb = e * o;
                        if (kbase + 16 * st + r >= qpos) { o = 1.f; bb = 0.f; }
                        om[st][r] = o; bt[st][r] = bb; }
            } else {
#pragma unroll
                for (int st = 0; st < 4; ++st)
#pragma unroll
                    for (int r = 0; r < 4; ++r) { const float e = ex2(s[st][r]); const float o = rcpf_(1.0f + e); om[st][r] = o; bt[st][r] = e * o; }
            }
#pragma unroll
            for (int st = 0; st < 4; ++st) {
                const float sp2 = om[st][3], sp1 = sp2 * om[st][2], sp0 = sp1 * om[st][1]; lt[st] = sp0 * om[st][0];
                bt[st][2] *= sp2; bt[st][1] *= sp1; bt[st][0] *= sp0;
                const float xa = __shfl_xor(lt[st], 16), xb = __shfl_xor(lt[st], 32), xc = __shfl_xor(lt[st], 48);
                X[st] = (g == 0) ? xa * xb * xc : (g == 1) ? xb * xc : (g == 2) ? xa : 1.f;
                GT[st] = lt[st] * xa * xb * xc;
            }
            const float Y3 = carry, Y2 = Y3 * GT[3], Y1 = Y2 * GT[2], Y0 = Y1 * GT[1];
            carry = Y0 * GT[0];
            const float f[4] = {Y0 * X[0], Y1 * X[1], Y2 * X[2], Y3 * X[3]};
            bf16x8 pf[2];
#pragma unroll
            for (int ks = 0; ks < 2; ++ks) { u32x4 pw; pw.x = pk2(bt[2 * ks][0] * f[2 * ks], bt[2 * ks][1] * f[2 * ks]); pw.y = pk2(bt[2 * ks][2] * f[2 * ks], bt[2 * ks][3] * f[2 * ks]);
                pw.z = pk2(bt[2 * ks + 1][0] * f[2 * ks + 1], bt[2 * ks + 1][1] * f[2 * ks + 1]); pw.w = pk2(bt[2 * ks + 1][2] * f[2 * ks + 1], bt[2 * ks + 1][3] * f[2 * ks + 1]); pf[ks] = __builtin_bit_cast(bf16x8, pw); }
#pragma unroll
            for (int dt = 0; dt < 8; ++dt)
#pragma unroll
                for (int ks = 0; ks < 2; ++ks) { const LAS bf16* vp = Vb + (16 * dt + li) * 72 + 32 * ks + 4 * g;
                    const u32x2 a0 = *(const LAS u32x2*)vp, a1 = *(const LAS u32x2*)(vp + 16); const u32x4 av = (u32x4){a0.x, a0.y, a1.x, a1.y};
                    oacc[dt] = __builtin_amdgcn_mfma_f32_16x16x32_bf16(__builtin_bit_cast(bf16x8, av), pf[ks], oacc[dt], 0, 0, 0); }
        }
        if (more) { const int nb = buf ^ 1;
            *(LAS u32x4*)(Ks + nb * (64 * 136) + kr0 * 136 + kc0) = lk[0]; *(LAS u32x4*)(Ks + nb * (64 * 136) + (kr0 + 32) * 136 + kc0) = lk[1];
            *(LAS u32x4*)(Vs + nb * (128 * 72) + vr0 * 72 + vc0) = lv[0]; *(LAS u32x4*)(Vs + nb * (128 * 72) + (vr0 + 64) * 72 + vc0) = lv[1]; }
        LDS_WAIT(); __syncthreads();
    }
    if (part) {
#pragma unroll
        for (int dt = 0; dt < 8; ++dt) part[(w * 8 + dt) * 64 + lane] = oacc[dt];
        if (tpart) tpart[w * 64 + lane] = carry;
    } else {
        bf16* op = OUT + (size_t)(b * SEQ + qpos) * BW + h * 128 + 4 * g;
#pragma unroll
        for (int dt = 0; dt < 8; ++dt) *(u32x2*)(op + 16 * dt) = (u32x2){pk2(oacc[dt][0], oacc[dt][1]), pk2(oacc[dt][2], oacc[dt][3])};
    }
}
__device__ __forceinline__ void attn_combine_item(Frame& F, int item, unsigned char* ws, bf16* OUT) {
    const int bh = item >> 4, q16 = item & 15, qt = 16 + q16, b = bh >> 2, h = bh & 3, w = F.wave, lane = F.lane, li = lane & 15, g = lane >> 4;
    const size_t base = (size_t)(bh * 16 + q16);
    const float* pl = (const float*)(ws + WS_OPART) + (base * 2 + 0) * 16384 + (size_t)(w * 8 * 64 + lane) * 4;
    const float* pr = (const float*)(ws + WS_OPART) + (base * 2 + 1) * 16384 + (size_t)(w * 8 * 64 + lane) * 4;
    const float t = ((const float*)(ws + WS_TPART))[base * 512 + w * 64 + lane];
    bf16* op = OUT + (size_t)(b * SEQ + qt * 128 + w * 16 + li) * BW + h * 128 + 4 * g;
#pragma unroll
    for (int dt = 0; dt < 8; ++dt) { const f32x4 a = *(const f32x4*)(pr + dt * 256), c = *(const f32x4*)(pl + dt * 256); const f32x4 o = a + c * t; *(u32x2*)(op + 16 * dt) = (u32x2){pk2(o[0], o[1]), pk2(o[2], o[3])}; }
}
#define CARRY_BAR() do { asm volatile("s_waitcnt lgkmcnt(0)" ::: "memory"); __builtin_amdgcn_s_barrier(); asm volatile("" ::: "memory"); } while (0)
__device__ __forceinline__ void carry_item(Frame& F, const Args& a, int l, int bh, unsigned char* ws) {
    const int lane = F.lane, w = F.wave, bi = w & 1, bj = (w >> 1) & 1, kh = w >> 2, l31 = lane & 31, hi = lane >> 5;
    LAS float* St = (LAS float*)F.lds;
    LAS float* Pp = (LAS float*)(F.lds + 16384);
    const float* PC = (const float*)(ws + WS_PC) + (size_t)bh * 64 * 4096; const float* LC = (const float*)(ws + WS_LC) + (size_t)bh * 64 * 4096; float* SS = (float*)(ws + WS_SS) + (size_t)bh * 64 * 4096;
    for (int i = F.tid; i < 4096; i += 512) { St[i] = 0.f; SS[i] = 0.f; }
    const int lo_p = (32 * kh + hi) * 64 + 32 * bi + l31, lo_s = (32 * kh + hi) * 64 + 32 * bj + l31, lo_o = (32 * bi + 4 * hi) * 64 + 32 * bj + l31;
    float afn[16], ltn[16];
#pragma unroll
    for (int kk2 = 0; kk2 < 16; ++kk2) afn[kk2] = PC[lo_p + kk2 * 128];
#pragma unroll
    for (int r = 0; r < 16; ++r) ltn[r] = (kh == 0) ? LC[lo_o + ((r & 3) + 8 * (r >> 2)) * 64] : 0.f;
    CARRY_BAR();
    for (int c = 0; c < 64; ++c) {
        float af[16], lt[16];
#pragma unroll
        for (int i = 0; i < 16; ++i) { af[i] = afn[i]; lt[i] = ltn[i]; }
        if (c < 63) {
            const float* Pn = PC + (size_t)(c + 1) * 4096; const float* Ln = LC + (size_t)(c + 1) * 4096;
#pragma unroll
            for (int kk2 = 0; kk2 < 16; ++kk2) afn[kk2] = Pn[lo_p + kk2 * 128];
            if (kh == 0) {
#pragma unroll
                for (int r = 0; r < 16; ++r) ltn[r] = Ln[lo_o + ((r & 3) + 8 * (r >> 2)) * 64];
            }
        }
        float bfv[16];
#pragma unroll
        for (int kk2 = 0; kk2 < 16; ++kk2) bfv[kk2] = St[lo_s + kk2 * 128];
        f32x16 acc0, acc1;
#pragma unroll
        for (int r = 0; r < 16; ++r) { acc0[r] = 0.f; acc1[r] = 0.f; }
#pragma unroll
        for (int kk2 = 0; kk2 < 16; kk2 += 2) { acc0 = __builtin_amdgcn_mfma_f32_32x32x2f32(af[kk2], bfv[kk2], acc0, 0, 0, 0); acc1 = __builtin_amdgcn_mfma_f32_32x32x2f32(af[kk2 + 1], bfv[kk2 + 1], acc1, 0, 0, 0); }
        if (kh == 1) {
#pragma unroll
            for (int r = 0; r < 16; ++r) Pp[(bj * 2 + bi) * 1024 + r * 64 + lane] = acc0[r] + acc1[r];
        }
        CARRY_BAR();
        if (kh == 0) {
            float* so = SS + (size_t)(c + 1) * 4096;
#pragma unroll
            for (int r = 0; r < 16; ++r) { const int jo = ((r & 3) + 8 * (r >> 2)) * 64;
                const float nv = (acc0[r] + acc1[r]) + Pp[(bj * 2 + bi) * 1024 + r * 64 + lane] + lt[r];
                St[lo_o + jo] = nv;
                if (c < 63) so[lo_o + jo] = nv;
                else { const int j = 32 * bi + (r & 3) + 8 * (r >> 2) + 4 * hi, v = 32 * bj + l31; a.out[O_WP + ((size_t)(l * 16 + bh)) * 4096 + v * 64 + j] = nv; } }
        }
        CARRY_BAR();
    }
}

__device__ __forceinline__ void fixup_item(Frame& F, const Args& a, int l, int item, unsigned char* ws, bf16* ACTC) {
    const int b = item >> 7, chunk = (item >> 1) & 63, h = (item & 1) * 4 + (F.wave >> 1), th = F.wave & 1, lane = F.lane, l31 = lane & 31, hi = lane >> 5;
    LAS float* pr = (LAS float*)(F.lds + F.wave * 8704);
    LAS float* stt = pr + 2080;
    const size_t ro = ((size_t)(b * SEQ + chunk * 64 + 32 * th)) * BW + h * 64;
    const float* PR = (const float*)(ws + WS_PR) + ro; const float* OL = (const float*)(ws + WS_OL) + ro;
    const float* St = (const float*)(ws + WS_SS) + ((size_t)((b * 8 + h) * 64 + chunk)) * 4096;
    f32x16 acc[2];
    const float gg = ((const float*)a.in[28])[l * 512 + h * 64 + lane], gb = ((const float*)a.in[29])[l * 512 + h * 64 + lane];
    const float* Vv = (const float*)(ws + WS_V) + ro; const float* GG = (const float*)(ws + WS_GG) + ro; const float* RK = (const float*)(ws + WS_RK) + ((size_t)(b * SEQ + chunk * 64 + 32 * th)) * 8 + h;
    float b0[32], b1[32];
    {
        float prv[32];
#pragma unroll
        for (int t = 0; t < 32; ++t) prv[t] = PR[(size_t)t * BW + lane];
#pragma unroll
        for (int vj = 0; vj < 2; ++vj)
#pragma unroll
            for (int r = 0; r < 16; ++r) acc[vj][r] = OL[(size_t)((r & 3) + 8 * (r >> 2) + 4 * hi) * BW + 32 * vj + l31];
        if (chunk > 0) {
#pragma unroll
            for (int j = 0; j < 32; ++j) { const int m = 2 * j + hi; b0[j] = St[m * 64 + l31]; b1[j] = St[m * 64 + 32 + l31]; }
        }
#pragma unroll
        for (int t = 0; t < 32; ++t) pr[t * 65 + lane] = prv[t];
    }
    LDS_WAIT();
    if (chunk > 0) {
#pragma unroll
        for (int j = 0; j < 32; ++j) { const int m = 2 * j + hi; const float a0 = pr[l31 * 65 + m];
            acc[0] = __builtin_amdgcn_mfma_f32_32x32x2f32(a0, b0[j], acc[0], 0, 0, 0); acc[1] = __builtin_amdgcn_mfma_f32_32x32x2f32(a0, b1[j], acc[1], 0, 0, 0); }
    }
    float vv[32], gv[32], rk[32];
#pragma unroll
    for (int t = 0; t < 32; ++t) { vv[t] = Vv[(size_t)t * BW + lane]; gv[t] = GG[(size_t)t * BW + lane]; rk[t] = RK[(size_t)t * 8]; }
#pragma unroll
    for (int vj = 0; vj < 2; ++vj)
#pragma unroll
        for (int r = 0; r < 16; ++r) pr[((r & 3) + 8 * (r >> 2) + 4 * hi) * 65 + 32 * vj + l31] = acc[vj][r];
    LDS_WAIT();
    if (lane < 32) { float s1 = 0.f;
#pragma unroll 16
        for (int v = 0; v < 64; ++v) s1 += pr[lane * 65 + v];
        const float mean = s1 * (1.f / 64.f); float s2 = 0.f;
#pragma unroll 16
        for (int v = 0; v < 64; ++v) { const float d = pr[lane * 65 + v] - mean; s2 = fmaf(d, d, s2); }
        stt[lane * 2] = mean; stt[lane * 2 + 1] = 1.0f / sqrtf(s2 * (1.f / 64.f) + 64e-5f); }
    LDS_WAIT();
    bf16* op = ACTC + (size_t)(b * SEQ + chunk * 64 + 32 * th) * BW + h * 64 + lane;
#pragma unroll
    for (int t = 0; t < 32; ++t) {
        const float y = ((pr[t * 65 + lane] - stt[t * 2]) * stt[t * 2 + 1] * gg + gb + rk[t] * vv[t]) * gv[t];
        op[(size_t)t * BW] = (bf16)f2bf(y); }
    LDS_WAIT();
}
__device__ __forceinline__ void cpost_sample_item(Frame& F, const Args& a, int l, int part, unsigned char* ws, bf16* ACTC) {
    const int h = F.wave, lane = F.lane;
    const float gg = ((const float*)a.in[28])[l * 512 + h * 64 + lane], gb = ((const float*)a.in[29])[l * 512 + h * 64 + lane];
    float xo[8], vv[8], gv[8], rk[8];
#pragma unroll
    for (int j = 0; j < 8; ++j) { const int r = part * 8 + j; const size_t o = (size_t)(MP + r) * BW + h * 64 + lane;
        xo[j] = ((const float*)(ws + WS_OL))[o]; vv[j] = ((const float*)(ws + WS_V))[o]; gv[j] = ((const float*)(ws + WS_GG))[o]; rk[j] = ((const float*)(ws + WS_RK))[(size_t)(MP + r) * 8 + h]; }
#pragma unroll
    for (int j = 0; j < 8; ++j) { const int r = part * 8 + j; const size_t o = (size_t)(MP + r) * BW + h * 64 + lane;
        float x = xo[j];
        const float mean = wave_sum(x) * (1.f / 64.f); x -= mean;
        const float rstd = 1.0f / sqrtf(wave_sum(x * x) * (1.f / 64.f) + 64e-5f);
        ACTC[o] = (bf16)f2bf((x * rstd * gg + gb + rk[j] * vv[j]) * gv[j]); }
}
__device__ __forceinline__ void decode_combine_item(Frame& F, const Args& a, int l, int qi, unsigned char* ws, bf16* ACTB) {
    const int sb = F.wave, lane = F.lane, hh = lane >> 5;
    const float* QS = (const float*)(ws + WS_QS); const float* OSEG = (const float*)(ws + WS_OSEG); const float* TSEG = (const float*)(ws + WS_TSEG);
    const float* bias = (const float*)a.in[17] + l * 4; const float bz[2] = {bias[hh] * LOG2E, bias[2 + hh] * LOG2E};
    const float* kn = a.out + O_KS + ((size_t)l * MS + sb * 4) * 512; const float* vn = a.out + O_VS + ((size_t)l * MS + sb * 4) * 512;
    float one = 1.f; asm volatile("" : "+v"(one));
    f32x4 O[2] = {(f32x4){0.f, 0.f, 0.f, 0.f}, (f32x4){0.f, 0.f, 0.f, 0.f}}; float carry[2] = {one, one};
    f32x4 q[2];
#pragma unroll
    for (int g = 0; g < 2; ++g) q[g] = *(const f32x4*)(QS + (size_t)(sb * 4 + qi) * BW + g * 256 + 4 * lane);
    for (int j = qi - 1; j >= 0; --j) {
#pragma unroll
        for (int g = 0; g < 2; ++g) {
            const f32x4 kv = *(const f32x4*)(kn + (size_t)j * 512 + g * 256 + 4 * lane), p = kv * q[g];
            float d = (p[0] + p[1]) + (p[2] + p[3]);
#pragma unroll
            for (int o = 1; o < 32; o <<= 1) d += __shfl_xor(d, o);
            const float e = ex2(d + bz[g]), om = rcpf_(1.0f + e), att = e * om * carry[g];
            O[g] += *(const f32x4*)(vn + (size_t)j * 512 + g * 256 + 4 * lane) * att; carry[g] *= om;
        }
    }
#pragma unroll 1
    for (int hs = 1; hs >= 0; --hs) {
        float tv[2][32];
#pragma unroll
        for (int g = 0; g < 2; ++g)
#pragma unroll
            for (int sg = 0; sg < 32; ++sg) tv[g][sg] = TSEG[(size_t)(sb * 64 + hs * 32 + sg) * 16 + qi * 4 + g * 2 + hh];
#pragma unroll
        for (int g = 0; g < 2; ++g) { float c = carry[g];
#pragma unroll
            for (int sg = 31; sg >= 0; --sg) { const float t = tv[g][sg]; tv[g][sg] = c; c *= t; }
            carry[g] = c; }
#pragma unroll
        for (int sb8 = 0; sb8 < 4; ++sb8) {
            f32x4 ov[2][8];
#pragma unroll
            for (int g = 0; g < 2; ++g)
#pragma unroll
                for (int j = 0; j < 8; ++j) { const int seg = hs * 32 + sb8 * 8 + j; ov[g][j] = *(const f32x4*)(OSEG + ((size_t)(sb * 64 + seg) * 16 + qi * 4 + g * 2 + hh) * 128 + 4 * (lane & 31)); }
#pragma unroll
            for (int g = 0; g < 2; ++g)
#pragma unroll
                for (int j = 0; j < 8; ++j) O[g] += ov[g][j] * tv[g][sb8 * 8 + j];
        }
    }
    bf16* op = ACTB + (size_t)(MP + sb * 4 + qi) * BW;
#pragma unroll
    for (int g = 0; g < 2; ++g) *(u32x2*)(op + g * 256 + 4 * lane) = (u32x2){pk2(O[g][0], O[g][1]), pk2(O[g][2], O[g][3])};
}

template <int MODE>
__device__ __forceinline__ void skinny_rows(Frame& F, const bf16* A, size_t sA, const bf16* Bt, size_t sB, int K, const bf16* G, bf16* MB, const float* res, float* out, bf16* Hn, const float* gn, float* rs) {
    constexpr int NBR = (MODE == 0) ? 4 : 1;
    const int u = F.vcu; if (u >= 256) return;
    const int rt = u & 1, ct = u >> 1, lane = F.lane, li = lane & 15, q = lane >> 4, w = F.wave;
    LAS f32x4* red = (LAS f32x4*)F.lds;
    f32x4 acc[NBR];
    const int nks = K / 32;
#pragma unroll
    for (int b = 0; b < NBR; ++b) {
        acc[b] = (f32x4){0.f, 0.f, 0.f, 0.f};
        const bf16* ap = A + (size_t)b * sA + (size_t)(MP + 16 * rt + li) * K + 8 * q;
        const bf16* bp = Bt + (size_t)b * sB + (size_t)(16 * ct + li) * K + 8 * q;
#pragma unroll 4
        for (int ks = w; ks < nks; ks += 8) {
            const bf16x8 av = *(const bf16x8*)(ap + 32 * ks), bv = *(const bf16x8*)(bp + 32 * ks);
            acc[b] = __builtin_amdgcn_mfma_f32_16x16x32_bf16(bv, av, acc[b], 0, 0, 0);
        }
        red[(w * NBR + b) * 64 + lane] = acc[b];
    }
    LDS_WAIT(); __syncthreads();
    if (w == 0) {
        const int row = MP + 16 * rt + li, col = 16 * ct + 4 * q;
        f32x4 tot = (f32x4){0.f, 0.f, 0.f, 0.f};
#pragma unroll
        for (int b = 0; b < NBR; ++b) {
            f32x4 v = red[b * 64 + lane];
#pragma unroll
            for (int j = 1; j < 8; ++j) v += red[(j * NBR + b) * 64 + lane];
            if (MODE == 0) { const u32x2 gw = *(const u32x2*)(G + (size_t)row * NGATE + (size_t)b * D + col);
                const f32x4 gf = (f32x4){__builtin_bit_cast(float, gw.x << 16), __builtin_bit_cast(float, gw.x & 0xffff0000u), __builtin_bit_cast(float, gw.y << 16), __builtin_bit_cast(float, gw.y & 0xffff0000u)};
                tot += v * gf; }
            else tot += v;
        }
        if (MODE == 0) *(u32x2*)(MB + (size_t)row * D + col) = (u32x2){pk2(tot[0], tot[1]), pk2(tot[2], tot[3])};
        else { const f32x4 v = *(const f32x4*)(res + (size_t)(row - MP) * D + col) + tot; *(f32x4*)(out + (size_t)(row - MP) * D + col) = v;
            if (Hn) { const f32x4 h = v * *(const f32x4*)(gn + col); *(u32x2*)(Hn + (size_t)row * D + col) = (u32x2){pk2(h[0], h[1]), pk2(h[2], h[3])};
                float ss = (v[0] * v[0] + v[1] * v[1]) + (v[2] * v[2] + v[3] * v[3]); ss += __shfl_xor(ss, 16); ss += __shfl_xor(ss, 32);
                if (q == 0) (void)__hip_atomic_fetch_add(rs + row, ss, __ATOMIC_RELAXED, __HIP_MEMORY_SCOPE_AGENT); } }
    }
    __syncthreads();
}

constexpr int NPH = 1 + NL * 11;
__global__ void __launch_bounds__(512, 2) mk_fwd(Args args) {
    extern __shared__ __attribute__((aligned(16))) unsigned char lds_raw[];
    Frame F; F.lds = (LAS unsigned char*)lds_raw; F.tid = threadIdx.x; F.lane = F.tid & 63; F.wave = __builtin_amdgcn_readfirstlane(F.tid >> 6);
    F.G = gridDim.x; { const int bx = blockIdx.x; F.vcu = (F.G % 8 == 0) ? (bx % 8) * (F.G / 8) + bx / 8 : bx; }
    unsigned char* ws = args.ws;
    volatile LAS unsigned* MISC = (volatile LAS unsigned*)(F.lds + LDS_CTL_OFF);
    for (int u = F.tid; u < (LDS_BYTES - LDS_CTL_OFF) / 4; u += 512) ((LAS unsigned*)(F.lds + LDS_CTL_OFF))[u] = 0u;
    __syncthreads();
    const bool single = (args.ph_hi - args.ph_lo) > 1;
    XcdBarrier bar; bar.bar = (unsigned*)(ws + WS_CTL) + CW_BAR; bar.x = 0; bar.st = nullptr;
    if (single) bar = xcd_barrier_post((unsigned*)(ws + WS_CTL) + CW_BAR, MISC + 8);
    const int lo = args.ph_lo, hi = args.ph_hi; const int sel = args.li ? args.li : 0xff;
#ifndef PH_MASK
#define PH_MASK 0xFFFu
#endif
#define IN(k) (lo <= (k) && (k) < hi)
#define EN(x) (((PH_MASK) >> (x)) & 1u)
#define SEAM(k) do { if (IN(k) && IN((k) + 1)) xcd_barrier(bar); } while (0)

#define PH_PTRS unsigned char* wsp = ws; int lp = l; asm volatile("" : "+s"(wsp), "+s"(lp)); Frame Fp = F; asm volatile("" : "+v"(Fp.tid), "+v"(Fp.lane), "+s"(Fp.wave), "+s"(Fp.vcu)); \
    bf16* H = (bf16*)(wsp + WS_H); bf16* P = (bf16*)(wsp + WS_P); bf16* G = (bf16*)(wsp + WS_G); bf16* ACT = (bf16*)(wsp + WS_ACT); float* MF = (float*)(wsp + WS_MF); bf16* MB = (bf16*)(wsp + WS_MB); \
    float* X1 = (float*)(wsp + WS_X1); bf16* HID = (bf16*)(wsp + WS_HID); float* XL = (float*)(wsp + WS_XL); bf16* QB = (bf16*)(wsp + WS_QB); bf16* KB = (bf16*)(wsp + WS_KB); bf16* VT = (bf16*)(wsp + WS_VT); float* QS = (float*)(wsp + WS_QS); \
    (void)H; (void)P; (void)G; (void)ACT; (void)MF; (void)MB; (void)X1; (void)HID; (void)XL; (void)QB; (void)KB; (void)VT; (void)QS;

    if (IN(0) && EN(11)) { const int l = 0; PH_PTRS; p0_convert(Fp, args); norm_phase(Fp, (const float*)args.in[0], (const float*)args.in[1], (const float*)args.in[8], H); }
    SEAM(0);
    for (int l = 0; l < NL; ++l) {
        const int pb = 1 + l * 11;
        if (IN(pb + 0) && EN(0)) { PH_PTRS;
            pg8::Gemm g{H, (const bf16*)(wsp + WS_WIN + lp * SZ_WIN), MPAD, INW, D, 0, 0}; pg8::StaticOrder S; S.init(MPAD, INW, F.G, (int)blockIdx.x);
            pg8::EpiIn E{P, G, lp > 0 ? (const float*)((unsigned*)(wsp + WS_CTL) + CW_RS + ((lp - 1) * 2 + 1) * MPAD) : nullptr};
            pg8::gemm_phase<pg8::EpiIn, pg8::StaticOrder, true>(Fp.tid, Fp.lds, g, S, E);
        }
        SEAM(pb + 0);
        if (IN(pb + 1) && EN(1)) {
            constexpr int N_C = 257, N_A = 257, N_D = 264, N_B = 257;
            unsigned* qctr = (unsigned*)(ws + WS_CTL) + CW_Q + 64 * (l * 16 + 0);
            volatile LAS int* qslot = (volatile LAS int*)(F.lds + LDS_CTL_OFF + 64);
            int it = F.vcu;
            while (it < N_C + N_A + N_D + N_B) {
                int nx = 0; if (F.tid == 0) nx = 256 + (int)__hip_atomic_fetch_add(qctr, 1u, __ATOMIC_RELAXED, __HIP_MEMORY_SCOPE_AGENT);
                int r = it; PH_PTRS;
                if (r < N_C) { if (sel & 1) cprep_item(Fp, args, lp, r, P, wsp); }
                else if ((r -= N_C) < N_A) { if (sel & 4) { if (r < 256) gmlp_item(Fp, args, lp, r >> 2, r & 3, P, ACT); else gmlp_sample_item(Fp, args, lp, P, ACT); } }
                else if ((r -= N_A) < N_D) { if (sel & 2) dconv_item(Fp, args, lp, r, P, ACT + (size_t)3 * MPAD * BW); }
                else { r -= N_D; if (sel & 8) bprep_item(Fp, args, lp, r, P, QB, KB, VT, QS); }
                if (F.tid == 0) *qslot = nx;
                __syncthreads(); it = __builtin_amdgcn_readfirstlane(*qslot); __syncthreads();
            }
        }
        SEAM(pb + 1);
        if (IN(pb + 2) && EN(2)) {
            for (int it = F.vcu; it < 256 + 8; it += F.G) {
                PH_PTRS;
                if (it < 256) { if (sel & 1) scan_item(Fp, lp, it, wsp); }
                else if (sel & 1) scan_sample_item(Fp, args, lp, it - 256, wsp);
            }
        }
        SEAM(pb + 2);
        if (IN(pb + 3) && EN(3)) {
            const int u = F.vcu;
            if (u < 256) {
                { PH_PTRS; const int bh = u >> 5, qt = u & 31; if (qt < 2 && (sel & 1)) carry_item(Fp, args, lp, bh * 2 + qt, wsp); }
                {
                    unsigned* actr = (unsigned*)(ws + WS_CTL) + CW_Q + 64 * (l * 16 + 2 + (u >> 5));
                    volatile LAS int* qslot = (volatile LAS int*)(F.lds + LDS_CTL_OFF + 64);
                    for (;;) {
                        if (F.tid == 0) *qslot = (int)__hip_atomic_fetch_add(actr, 1u, __ATOMIC_RELAXED, __HIP_MEMORY_SCOPE_AGENT);
                        __syncthreads(); const int qi = __builtin_amdgcn_readfirstlane(*qslot); __syncthreads();
                        if (qi >= 112) break;
                        const int blk = qi / 7, pos = qi % 7;
                        PH_PTRS; const int bh = u >> 5;
                        if (pos == 0 || pos == 3 || pos == 5) {
                            if (!(sel & 2)) continue;
                            const int pi = 3 * blk + (pos == 0 ? 0 : pos == 3 ? 1 : 2);
                            const float b2 = ((const float*)args.in[17])[lp * 4 + (bh & 3)] * LOG2E;
                            bf16* AO = ACT + (size_t)1 * MPAD * BW;
                            int qt, kb_lo, nkb; f32x4* part = nullptr; float* tp = nullptr;
                            if (pi < 8) { qt = 15 - pi; kb_lo = 0; nkb = 2 * qt + 2; }
                            else if (pi >= 40) { qt = 47 - pi; kb_lo = 0; nkb = 2 * qt + 2; }
                            else { qt = 31 - ((pi - 8) >> 1); const int right = (pi - 8) & 1, q16 = qt - 16; kb_lo = right ? qt + 1 : 0; nkb = qt + 1;
                                part = (f32x4*)(wsp + WS_OPART) + ((size_t)((bh * 16 + q16) * 2 + right)) * 4096;
                                if (right) tp = (float*)(wsp + WS_TPART) + (size_t)(bh * 16 + q16) * 512; }
                            attn_unit(Fp, bh >> 2, bh & 3, qt, kb_lo, nkb, QB, KB, VT, AO, b2, part, tp);
                        } else {
                            if (!(sel & 4)) continue;
                            const int di = 4 * blk + (pos == 1 ? 0 : pos == 2 ? 1 : pos == 4 ? 2 : 3);
                            decode_item(Fp, args, lp, bh * 64 + di, wsp);
                        }
                    }
                }
            }
        }
        SEAM(pb + 3);
        if (IN(pb + 4) && EN(4)) {
            for (int it = F.vcu; it < 256 + 8; it += F.G) {
                PH_PTRS;
                if (it < 256) { fixup_item(Fp, args, lp, it, wsp, ACT + (size_t)2 * MPAD * BW); __syncthreads(); }
                else if (it < 260) cpost_sample_item(Fp, args, lp, it - 256, wsp, ACT + (size_t)2 * MPAD * BW);
                else decode_combine_item(Fp, args, lp, it - 260, wsp, ACT + (size_t)1 * MPAD * BW);
            }
            { const int ci = 255 - F.vcu; if (ci < 128) { PH_PTRS; attn_combine_item(Fp, ci, wsp, ACT + (size_t)1 * MPAD * BW); } }
        }
        SEAM(pb + 4);
        if (IN(pb + 5) && EN(5)) { PH_PTRS;
            pg8::Gemm g{ACT, (const bf16*)(wsp + WS_WBO + lp * SZ_WBO), MP, D, BW, (size_t)MPAD * BW, (size_t)D * BW}; pg8::MergeOrder S; S.so.initn(MP / 256, D / 128, F.G, (int)blockIdx.x);
            pg8::EpiMerge E{G, MB};
            pg8::gemm_phase<pg8::EpiMerge, pg8::MergeOrder, true, 1>(Fp.tid, Fp.lds, g, S, E);
            skinny_rows<0>(Fp, ACT, (size_t)MPAD * BW, (const bf16*)(wsp + WS_WBO + lp * SZ_WBO), (size_t)D * BW, BW, G, MB, nullptr, nullptr, nullptr, nullptr, nullptr);
        }
        SEAM(pb + 5);
        if (IN(pb + 6) && EN(6)) { PH_PTRS;
            const float* xin0 = lp == 0 ? (const float*)args.in[0] : XL; const float* xin1 = lp == 0 ? (const float*)args.in[1] : XL + (size_t)MP * D;
            pg8::Gemm g{MB, (const bf16*)(wsp + WS_WMIX + lp * SZ_WMIX), MP, D, D, 0, 0}; pg8::StaticOrder S; S.init(MP, D, F.G, (int)blockIdx.x);
            float* rsp = (float*)((unsigned*)(wsp + WS_CTL) + CW_RS + (lp * 2 + 0) * MPAD); const float* gnp = (const float*)args.in[37] + lp * D;
            pg8::EpiRes E{xin0, X1, H, gnp, rsp};
            pg8::gemm_phase<pg8::EpiRes, pg8::StaticOrder, true>(Fp.tid, Fp.lds, g, S, E);
            skinny_rows<1>(Fp, MB, 0, (const bf16*)(wsp + WS_WMIX + lp * SZ_WMIX), 0, D, nullptr, nullptr, xin1, X1 + (size_t)MP * D, H, gnp, rsp);
        }
        SEAM(pb + 6);
        if (IN(pb + 8) && EN(8)) { PH_PTRS;
            pg8::Gemm g{H, (const bf16*)(wsp + WS_WGU + lp * SZ_WGU), MPAD, 2 * FF, D, 0, 0}; pg8::StaticOrder S; S.init(MPAD, 2 * FF, F.G, (int)blockIdx.x);
            pg8::EpiGU E{HID, (const float*)((unsigned*)(wsp + WS_CTL) + CW_RS + (lp * 2 + 0) * MPAD)};
            pg8::gemm_phase<pg8::EpiGU, pg8::StaticOrder, true>(Fp.tid, Fp.lds, g, S, E);
        }
        SEAM(pb + 8);
        if (IN(pb + 9) && EN(9)) { PH_PTRS;
            float* yout = lp == NL - 1 ? args.out + O_Y : XL;
            pg8::Gemm g{HID, (const bf16*)(wsp + WS_WDN + lp * SZ_WDN), MP, D, FF, 0, 0}; pg8::StaticOrder S; S.init(MP, D, F.G, (int)blockIdx.x);
            const bool nxt = lp + 1 < NL; float* rsp = (float*)((unsigned*)(wsp + WS_CTL) + CW_RS + (lp * 2 + 1) * MPAD); const float* gnp = (const float*)args.in[8] + (nxt ? lp + 1 : 0) * D;
            pg8::EpiRes E{X1, yout, nxt ? H : nullptr, gnp, rsp};
            pg8::gemm_phase<pg8::EpiRes, pg8::StaticOrder, true>(Fp.tid, Fp.lds, g, S, E);
            skinny_rows<1>(Fp, HID, 0, (const bf16*)(wsp + WS_WDN + lp * SZ_WDN), 0, FF, nullptr, nullptr, X1 + (size_t)MP * D, yout + (size_t)MP * D, nxt ? H : nullptr, gnp, rsp);
        }
        if (l + 1 < NL) SEAM(pb + 9);
    }
#undef IN
#undef SEAM
}

#ifndef MK_PER_PHASE
#define MK_PER_PHASE 0
#endif
extern "C" void kernel_launch(void* const* d_in, const int* in_sizes, int n_in, void* d_out, int out_size, void* d_ws, size_t ws_size, hipStream_t stream) {
    static int grid = 0;
    if (grid == 0) {
        if (n_in != 41 || (size_t)out_size != O_END || ws_size < WS_END) { fprintf(stderr, "kernel_launch: unexpected shapes: n_in %d out %d ws %zu (need %zu)\n", n_in, out_size, ws_size, (size_t)WS_END); grid = -1; return; }
        int dev = 0, cus = 0, per_cu = 0;
        if (hipGetDevice(&dev) != hipSuccess || hipDeviceGetAttribute(&cus, hipDeviceAttributeMultiprocessorCount, dev) != hipSuccess) { grid = -1; return; }
        if (hipFuncSetAttribute((const void*)mk_fwd, hipFuncAttributeMaxDynamicSharedMemorySize, LDS_BYTES) != hipSuccess) { fprintf(stderr, "kernel_launch: hipFuncSetAttribute failed\n"); grid = -1; return; }
        if (hipOccupancyMaxActiveBlocksPerMultiprocessor(&per_cu, (const void*)mk_fwd, 512, LDS_BYTES) != hipSuccess || per_cu < 1) fprintf(stderr, "kernel_launch: occupancy query reports %d\n", per_cu);
        (void)hipGetLastError();
        grid = cus;
        if (grid != 256) fprintf(stderr, "kernel_launch: %d CUs (built for 256)\n", grid);
    }
    if (grid < 0) return;
    (void)hipMemsetAsync((char*)d_ws + WS_CTL, 0, CTL_BYTES, stream);
    Args a{};
    for (int i = 0; i < 41; ++i) a.in[i] = d_in[i];
    a.out = (float*)d_out; a.ws = (unsigned char*)d_ws; a.li = 0; a.pad = 0;
#ifndef MAX_PH
#define MAX_PH NPH
#endif
#if MK_PER_PHASE
    for (int p = 0; p < MAX_PH; ++p) { a.ph_lo = p; a.ph_hi = p + 1; hipLaunchKernelGGL(mk_fwd, dim3(grid), dim3(512), LDS_BYTES, stream, a); }
#else
    a.ph_lo = 0; a.ph_hi = MAX_PH;
    hipLaunchKernelGGL(mk_fwd, dim3(grid), dim3(512), LDS_BYTES, stream, a);
#endif
#ifdef PROBE_PH
    for (int r = 0; r < PROBE_N; ++r) { a.ph_lo = (PROBE_PH < 0) ? 0 : 1 + (NL - 1) * 11 + PROBE_PH; a.ph_hi = a.ph_lo + 1; a.li = PROBE_SEL; hipLaunchKernelGGL(mk_fwd, dim3(grid), dim3(512), LDS_BYTES, stream, a); }
#endif
    const hipError_t le = hipPeekAtLastError();
    if (le != hipSuccess) fprintf(stderr, "kernel_launch: launch failed: %s\n", hipGetErrorName(le));
}
```

```cpp
#include <hip/hip_runtime.h>
#include <cstdio>
#include <cstdint>

#define LAS __attribute__((address_space(3)))
typedef unsigned short bf16;
typedef short bf16x8 __attribute__((ext_vector_type(8)));
typedef float f32x4 __attribute__((ext_vector_type(4)));
typedef float f32x16 __attribute__((ext_vector_type(16)));
typedef float f32x2 __attribute__((ext_vector_type(2)));
typedef unsigned u32x4 __attribute__((ext_vector_type(4)));
typedef unsigned u32x2 __attribute__((ext_vector_type(2)));
typedef const __attribute__((address_space(4))) float cfloat;

constexpr int D = 2048, SEQ = 4096, NL = 2, NSB = 8, NST = 4, NPAGES = 128, NPHYS = 1280;
constexpr int BW = 512, FF = 5632, INW = 13568, NPRE = 5376, NGATE = 8192, CSHIFT = 1792;
constexpr int MP = 8192, MS = 32, MR = 8224, MPAD = 8448;
constexpr int PA0 = 0, PB0 = 1024, PC0 = 2560, PD0 = 4352;
constexpr float LOG2E = 1.4426950408889634f;

constexpr size_t O_Y = 0, O_KP = 16842752, O_VP = 25231360, O_KS = 33619968, O_VS = 33652736, O_WP = 33685504, O_WS = 33816576,
                 O_SHP = 34340864, O_SHS = 34348032, O_CP = 34376704, O_CS = 34438144, O_GV = 34683904, O_END = 34716672;

constexpr size_t al(size_t x) { return (x + 1048575) & ~(size_t)1048575; }
constexpr size_t WS_CTL = 0, CTL_BYTES = 1048576;
constexpr size_t SZ_WIN = (size_t)INW * D * 2, SZ_WBO = (size_t)4 * D * BW * 2, SZ_WMIX = (size_t)D * D * 2, SZ_WGU = (size_t)2 * FF * D * 2, SZ_WDN = (size_t)D * FF * 2, SZ_LW = (size_t)512 * 256 * 2;
constexpr size_t WS_WIN = al(WS_CTL + CTL_BYTES);
constexpr size_t WS_WBO = al(WS_WIN + NL * SZ_WIN);
constexpr size_t WS_WMIX = al(WS_WBO + NL * SZ_WBO);
constexpr size_t WS_WGU = al(WS_WMIX + NL * SZ_WMIX);
constexpr size_t WS_WDN = al(WS_WGU + NL * SZ_WGU);
constexpr size_t WS_LW = al(WS_WDN + NL * SZ_WDN);
constexpr size_t WS_H = al(WS_LW + NL * SZ_LW);
constexpr size_t WS_P = al(WS_H + (size_t)MPAD * D * 2);
constexpr size_t WS_G = al(WS_P + (size_t)MPAD * NPRE * 2);
constexpr size_t WS_ACT = al(WS_G + (size_t)MPAD * NGATE * 2);
constexpr size_t WS_MF = al(WS_ACT + (size_t)4 * MPAD * BW * 2);
constexpr size_t WS_MB = al(WS_MF + 1048576);
constexpr size_t WS_X1 = al(WS_MB + (size_t)MPAD * D * 2);
constexpr size_t WS_HID = al(WS_X1 + (size_t)MPAD * D * 4);
constexpr size_t WS_XL = al(WS_HID + (size_t)MPAD * FF * 2);
constexpr size_t WS_QB = al(WS_XL + (size_t)MPAD * D * 4);
constexpr size_t WS_KB = al(WS_QB + (size_t)MP * BW * 2);
constexpr size_t WS_VT = al(WS_KB + (size_t)MP * BW * 2);
constexpr size_t WS_QS = al(WS_VT + (size_t)MP * BW * 2);
constexpr size_t WS_OSEG = al(WS_QS + (size_t)MS * BW * 4);
constexpr size_t WS_TSEG = al(WS_OSEG + (size_t)8 * 64 * 16 * 128 * 4);
constexpr size_t SZ_RW = (size_t)MR * BW * 4;
constexpr size_t WS_R = al(WS_TSEG + 8 * 64 * 16 * 4);
constexpr size_t SZ_RWL = al(SZ_RW);
constexpr size_t WS_W = WS_R + NL * SZ_RWL, WS_KX = WS_W + NL * SZ_RWL, WS_V = WS_KX + NL * SZ_RWL, WS_KK = al(WS_V + SZ_RW), WS_KKA = WS_KK + NL * SZ_RWL, WS_GG = WS_KKA + NL * SZ_RWL;
constexpr size_t WS_OL = al(WS_GG + SZ_RW), WS_PR = al(WS_OL + SZ_RW);
constexpr size_t WS_RK = al(WS_PR + SZ_RW);
constexpr size_t SZ_CH = (size_t)16 * 64 * 4096 * 4;
constexpr size_t WS_PC = al(WS_RK + (size_t)MR * 8 * 4), WS_LC = al(WS_PC + SZ_CH), WS_SS = al(WS_LC + SZ_CH);
constexpr size_t WS_OPART = al(WS_SS + SZ_CH);
constexpr size_t WS_TPART = al(WS_OPART + (size_t)8 * 16 * 2 * 8 * 8 * 64 * 16);
constexpr size_t WS_END = al(WS_TPART + (size_t)8 * 16 * 8 * 64 * 4);

constexpr int CW_BAR = 4096;
constexpr int CW_RS = 16384;
constexpr int CW_Q = 8192;

constexpr int LDS_BYTES = 147456, LDS_CTL_OFF = 143360;

__device__ __forceinline__ unsigned f2bf(float f) { unsigned u = __builtin_bit_cast(unsigned, f); return (u + 0x7fffu + ((u >> 16) & 1u)) >> 16; }
typedef __bf16 bf16x2_t __attribute__((ext_vector_type(2)));
__device__ __forceinline__ unsigned pk2(float lo, float hi) { const f32x2 v = {lo, hi}; const bf16x2_t b = __builtin_convertvector(v, bf16x2_t); return __builtin_bit_cast(unsigned, b); }
__device__ __forceinline__ float wave_sum(float v) {
#pragma unroll
    for (int o = 1; o < 64; o <<= 1) v += __shfl_xor(v, o);
    return v;
}
__device__ __forceinline__ float ex2(float x) { return __builtin_amdgcn_exp2f(x); }
__device__ __forceinline__ float rcpf_(float x) { return __builtin_amdgcn_rcpf(x); }
__device__ __forceinline__ float sigmoidf_(float x) { return rcpf_(1.0f + ex2(-x * LOG2E)); }
__device__ __forceinline__ float gelu_tanh(float x) {
    const float u = 0.7978845608028654f * (x + 0.044715f * x * x * x);
    const float t = 1.0f - 2.0f * rcpf_(1.0f + ex2(2.0f * LOG2E * u));
    return 0.5f * x * (1.0f + t);
}
__device__ __forceinline__ f32x4 ldb4(const bf16* p) { const u32x2 w = *(const u32x2*)p; return (f32x4){__builtin_bit_cast(float, w.x << 16), __builtin_bit_cast(float, w.x & 0xffff0000u), __builtin_bit_cast(float, w.y << 16), __builtin_bit_cast(float, w.y & 0xffff0000u)}; }
#define LDS_WAIT() asm volatile("s_waitcnt lgkmcnt(0)" ::: "memory")
#define VM_WAIT() asm volatile("s_waitcnt vmcnt(0)" ::: "memory")

namespace pg8 {
typedef unsigned short bf16_t;
constexpr int BM = 256, BK = 64, HALF = 128, HTB = HALF * BK * 2, STAGE_BYTES = 8 * HTB, NXCD = 8, WGM = 8;
__host__ __device__ __forceinline__ int lds_byte(int r, int c) { const int st = (r >> 4) * 2 + (c >> 5), rr = r & 15, cc = c & 31, ob = rr * 64 + cc * 2; return st * 1024 + (ob ^ (((ob >> 9) & 1) << 5)); }
__host__ __device__ __forceinline__ void stage_rc(int b, int& R, int& C) { const int st = b / 1024, sb = b % 1024, swz = sb ^ (((sb >> 9) & 1) << 5); R = (st >> 1) * 16 + swz / 64; C = (st & 1) * 32 + (swz % 64) / 2; }
__host__ __device__ __forceinline__ int perm32(int rho) { const int n = rho >> 4, i = rho & 15; return 8 * (i >> 2) + 4 * n + (i & 3); }
struct Unit { int pm, pn, pb; };
struct Gemm { const bf16_t* A; const bf16_t* Bt; int M, N, K; size_t sA, sB; };
struct StaticOrder {
    int nM, nN, nwg, G, c;
    __host__ __device__ void init(int M, int N, int G_, int c_) { nM = M / BM; nN = N / BM; nwg = nM * nN; G = G_; c = c_; }
    __host__ __device__ void initn(int nM_, int nN_, int G_, int c_) { nM = nM_; nN = nN_; nwg = nM * nN; G = G_; c = c_; }
    __host__ __device__ bool next(int i, Unit& u) const {
        const long L = (long)i * G + c; if (L >= nwg) return false;
        int wgid = (int)L; { const int q = nwg / NXCD, r = nwg % NXCD, xcd = wgid % NXCD, off = wgid / NXCD; wgid = (xcd < r ? xcd * (q + 1) : r * (q + 1) + (xcd - r) * q) + off; }
        const int nig = WGM * nN, gid = wgid / nig, fm = gid * WGM, gsz = (nM - fm) < WGM ? (nM - fm) : WGM;
        u.pm = fm + ((wgid % nig) % gsz); u.pn = (wgid % nig) / gsz; u.pb = 0; return true;
    }
};
struct MergeOrder {
    StaticOrder so;
    __host__ __device__ bool next(int i, Unit& u) const { if (!so.next(i >> 2, u)) return false; u.pb = i & 3; return true; }
};
__device__ __forceinline__ unsigned cvt_pk_bf16(float lo, float hi) { return pk2(lo, hi); }

template <class Epi, class Sched, bool ALIGN_EPI, int NB = 2>
__device__ __forceinline__ void gemm_phase(const int tid, LAS unsigned char* lds, const Gemm g, const Sched& S, const Epi& E) {
    const int wid = __builtin_amdgcn_readfirstlane(tid >> 6), lane = tid & 63, wr = wid >> 2, wc = wid & 3, fr = lane & 15, fq = lane >> 4;
    const int K = g.K, nt = K / BK;
    unsigned voffA[2], voffB[2];
#pragma unroll
    for (int i = 0; i < 2; ++i) { int R, C; stage_rc(tid * 16 + i * 8192, R, C); const int Rb = (R & ~31) + perm32(R & 31);
        voffA[i] = (unsigned)(R * K + C) * 2u; voffB[i] = (unsigned)(Rb * K + C) * 2u; }
    const size_t kstep = (size_t)(BK * 2);
    const size_t hstep = (size_t)HALF * K * 2;
    const size_t tstep = 2 * hstep;
    const size_t bstep = (NB == 2) ? tstep : hstep;
    const unsigned ldsw = (unsigned)wid * 1024u;
    const int aoff = lds_byte(wr * 64 + fr, fq * 8), boff = lds_byte(wc * 32 + fr, fq * 8);
#define PG8_SA(b, h) (((b) * 2 + (h)) * HTB)
#define PG8_SB(b, h) ((4 + (b) * 2 + (h)) * HTB)
#define PG8_STAGE(bufoff, gbase, voff) do { _Pragma("unroll") for (int _i = 0; _i < 2; ++_i) \
        __builtin_amdgcn_global_load_lds((const unsigned*)((const char*)(gbase) + (voff)[_i]), (LAS unsigned*)(lds + (bufoff) + ldsw + _i * 8192), 16, 0, 0); } while (0)
#define PG8_LDA(dst, b, h) do { _Pragma("unroll") for (int m = 0; m < 4; ++m) _Pragma("unroll") for (int k = 0; k < 2; ++k) dst[m][k] = *(const LAS bf16x8*)(lds + PG8_SA(b, h) + aoff + m * 2048 + k * 1024); } while (0)
#define PG8_LDB(dst, b, h) do { _Pragma("unroll") for (int n = 0; n < 2; ++n) _Pragma("unroll") for (int k = 0; k < 2; ++k) dst[n][k] = *(const LAS bf16x8*)(lds + PG8_SB(b, h) + boff + n * 2048 + k * 1024); } while (0)
#define PG8_MMA(ai, bj, At, Bt) do { __builtin_amdgcn_s_setprio(1); _Pragma("unroll") for (int m = 0; m < 4; ++m) _Pragma("unroll") for (int n = 0; n < 2; ++n) _Pragma("unroll") for (int k = 0; k < 2; ++k) \
        acc[ai][bj][m][n] = __builtin_amdgcn_mfma_f32_16x16x32_bf16(Bt[n][k], At[m][k], acc[ai][bj][m][n], 0, 0, 0); __builtin_amdgcn_s_setprio(0); } while (0)
#define PG8_WAIT_V(n) asm volatile("s_waitcnt vmcnt(" #n ")" ::: "memory")
#define PG8_WAIT_L(n) asm volatile("s_waitcnt lgkmcnt(" #n ")" ::: "memory")
#define PG8_BAR __builtin_amdgcn_s_barrier()
#define PG8_SCHED __builtin_amdgcn_sched_barrier(0)
    Unit cur, nxt; int ui = 0;
    if (!S.next(0, cur)) return;
    f32x4 acc[2][NB][4][2];
    f32x4 xreg[NB == 1 ? 2 : 1][NB == 1 ? 4 : 1][NB == 1 ? 2 : 1];
#pragma unroll
    for (int a = 0; a < 2; ++a)
#pragma unroll
        for (int b = 0; b < NB; ++b)
#pragma unroll
            for (int m = 0; m < 4; ++m)
#pragma unroll
                for (int n = 0; n < 2; ++n) acc[a][b][m][n] = (f32x4){0.f, 0.f, 0.f, 0.f};
    bf16x8 At[4][2], B0[2][2], B1[NB == 2 ? 2 : 1][2];
    const char* cA = (const char*)(g.A + (size_t)cur.pb * g.sA) + (size_t)cur.pm * tstep; const char* cB = (const char*)(g.Bt + (size_t)cur.pb * g.sB) + (size_t)cur.pn * bstep;
    if constexpr (NB == 2) {
        PG8_STAGE(PG8_SB(0, 0), cB, voffB); PG8_STAGE(PG8_SB(0, 1), cB + hstep, voffB); PG8_STAGE(PG8_SA(0, 0), cA, voffA); PG8_STAGE(PG8_SA(0, 1), cA + hstep, voffA);
        if (wr == 1) PG8_BAR;
        PG8_WAIT_V(2); PG8_BAR;
        PG8_STAGE(PG8_SB(1, 0), cB + kstep, voffB); PG8_STAGE(PG8_SA(1, 0), cA + kstep, voffA); PG8_STAGE(PG8_SB(1, 1), cB + hstep + kstep, voffB);
        PG8_WAIT_V(6); PG8_BAR;
    } else {
        PG8_STAGE(PG8_SB(0, 0), cB, voffB); PG8_STAGE(PG8_SA(0, 0), cA, voffA); PG8_STAGE(PG8_SA(0, 1), cA + hstep, voffA);
        if (wr == 1) PG8_BAR;
        PG8_WAIT_V(2); PG8_BAR;
        PG8_STAGE(PG8_SB(1, 0), cB + kstep, voffB); PG8_STAGE(PG8_SA(1, 0), cA + kstep, voffA);
        PG8_WAIT_V(4); PG8_BAR;
    }
    for (;;) {
        const bool has_next = S.next(ui + 1, nxt);
        const char* nA = has_next ? (const char*)(g.A + (size_t)nxt.pb * g.sA) + (size_t)nxt.pm * tstep : cA; const char* nB = has_next ? (const char*)(g.Bt + (size_t)nxt.pb * g.sB) + (size_t)nxt.pn * bstep : cB;
        for (int t = 0; t < nt; t += 2) {
            const bool last = (t == nt - 2);
            const char* a1 = cA + (size_t)(t + 1) * kstep;
            const char* a2 = last ? nA : cA + (size_t)(t + 2) * kstep; const char* b2 = last ? nB : cB + (size_t)(t + 2) * kstep;
            const char* a3 = a2 + kstep; const char* b3 = b2 + kstep;
            if constexpr (NB == 2) {
            PG8_LDB(B0, 0, 0); PG8_LDB(B1, 0, 1); PG8_SCHED; PG8_LDA(At, 0, 0); PG8_STAGE(PG8_SA(1, 1), a1 + hstep, voffA);
            PG8_WAIT_V(8); PG8_WAIT_L(0); PG8_BAR; PG8_MMA(0, 0, At, B0); PG8_MMA(0, 1, At, B1); PG8_BAR; PG8_SCHED;
            PG8_LDA(At, 0, 1); PG8_STAGE(PG8_SB(0, 0), b2, voffB); PG8_STAGE(PG8_SB(0, 1), b2 + hstep, voffB); PG8_STAGE(PG8_SA(0, 0), a2, voffA);
            PG8_WAIT_V(8); PG8_WAIT_L(0); PG8_BAR; PG8_MMA(1, 0, At, B0); PG8_MMA(1, 1, At, B1); PG8_BAR; PG8_SCHED;
            PG8_LDB(B0, 1, 0); PG8_LDB(B1, 1, 1); PG8_SCHED; PG8_LDA(At, 1, 0); PG8_STAGE(PG8_SA(0, 1), a2 + hstep, voffA);
            PG8_WAIT_V(8); PG8_WAIT_L(0); PG8_BAR; PG8_MMA(0, 0, At, B0); PG8_MMA(0, 1, At, B1); PG8_BAR; PG8_SCHED;
            PG8_LDA(At, 1, 1); PG8_STAGE(PG8_SB(1, 0), b3, voffB); PG8_STAGE(PG8_SB(1, 1), b3 + hstep, voffB); PG8_STAGE(PG8_SA(1, 0), a3, voffA);
            PG8_WAIT_V(8); PG8_WAIT_L(0); PG8_BAR; PG8_MMA(1, 0, At, B0); PG8_MMA(1, 1, At, B1); PG8_BAR; PG8_SCHED;
            } else {
            PG8_LDB(B0, 0, 0); PG8_SCHED; PG8_LDA(At, 0, 0); PG8_STAGE(PG8_SA(1, 1), a1 + hstep, voffA);
            PG8_WAIT_V(6); PG8_WAIT_L(0); PG8_BAR; PG8_MMA(0, 0, At, B0); PG8_BAR; PG8_SCHED;
            PG8_LDA(At, 0, 1); PG8_STAGE(PG8_SB(0, 0), b2, voffB); PG8_STAGE(PG8_SA(0, 0), a2, voffA);
            PG8_WAIT_V(6); PG8_WAIT_L(0); PG8_BAR; PG8_MMA(1, 0, At, B0); PG8_BAR; PG8_SCHED;
            PG8_LDB(B0, 1, 0); PG8_SCHED; PG8_LDA(At, 1, 0); PG8_STAGE(PG8_SA(0, 1), a2 + hstep, voffA);
            PG8_WAIT_V(6); PG8_WAIT_L(0); PG8_BAR; PG8_MMA(0, 0, At, B0); PG8_BAR; PG8_SCHED;
            PG8_LDA(At, 1, 1); PG8_STAGE(PG8_SB(1, 0), b3, voffB); PG8_STAGE(PG8_SA(1, 0), a3, voffA);
            PG8_WAIT_V(6); PG8_WAIT_L(0); PG8_BAR; PG8_MMA(1, 0, At, B0); PG8_BAR; PG8_SCHED;
            }
        }
        if constexpr (ALIGN_EPI) { if (wr == 0) PG8_BAR; }
        if constexpr (NB == 2) E(acc, cur, wr, wc, fr, fq); else E(acc, xreg, cur, wr, wc, fr, fq);
        if (!has_next) break;
#pragma unroll
        for (int a = 0; a < 2; ++a)
#pragma unroll
            for (int b = 0; b < NB; ++b)
#pragma unroll
                for (int m = 0; m < 4; ++m)
#pragma unroll
                    for (int n = 0; n < 2; ++n) acc[a][b][m][n] = (f32x4){0.f, 0.f, 0.f, 0.f};
        cur = nxt; cA = nA; cB = nB; ++ui;
        if constexpr (ALIGN_EPI) { if (wr == 1) PG8_BAR; }
    }
    PG8_WAIT_V(0);
    if constexpr (!ALIGN_EPI) { if (wr == 0) PG8_BAR; }
    PG8_BAR;
#undef PG8_SA
#undef PG8_SB
#undef PG8_STAGE
#undef PG8_LDA
#undef PG8_LDB
#undef PG8_MMA
#undef PG8_WAIT_V
#undef PG8_WAIT_L
#undef PG8_BAR
#undef PG8_SCHED
}

struct EpiIn {
    bf16_t* P; bf16_t* G; const float* rs;
    __device__ __forceinline__ void operator()(const f32x4 (&acc)[2][2][4][2], const Unit& u, int wr, int wc, int fr, int fq) const {
        const int row0 = u.pm * BM + wr * 64 + fr;
        float scv[2][4];
#pragma unroll
        for (int ai = 0; ai < 2; ++ai)
#pragma unroll
            for (int m = 0; m < 4; ++m) scv[ai][m] = rs ? rs[row0 + ai * HALF + m * 16] : 0.f;
#pragma unroll
        for (int ai = 0; ai < 2; ++ai)
#pragma unroll
            for (int m = 0; m < 4; ++m) scv[ai][m] = rs ? 1.0f / sqrtf(scv[ai][m] * (1.0f / D) + 1e-6f) : 1.0f;
        if (u.pn < 21) {
            const int col0 = u.pn * BM + wc * 32 + 8 * fq;
#pragma unroll
            for (int ai = 0; ai < 2; ++ai)
#pragma unroll
                for (int m = 0; m < 4; ++m) { bf16_t* rowp = P + (size_t)(row0 + ai * HALF + m * 16) * NPRE + col0;
                    const float sc = scv[ai][m];
#pragma unroll
                    for (int bj = 0; bj < 2; ++bj) { const f32x4 v0 = acc[ai][bj][m][0] * sc, v1 = acc[ai][bj][m][1] * sc;
                        u32x4 w; w.x = cvt_pk_bf16(v0[0], v0[1]); w.y = cvt_pk_bf16(v0[2], v0[3]); w.z = cvt_pk_bf16(v1[0], v1[1]); w.w = cvt_pk_bf16(v1[2], v1[3]);
                        *(u32x4*)(rowp + bj * HALF) = w; } }
        } else {
            const int col0 = (u.pn - 21) * BM + wc * 32 + 8 * fq;
#pragma unroll
            for (int ai = 0; ai < 2; ++ai)
#pragma unroll
                for (int m = 0; m < 4; ++m) { bf16_t* rowp = G + (size_t)(row0 + ai * HALF + m * 16) * NGATE + col0;
                    const float sc = scv[ai][m];
#pragma unroll
                    for (int bj = 0; bj < 2; ++bj) { const f32x4 v0 = acc[ai][bj][m][0] * sc, v1 = acc[ai][bj][m][1] * sc;
                        u32x4 w; w.x = cvt_pk_bf16(sigmoidf_(v0[0]), sigmoidf_(v0[1])); w.y = cvt_pk_bf16(sigmoidf_(v0[2]), sigmoidf_(v0[3]));
                        w.z = cvt_pk_bf16(sigmoidf_(v1[0]), sigmoidf_(v1[1])); w.w = cvt_pk_bf16(sigmoidf_(v1[2]), sigmoidf_(v1[3]));
                        *(u32x4*)(rowp + bj * HALF) = w; } }
        }
    }
};
__device__ __forceinline__ f32x4 bf4lo(u32x4 g) { return (f32x4){__builtin_bit_cast(float, g.x << 16), __builtin_bit_cast(float, g.x & 0xffff0000u), __builtin_bit_cast(float, g.y << 16), __builtin_bit_cast(float, g.y & 0xffff0000u)}; }
__device__ __forceinline__ f32x4 bf4hi(u32x4 g) { return (f32x4){__builtin_bit_cast(float, g.z << 16), __builtin_bit_cast(float, g.z & 0xffff0000u), __builtin_bit_cast(float, g.w << 16), __builtin_bit_cast(float, g.w & 0xffff0000u)}; }
struct EpiMerge {
    const bf16_t* G; bf16_t* MB;
    __device__ __forceinline__ void operator()(const f32x4 (&acc)[2][1][4][2], f32x4 (&mr)[2][4][2], const Unit& u, int wr, int wc, int fr, int fq) const {
        const int row0 = u.pm * BM + wr * 64 + fr, col0 = u.pn * HALF + wc * 32 + 8 * fq;
        u32x4 gv[2][4];
#pragma unroll
        for (int ai = 0; ai < 2; ++ai)
#pragma unroll
            for (int m = 0; m < 4; ++m) gv[ai][m] = *(const u32x4*)(G + (size_t)(row0 + ai * HALF + m * 16) * NGATE + (size_t)u.pb * D + col0);
#pragma unroll
        for (int ai = 0; ai < 2; ++ai)
#pragma unroll
            for (int m = 0; m < 4; ++m) {
                const f32x4 p0 = acc[ai][0][m][0] * bf4lo(gv[ai][m]), p1 = acc[ai][0][m][1] * bf4hi(gv[ai][m]);
                if (u.pb == 0) { mr[ai][m][0] = p0; mr[ai][m][1] = p1; } else { mr[ai][m][0] += p0; mr[ai][m][1] += p1; }
                if (u.pb == 3) { const f32x4 v0 = mr[ai][m][0], v1 = mr[ai][m][1];
                    u32x4 w; w.x = cvt_pk_bf16(v0[0], v0[1]); w.y = cvt_pk_bf16(v0[2], v0[3]); w.z = cvt_pk_bf16(v1[0], v1[1]); w.w = cvt_pk_bf16(v1[2], v1[3]);
                    *(u32x4*)(MB + (size_t)(row0 + ai * HALF + m * 16) * D + col0) = w; } }
    }
};
struct EpiRes {
    const float* r0; float* out; bf16_t* Hn; const float* gn; float* rs;
    __device__ __forceinline__ void operator()(const f32x4 (&acc)[2][2][4][2], const Unit& u, int wr, int wc, int fr, int fq) const {
        const int row0 = u.pm * BM + wr * 64 + fr, col0 = u.pn * BM + wc * 32 + 8 * fq;
        f32x4 gv[2][2];
        if (Hn) {
#pragma unroll
            for (int bj = 0; bj < 2; ++bj) { gv[bj][0] = *(const f32x4*)(gn + col0 + bj * HALF); gv[bj][1] = *(const f32x4*)(gn + col0 + bj * HALF + 4); } }
#pragma unroll
        for (int aih = 0; aih < 4; ++aih) { const int ai = aih >> 1, m0 = (aih & 1) * 2;
            f32x4 rv[4][2][2];
#pragma unroll
            for (int m = m0; m < m0 + 2; ++m) { const float* rp = r0 + (size_t)(row0 + ai * HALF + m * 16) * D + col0;
#pragma unroll
                for (int bj = 0; bj < 2; ++bj) { rv[m][bj][0] = *(const f32x4*)(rp + bj * HALF); rv[m][bj][1] = *(const f32x4*)(rp + bj * HALF + 4); } }
#pragma unroll
            for (int m = m0; m < m0 + 2; ++m) { const int row = row0 + ai * HALF + m * 16;
                float ss = 0.f;
#pragma unroll
                for (int bj = 0; bj < 2; ++bj) { const f32x4 v0 = acc[ai][bj][m][0] + rv[m][bj][0], v1 = acc[ai][bj][m][1] + rv[m][bj][1];
                    float* op = out + (size_t)row * D + col0 + bj * HALF; *(f32x4*)op = v0; *(f32x4*)(op + 4) = v1;
                    if (Hn) { ss += (v0[0] * v0[0] + v0[1] * v0[1]) + (v0[2] * v0[2] + v0[3] * v0[3]) + (v1[0] * v1[0] + v1[1] * v1[1]) + (v1[2] * v1[2] + v1[3] * v1[3]);
                        const f32x4 h0 = v0 * gv[bj][0], h1 = v1 * gv[bj][1];
                        u32x4 w; w.x = cvt_pk_bf16(h0[0], h0[1]); w.y = cvt_pk_bf16(h0[2], h0[3]); w.z = cvt_pk_bf16(h1[0], h1[1]); w.w = cvt_pk_bf16(h1[2], h1[3]);
                        *(u32x4*)(Hn + (size_t)row * D + col0 + bj * HALF) = w; } }
                if (Hn) { ss += __shfl_xor(ss, 16); ss += __shfl_xor(ss, 32); if (fq == 0) (void)__hip_atomic_fetch_add(rs + row, ss, __ATOMIC_RELAXED, __HIP_MEMORY_SCOPE_AGENT); }
            }
        }
    }
};
struct EpiGU {
    bf16_t* HID; const float* rs;
    __device__ __forceinline__ void operator()(const f32x4 (&acc)[2][2][4][2], const Unit& u, int wr, int wc, int fr, int fq) const {
        const int row0 = u.pm * BM + wr * 64 + fr, col0 = u.pn * HALF + wc * 32 + 8 * fq;
        float scv[2][4];
#pragma unroll
        for (int ai = 0; ai < 2; ++ai)
#pragma unroll
            for (int m = 0; m < 4; ++m) scv[ai][m] = rs[row0 + ai * HALF + m * 16];
#pragma unroll
        for (int ai = 0; ai < 2; ++ai)
#pragma unroll
            for (int m = 0; m < 4; ++m) { const size_t row = (size_t)(row0 + ai * HALF + m * 16);
                const float sc = 1.0f / sqrtf(scv[ai][m] * (1.0f / D) + 1e-6f);
                const f32x4 g0 = acc[ai][0][m][0] * sc, g1 = acc[ai][0][m][1] * sc, u0 = acc[ai][1][m][0] * sc, u1 = acc[ai][1][m][1] * sc;
                float o[8];
#pragma unroll
                for (int j = 0; j < 4; ++j) { o[j] = g0[j] * sigmoidf_(g0[j]) * u0[j]; o[4 + j] = g1[j] * sigmoidf_(g1[j]) * u1[j]; }
                u32x4 w; w.x = cvt_pk_bf16(o[0], o[1]); w.y = cvt_pk_bf16(o[2], o[3]); w.z = cvt_pk_bf16(o[4], o[5]); w.w = cvt_pk_bf16(o[6], o[7]);
                *(u32x4*)(HID + row * FF + col0) = w; }
    }
};
}

#define XB_TMO      128
#define XB_XCNT(j)  (256  + 64 * (j))
#define XB_XSUB(j)  (1280 + 64 * (j))
#define XB_XGEN(j)  (2304 + 64 * (j))
#define XB_TOP      3328
#define XB_TOPGEN   3392
#define XCD_BAR_WORDS 3456
#define XB_SPIN_CAP (1u << 18)
__device__ __forceinline__ unsigned xb_ld(unsigned* p)              { return __hip_atomic_load(p, __ATOMIC_RELAXED, __HIP_MEMORY_SCOPE_AGENT); }
__device__ __forceinline__ unsigned xb_add(unsigned* p, unsigned v) { return __hip_atomic_fetch_add(p, v, __ATOMIC_RELAXED, __HIP_MEMORY_SCOPE_AGENT); }
__device__ __forceinline__ unsigned xb_xcc_id() { return (unsigned)__builtin_amdgcn_s_getreg((3 << 11) | 20) & 0xFu; }
#define XB_SPIN(cond, bar) do { unsigned _sp = 0; while (cond) { __builtin_amdgcn_s_sleep(1); \
    if ((++_sp & 255u) == 0u) { if (xb_ld(&(bar)[XB_TMO])) break; if (_sp > XB_SPIN_CAP) { atomicAdd(&(bar)[XB_TMO], 1u); break; } } } } while (0)
struct XcdBarrier { unsigned* bar; unsigned x; volatile LAS unsigned* st; };
__device__ __forceinline__ XcdBarrier xcd_barrier_post(unsigned* bar, volatile LAS unsigned* st) {
    XcdBarrier b; b.bar = bar; b.x = xb_xcc_id(); b.st = st;
    if (threadIdx.x == 0) (void)xb_add(&bar[XB_XCNT(b.x)], 1u);
    return b;
}
__device__ __forceinline__ void xcd_barrier_complete(unsigned* bar, unsigned x, unsigned& nloc, unsigned& nx) {
    const unsigned G = gridDim.x * gridDim.y * gridDim.z;
    unsigned sum, cnt, mine, sp = 0u;
    for (;;) {
        sum = 0u; cnt = 0u; mine = 0u;
#pragma unroll
        for (unsigned j = 0; j < 16; ++j) { const unsigned c = xb_ld(&bar[XB_XCNT(j)]); sum += c; cnt += (c > 0u) ? 1u : 0u; mine = (j == x) ? c : mine; }
        if (sum == G) break;
        __builtin_amdgcn_s_sleep(1);
        if ((++sp & 255u) == 0u) { if (xb_ld(&bar[XB_TMO])) break; if (sp > XB_SPIN_CAP) { atomicAdd(&bar[XB_TMO], 1u); break; } }
    }
    nloc = mine > 0u ? mine : 1u; nx = cnt > 0u ? cnt : 1u;
}
__device__ __forceinline__ void xcd_barrier(const XcdBarrier& b) {
    asm volatile("s_waitcnt vmcnt(0)" ::: "memory");
    __syncthreads();
    if (threadIdx.x == 0) {
        unsigned* bar = b.bar;
        __builtin_amdgcn_s_waitcnt(0);
        unsigned nloc = b.st[0], nx = b.st[1];
        if (nloc == 0u) { xcd_barrier_complete(bar, b.x, nloc, nx); b.st[0] = nloc; b.st[1] = nx; }
        const unsigned old = xb_add(&bar[XB_XSUB(b.x)], 1u);
        const unsigned gen = old / nloc;
        if (old + 1u == (gen + 1u) * nloc) {
            __builtin_amdgcn_fence(__ATOMIC_RELEASE, "agent");
            asm volatile("s_waitcnt vmcnt(0)" ::: "memory");
            const unsigned og = xb_add(&bar[XB_TOP], 1u);
            const unsigned tg = og / nx;
            if (og + 1u == (tg + 1u) * nx) xb_add(&bar[XB_TOPGEN], 1u);
            else XB_SPIN(xb_ld(&bar[XB_TOPGEN]) == tg, bar);
            __builtin_amdgcn_fence(__ATOMIC_ACQUIRE, "agent");
            xb_add(&bar[XB_XGEN(b.x)], 1u);
            asm volatile("s_waitcnt vmcnt(0)" ::: "memory");
        } else {
            XB_SPIN(xb_ld(&bar[XB_XGEN(b.x)]) == gen, bar);
            __builtin_amdgcn_fence(__ATOMIC_ACQUIRE, "agent");
            asm volatile("s_waitcnt vmcnt(0)" ::: "memory");
        }
    }
    __syncthreads();
}

struct Args { const void* in[41]; float* out; unsigned char* ws; int ph_lo, ph_hi, li, pad; };
struct Frame {
    LAS unsigned char* lds;
    int tid, lane, wave, vcu, G;
};
constexpr int NW = 8;

__device__ __forceinline__ void cvt_item(const float* W, int N, bf16* WT, int Kd, int k0, int n0, int drow0, int kd0, LAS float* scr, int lane) {
    const int lr = lane >> 4, lc = (lane & 15) * 4;
    f32x4 v[16];
#pragma unroll
    for (int i = 0; i < 16; ++i) v[i] = __builtin_nontemporal_load((const f32x4*)(W + (size_t)(k0 + 4 * i + lr) * N + n0 + lc));
#pragma unroll
    for (int i = 0; i < 16; ++i) { LAS float* s = scr + (4 * i + lr) * 65 + lc; s[0] = v[i][0]; s[1] = v[i][1]; s[2] = v[i][2]; s[3] = v[i][3]; }
    LDS_WAIT(); asm volatile("" ::: "memory");
    const int c = lane & 7;
#pragma unroll
    for (int j = 0; j < 8; ++j) { const int n = (lane >> 3) + 8 * j; const LAS float* s = scr + (8 * c) * 65 + n;
        u32x4 o; o.x = pk2(s[0 * 65], s[1 * 65]); o.y = pk2(s[2 * 65], s[3 * 65]); o.z = pk2(s[4 * 65], s[5 * 65]); o.w = pk2(s[6 * 65], s[7 * 65]);
        *(u32x4*)(WT + (size_t)(drow0 + n) * Kd + kd0 + 8 * c) = o; }
    LDS_WAIT(); asm volatile("" ::: "memory");
}
__device__ __forceinline__ void p0_convert(Frame& F, const Args& a) {
    LAS float* scr = (LAS float*)(F.lds + F.wave * 16640);
    const int gw = F.vcu * NW + F.wave, NGW = F.G * NW;
    constexpr int I_IN = 32 * 212, I_BO = 8 * 32, I_MIX = 32 * 32, I_G = 32 * 88, I_DN = 88 * 32, I_LW = 8, I_LG = 16;
    constexpr int PER_L = I_IN + 4 * I_BO + I_MIX + 2 * I_G + I_DN + 2 * I_LW + I_LG;
    for (int it = gw; it < NL * PER_L; it += NGW) {
        const int l = it / PER_L; int r = it % PER_L;
        unsigned char* ws = a.ws;
        if (r < I_IN) { const int kb = r / 212, nb = r % 212; cvt_item((const float*)a.in[9] + (size_t)l * D * INW, INW, (bf16*)(ws + WS_WIN + l * SZ_WIN), D, kb * 64, nb * 64, nb * 64, kb * 64, scr, F.lane); continue; } r -= I_IN;
        if (r < 4 * I_BO) { const int b = r / I_BO, q = r % I_BO, kb = q / 32, nb = q % 32; const int idx = (b == 0) ? 14 : (b == 1) ? 18 : (b == 2) ? 30 : 35;
            cvt_item((const float*)a.in[idx] + (size_t)l * BW * D, D, (bf16*)(ws + WS_WBO + l * SZ_WBO) + (size_t)b * D * BW, BW, kb * 64, nb * 64, nb * 64, kb * 64, scr, F.lane); continue; } r -= 4 * I_BO;
        if (r < I_MIX) { const int kb = r / 32, nb = r % 32; cvt_item((const float*)a.in[36] + (size_t)l * D * D, D, (bf16*)(ws + WS_WMIX + l * SZ_WMIX), D, kb * 64, nb * 64, nb * 64, kb * 64, scr, F.lane); continue; } r -= I_MIX;
        if (r < 2 * I_G) { const int up = r / I_G, q = r % I_G, kb = q / 88, nb = q % 88, n0 = nb * 64;
            cvt_item((const float*)a.in[up ? 39 : 38] + (size_t)l * D * FF, FF, (bf16*)(ws + WS_WGU + l * SZ_WGU), D, kb * 64, n0, (n0 / 128) * 256 + up * 128 + (n0 % 128), kb * 64, scr, F.lane); continue; } r -= 2 * I_G;
        if (r < I_DN) { const int kb = r / 32, nb = r % 32; cvt_item((const float*)a.in[40] + (size_t)l * FF * D, D, (bf16*)(ws + WS_WDN + l * SZ_WDN), FF, kb * 64, nb * 64, nb * 64, kb * 64, scr, F.lane); continue; } r -= I_DN;
        bf16* lw = (bf16*)(ws + WS_LW + l * SZ_LW);
        if (r < I_LW) { cvt_item((const float*)a.in[21] + (size_t)l * 64 * 512, 512, lw, 256, 0, r * 64, r * 64, 0, scr, F.lane); continue; } r -= I_LW;
        if (r < I_LW) { cvt_item((const float*)a.in[23] + (size_t)l * 64 * 512, 512, lw, 256, 0, r * 64, r * 64, 64, scr, F.lane); continue; } r -= I_LW;
        { const int kb = r / 8, nb = r % 8; cvt_item((const float*)a.in[24] + (size_t)l * 128 * 512, 512, lw, 256, kb * 64, nb * 64, nb * 64, 128 + kb * 64, scr, F.lane); }
    }
}

__device__ __forceinline__ void norm_phase(Frame& F, const float* s0, const float* s1, const float* gain, bf16* H) {
    const int gw = F.vcu * NW + F.wave, NGW = F.G * NW;
    f32x4 gv[8];
#pragma unroll
    for (int j = 0; j < 8; ++j) gv[j] = *(const f32x4*)(gain + (j * 64 + F.lane) * 4);
    for (int m = gw; m < MPAD; m += NGW) {
        u32x2* o = (u32x2*)(H + (size_t)m * D) + F.lane;
        if (m >= MR) {
#pragma unroll
            for (int j = 0; j < 8; ++j) o[64 * j] = (u32x2){0u, 0u};
            continue; }
        const f32x4* xr = (const f32x4*)((m < MP) ? s0 + (size_t)m * D : s1 + (size_t)(m - MP) * D) + F.lane;
        f32x4 v[8]; float ss = 0.f;
#pragma unroll
        for (int j = 0; j < 8; ++j) { v[j] = xr[64 * j]; ss += (v[j][0] * v[j][0] + v[j][1] * v[j][1]) + (v[j][2] * v[j][2] + v[j][3] * v[j][3]); }
        const float rs = 1.0f / sqrtf(wave_sum(ss) * (1.0f / D) + 1e-6f);
#pragma unroll
        for (int j = 0; j < 8; ++j) { const f32x4 y = v[j] * rs * gv[j]; o[64 * j] = (u32x2){pk2(y[0], y[1]), pk2(y[2], y[3])}; }
    }
}

__device__ __forceinline__ void gmlp_item(Frame& F, const Args& a, int l, int chunk, int g, const bf16* P, bf16* ACTA) {
    LAS bf16* Vt = (LAS bf16*)F.lds;
    const int lane = F.lane, w = F.wave;
    const float* lng = (const float*)a.in[10] + l * 512; const float* lnb = (const float*)a.in[11] + l * 512;
    const float* ws_ = (const float*)a.in[12] + (size_t)(l * 4 + g) * 128 * 128; const float* bs = (const float*)a.in[13] + (l * 4 + g) * 128;
    const int row0 = chunk * 128;
    f32x4 uv[8]; float btv[8];
    { const int li_ = lane & 15, q_ = lane >> 4, c0_ = 128 * g + 16 * w + 4 * q_;
#pragma unroll
      for (int tt = 0; tt < 8; ++tt) { const int t = 16 * tt + li_; uv[tt] = ldb4(P + (size_t)(row0 + t) * NPRE + PA0 + c0_); btv[tt] = bs[t]; } }
    const int myj = g >> 1, mylo = (g & 1) * 32;
    const f32x4 lgv = *(const f32x4*)(lng + myj * 256 + 4 * lane), lbv = *(const f32x4*)(lnb + myj * 256 + 4 * lane);
#pragma unroll 1
    for (int i0 = 0; i0 < 16; i0 += 8) {
        f32x4 xa[8], xb[8];
#pragma unroll
        for (int i = 0; i < 8; ++i) { const bf16* pr = P + (size_t)(row0 + w * 16 + i0 + i) * NPRE + PA0 + 512; xa[i] = ldb4(pr + 4 * lane); xb[i] = ldb4(pr + 256 + 4 * lane); }
#pragma unroll
        for (int i = 0; i < 8; ++i) {
            const int s = w * 16 + i0 + i; f32x4 x0 = xa[i], x1 = xb[i];
#pragma unroll
            for (int j = 0; j < 4; ++j) { x0[j] = gelu_tanh(x0[j]); x1[j] = gelu_tanh(x1[j]); }
            const float mean = wave_sum((x0[0] + x0[1]) + (x0[2] + x0[3]) + (x1[0] + x1[1]) + (x1[2] + x1[3])) * (1.f / 512.f);
            x0 -= mean; x1 -= mean;
            const float var = wave_sum((x0[0] * x0[0] + x0[1] * x0[1]) + (x0[2] * x0[2] + x0[3] * x0[3]) + (x1[0] * x1[0] + x1[1] * x1[1]) + (x1[2] * x1[2] + x1[3] * x1[3])) * (1.f / 512.f);
            const float rstd = 1.0f / sqrtf(var + 1e-5f);
            const f32x4 xm = myj ? x1 : x0;
            if ((lane >> 5) == (g & 1)) {
                const int cl = 4 * (lane - mylo);
#pragma unroll
                for (int j = 0; j < 4; ++j) Vt[(cl + j) * 136 + s] = (bf16)f2bf(xm[j] * rstd * lgv[j] + lbv[j]);
            }
        }
    }
    LDS_WAIT(); __syncthreads();
    const int li = lane & 15, q = lane >> 4;
    f32x4 acc[8];
#pragma unroll
    for (int tt = 0; tt < 8; ++tt) acc[tt] = (f32x4){0.f, 0.f, 0.f, 0.f};
#pragma unroll
    for (int ks = 0; ks < 4; ++ks) {
        const bf16x8 af = *(const LAS bf16x8*)(Vt + (16 * w + li) * 136 + 32 * ks + 8 * q);
        const int s0 = 32 * ks + 8 * q;
        f32x4 wl[8][2];
#pragma unroll
        for (int tt = 0; tt < 8; ++tt) { if (32 * ks > 16 * tt + 15) continue; const int t = 16 * tt + li; wl[tt][0] = *(const f32x4*)(ws_ + t * 128 + s0); wl[tt][1] = *(const f32x4*)(ws_ + t * 128 + s0 + 4); }
#pragma unroll
        for (int tt = 0; tt < 8; ++tt) {
            if (32 * ks > 16 * tt + 15) continue;
            const int t = 16 * tt + li;
            float wv[8] = {wl[tt][0][0], wl[tt][0][1], wl[tt][0][2], wl[tt][0][3], wl[tt][1][0], wl[tt][1][1], wl[tt][1][2], wl[tt][1][3]};
#pragma unroll
            for (int j = 0; j < 8; ++j) if (s0 + j > t) wv[j] = 0.f;
            u32x4 bw; bw.x = pk2(wv[0], wv[1]); bw.y = pk2(wv[2], wv[3]); bw.z = pk2(wv[4], wv[5]); bw.w = pk2(wv[6], wv[7]);
            acc[tt] = __builtin_amdgcn_mfma_f32_16x16x32_bf16(af, __builtin_bit_cast(bf16x8, bw), acc[tt], 0, 0, 0);
        }
    }
    {
        const int c0 = 128 * g + 16 * w + 4 * q;
#pragma unroll
        for (int tt = 0; tt < 8; ++tt) {
            const int t = 16 * tt + li; float o[4];
#pragma unroll
            for (int j = 0; j < 4; ++j) o[j] = gelu_tanh(uv[tt][j]) * (acc[tt][j] + btv[tt]);
            *(u32x2*)(ACTA + (size_t)(row0 + t) * BW + c0) = (u32x2){pk2(o[0], o[1]), pk2(o[2], o[3])};
        }
    }
    __syncthreads();
}
__device__ __forceinline__ void gmlp_sample_item(Frame& F, const Args& a, int l, const bf16* P, bf16* ACTA) {
    const int lane = F.lane, sb = F.wave;
    const float* lng = (const float*)a.in[10] + l * 512; const float* lnb = (const float*)a.in[11] + l * 512;
    float vn[4][8], uu[4][8];
#pragma unroll
    for (int t = 0; t < 4; ++t) {
        const bf16* pr = P + (size_t)(MP + sb * 4 + t) * NPRE + PA0;
        f32x4 u0 = ldb4(pr + 4 * lane), u1 = ldb4(pr + 256 + 4 * lane), x0 = ldb4(pr + 512 + 4 * lane), x1 = ldb4(pr + 768 + 4 * lane);
#pragma unroll
        for (int j = 0; j < 4; ++j) { x0[j] = gelu_tanh(x0[j]); x1[j] = gelu_tanh(x1[j]); uu[t][j] = gelu_tanh(u0[j]); uu[t][4 + j] = gelu_tanh(u1[j]); }
        const float mean = wave_sum((x0[0] + x0[1]) + (x0[2] + x0[3]) + (x1[0] + x1[1]) + (x1[2] + x1[3])) * (1.f / 512.f);
        x0 -= mean; x1 -= mean;
        const float var = wave_sum((x0[0] * x0[0] + x0[1] * x0[1]) + (x0[2] * x0[2] + x0[3] * x0[3]) + (x1[0] * x1[0] + x1[1] * x1[1]) + (x1[2] * x1[2] + x1[3] * x1[3])) * (1.f / 512.f);
        const float rstd = 1.0f / sqrtf(var + 1e-5f);
        const f32x4 g0 = *(const f32x4*)(lng + 4 * lane), g1 = *(const f32x4*)(lng + 256 + 4 * lane), b0 = *(const f32x4*)(lnb + 4 * lane), b1 = *(const f32x4*)(lnb + 256 + 4 * lane);
        f32x4 y0 = x0 * rstd * g0 + b0, y1 = x1 * rstd * g1 + b1;
        float* gv = a.out + O_GV + (size_t)((l * NSB + sb) * NST + t) * 512;
        *(f32x4*)(gv + 4 * lane) = y0; *(f32x4*)(gv + 256 + 4 * lane) = y1;
#pragma unroll
        for (int j = 0; j < 4; ++j) { vn[t][j] = y0[j]; vn[t][4 + j] = y1[j]; }
    }
#pragma unroll
    for (int t = 0; t < 4; ++t) {
        float o[8];
#pragma unroll
        for (int hf = 0; hf < 2; ++hf) {
            const int g = hf * 2 + (lane >> 5);
            const float* wg = (const float*)a.in[12] + (size_t)(l * 4 + g) * 128 * 128; const float bt = ((const float*)a.in[13])[(l * 4 + g) * 128 + t];
#pragma unroll
            for (int j = 0; j < 4; ++j) { float s = bt;
#pragma unroll
                for (int s2 = 0; s2 <= t; ++s2) s += wg[t * 128 + s2] * vn[s2][hf * 4 + j];
                o[hf * 4 + j] = uu[t][hf * 4 + j] * s; }
        }
        bf16* op = ACTA + (size_t)(MP + sb * 4 + t) * BW;
        *(u32x2*)(op + 4 * lane) = (u32x2){pk2(o[0], o[1]), pk2(o[2], o[3])}; *(u32x2*)(op + 256 + 4 * lane) = (u32x2){pk2(o[4], o[5]), pk2(o[6], o[7])};
    }
}
__device__ __forceinline__ void bprep_item(Frame& F, const Args& a, int l, int item, const bf16* P, bf16* QB, bf16* KB, bf16* VT, float* QS) {
    const int lane = F.lane, w = F.wave; const bool samp = (item == 256); const int row0 = item * 32;
    LAS float* vs = (LAS float*)F.lds;
    const float* qn = (const float*)a.in[15] + l * 128; const float* kn = (const float*)a.in[16] + l * 128;
    const f32x4 qg = *(const f32x4*)(qn + 4 * (lane & 31)), kg = *(const f32x4*)(kn + 4 * (lane & 31));
    const float qs = 0.08838834764831845f * LOG2E;
    f32x4 xall[4][6];
#pragma unroll
    for (int i = 0; i < 4; ++i) { const bf16* pr = P + (size_t)(row0 + w * 4 + i) * NPRE + PB0;
#pragma unroll
        for (int j = 0; j < 6; ++j) xall[i][j] = ldb4(pr + j * 256 + 4 * lane); }
#pragma unroll
    for (int i = 0; i < 4; ++i) {
        const int r = w * 4 + i, row = row0 + r;
        f32x4 x[6];
#pragma unroll
        for (int j = 0; j < 6; ++j) x[j] = xall[i][j];
        float* ko; float* vo;
        if (!samp) { ko = a.out + O_KP + ((size_t)l * MP + row) * 512; vo = a.out + O_VP + ((size_t)l * MP + row) * 512; }
        else { ko = a.out + O_KS + ((size_t)l * MS + r) * 512; vo = a.out + O_VS + ((size_t)l * MS + r) * 512; }
#pragma unroll
        for (int j = 0; j < 4; ++j) {
            float ss = (x[j][0] * x[j][0] + x[j][1] * x[j][1]) + (x[j][2] * x[j][2] + x[j][3] * x[j][3]);
#pragma unroll
            for (int o = 1; o < 32; o <<= 1) ss += __shfl_xor(ss, o);
            const float rs = 1.0f / sqrtf(ss * (1.f / 128.f) + 1e-6f);
            if (j < 2) { const f32x4 y = x[j] * rs * qg * qs;
                if (!samp) *(u32x2*)(QB + (size_t)row * BW + j * 256 + 4 * lane) = (u32x2){pk2(y[0], y[1]), pk2(y[2], y[3])};
                else *(f32x4*)(QS + (size_t)r * BW + j * 256 + 4 * lane) = y; }
            else { const f32x4 y = x[j] * rs * kg; *(f32x4*)(ko + (j - 2) * 256 + 4 * lane) = y;
                if (!samp) *(u32x2*)(KB + (size_t)row * BW + (j - 2) * 256 + 4 * lane) = (u32x2){pk2(y[0], y[1]), pk2(y[2], y[3])}; }
        }
#pragma unroll
        for (int j = 4; j < 6; ++j) { *(f32x4*)(vo + (j - 4) * 256 + 4 * lane) = x[j];
            if (!samp) { LAS float* s = vs + r * 513 + (j - 4) * 256 + 4 * lane; s[0] = x[j][0]; s[1] = x[j][1]; s[2] = x[j][2]; s[3] = x[j][3]; } }
    }
    if (!samp) {
        LDS_WAIT(); __syncthreads();
        const int n = F.tid, b = row0 / SEQ, t0 = row0 % SEQ, h = n >> 7, d = n & 127;
        bf16* vp = VT + ((size_t)((b * 4 + h) * 128 + d)) * SEQ + t0;
#pragma unroll
        for (int c = 0; c < 4; ++c) { const LAS float* s = vs + (8 * c) * 513 + n;
            u32x4 o; o.x = pk2(s[0], s[513]); o.y = pk2(s[2 * 513], s[3 * 513]); o.z = pk2(s[4 * 513], s[5 * 513]); o.w = pk2(s[6 * 513], s[7 * 513]);
            *(u32x4*)(vp + 8 * c) = o; }
        LDS_WAIT(); __syncthreads();
    }
}
__device__ __forceinline__ void cprep_item(Frame& F, const Args& a, int l, int item, const bf16* P, unsigned char* ws) {
    const int lane = F.lane, w = F.wave, tid = F.tid; const bool samp = (item == 256); const int row0 = item * 32;
    LAS bf16* act = (LAS bf16*)F.lds;
    const float* mu = (const float*)a.in[19] + l * CSHIFT;
    const float* sh0 = (const float*)a.in[6] + (size_t)l * NSB * CSHIFT;
    {
        const int r = tid >> 4, cg = tid & 15, row = row0 + r;
        const bool first = samp ? ((r & 3) == 0) : ((row % SEQ) == 0);
        const bf16* pc = P + (size_t)row * NPRE + PC0 + 1536 + cg * 16;
        const float* ps = sh0 + (size_t)(r >> 2) * CSHIFT + 1536 + cg * 16;
        unsigned o[8];
#pragma unroll
        for (int j = 0; j < 4; ++j) {
            const f32x4 c = ldb4(pc + 4 * j); f32x4 p = first ? (samp ? *(const f32x4*)(ps + 4 * j) : (f32x4){0.f, 0.f, 0.f, 0.f}) : ldb4(pc - NPRE + 4 * j); const f32x4 m = *(const f32x4*)(mu + 1536 + cg * 16 + 4 * j);
            f32x4 x = c + (p - c) * m;
#pragma unroll
            for (int e = 0; e < 4; ++e) { if (cg < 4) x[e] = 1.0f - 2.0f * rcpf_(1.0f + ex2(2.0f * LOG2E * x[e])); else if (cg >= 8) x[e] = sigmoidf_(x[e]); }
            o[2 * j] = pk2(x[0], x[1]); o[2 * j + 1] = pk2(x[2], x[3]);
        }
        LAS u32x4* dst = (LAS u32x4*)(act + r * 264 + cg * 16);
        dst[0] = (u32x4){o[0], o[1], o[2], o[3]}; dst[1] = (u32x4){o[4], o[5], o[6], o[7]};
    }
    LDS_WAIT(); __syncthreads();
    const int li = lane & 15, q = lane >> 4;
    const bf16* lw = (const bf16*)(ws + WS_LW + l * SZ_LW);
    const float* w0 = (const float*)a.in[20] + l * 512; const float* a0 = (const float*)a.in[22] + l * 512;
    const float* k_k = (const float*)a.in[25] + l * 512; const float* k_a = (const float*)a.in[26] + l * 512; const float* r_k = (const float*)a.in[27] + l * 512;
    float* Rr = (float*)(ws + WS_R + l * SZ_RWL); float* Ww = (float*)(ws + WS_W + l * SZ_RWL); float* KX = (float*)(ws + WS_KX + l * SZ_RWL); float* Vv = (float*)(ws + WS_V);
    float* KK = (float*)(ws + WS_KK + l * SZ_RWL); float* KKA = (float*)(ws + WS_KKA + l * SZ_RWL); float* GG = (float*)(ws + WS_GG); float* RK = (float*)(ws + WS_RK);
    int lwo = (64 * w + li) * 256 + 8 * q, aco = li * 264 + 8 * q, c00 = 64 * w + 4 * q;
    asm volatile("" : "+v"(lwo), "+v"(aco), "+v"(c00));
    f32x4 xsv[2][4][3];
    int rows[2];
#define CPREP_LOAD_XS(mt) do { const int r = 16 * (mt) + li, row = row0 + r; rows[mt] = row; \
        const bool first = samp ? ((r & 3) == 0) : ((row % SEQ) == 0); \
        const bf16* pc = P + (size_t)row * NPRE + PC0; \
        const float* ps = sh0 + (size_t)(r >> 2) * CSHIFT; \
        _Pragma("unroll") for (int ct = 0; ct < 4; ++ct) _Pragma("unroll") for (int j = 0; j < 3; ++j) { const int c0 = c00 + 16 * ct; const f32x4 c = ldb4(pc + j * 512 + c0); \
            const f32x4 p = first ? (samp ? *(const f32x4*)(ps + j * 512 + c0) : (f32x4){0.f, 0.f, 0.f, 0.f}) : ldb4(pc - NPRE + j * 512 + c0); xsv[mt][ct][j] = c + (p - c) * *(const f32x4*)(mu + j * 512 + c0); } } while (0)
    CPREP_LOAD_XS(0);
    f32x4 aw[2][4], aa[2][4], ag[2][4];
#pragma unroll
    for (int mt = 0; mt < 2; ++mt)
#pragma unroll
        for (int ct = 0; ct < 4; ++ct) { aw[mt][ct] = (f32x4){0.f, 0.f, 0.f, 0.f}; aa[mt][ct] = aw[mt][ct]; ag[mt][ct] = aw[mt][ct]; }
#pragma unroll
    for (int hb = 0; hb < 4; ++hb) {
        bf16x8 af[2][4];
#pragma unroll
        for (int k2 = 0; k2 < 2; ++k2)
#pragma unroll
            for (int ct = 0; ct < 4; ++ct) af[k2][ct] = *(const bf16x8*)(lw + lwo + ct * 16 * 256 + 32 * (hb * 2 + k2));
#pragma unroll
        for (int k2 = 0; k2 < 2; ++k2) { const int ks = hb * 2 + k2;
#pragma unroll
            for (int mt = 0; mt < 2; ++mt) { const bf16x8 bfr = *(const LAS bf16x8*)(act + aco + mt * 16 * 264 + 32 * ks);
#pragma unroll
                for (int ct = 0; ct < 4; ++ct) {
                    if (ks < 2) aw[mt][ct] = __builtin_amdgcn_mfma_f32_16x16x32_bf16(af[k2][ct], bfr, aw[mt][ct], 0, 0, 0);
                    else if (ks < 4) aa[mt][ct] = __builtin_amdgcn_mfma_f32_16x16x32_bf16(af[k2][ct], bfr, aa[mt][ct], 0, 0, 0);
                    else ag[mt][ct] = __builtin_amdgcn_mfma_f32_16x16x32_bf16(af[k2][ct], bfr, ag[mt][ct], 0, 0, 0);
                } } }
        asm volatile("" ::: "memory");
    }
#pragma unroll
    for (int mt = 0; mt < 2; ++mt) {
        if (mt == 1) { asm volatile("" ::: "memory"); CPREP_LOAD_XS(1); }
        const int row = rows[mt];
        f32x4 kkv[4], av[4]; float ss = 0.f, rk = 0.f;
#pragma unroll
        for (int ct = 0; ct < 4; ++ct) {
            const int c0 = c00 + 16 * ct;
            f32x4 xs[3];
#pragma unroll
            for (int j = 0; j < 3; ++j) xs[j] = xsv[mt][ct][j];
            const f32x4 w0v = *(const f32x4*)(w0 + c0), a0v = *(const f32x4*)(a0 + c0), kkw = *(const f32x4*)(k_k + c0), kaw = *(const f32x4*)(k_a + c0), rkw = *(const f32x4*)(r_k + c0);
            f32x4 dec;
#pragma unroll
            for (int e = 0; e < 4; ++e) {
                const float x = -(w0v[e] + aw[mt][ct][e]);
                const float sp = fmaxf(x, 0.f) + 0.6931471805599453f * __builtin_amdgcn_logf(1.0f + ex2(-fabsf(x) * LOG2E));
                dec[e] = ex2(-LOG2E * ex2(LOG2E * (-sp - 0.5f)));
                av[ct][e] = sigmoidf_(a0v[e] + aa[mt][ct][e]);
            }
            kkv[ct] = xs[1] * kkw;
            const f32x4 kxv = xs[1] * (1.0f + (av[ct] - 1.0f) * kaw);
            ss += (kkv[ct][0] * kkv[ct][0] + kkv[ct][1] * kkv[ct][1]) + (kkv[ct][2] * kkv[ct][2] + kkv[ct][3] * kkv[ct][3]);
            const f32x4 t = xs[0] * kxv * rkw; rk += (t[0] + t[1]) + (t[2] + t[3]);
            const size_t o = (size_t)row * BW + c0;
            *(f32x4*)(Rr + o) = xs[0]; *(f32x4*)(Ww + o) = dec; *(f32x4*)(KX + o) = kxv; *(f32x4*)(Vv + o) = xs[2]; *(f32x4*)(GG + o) = ag[mt][ct];
        }
        ss += __shfl_xor(ss, 16); ss += __shfl_xor(ss, 32); rk += __shfl_xor(rk, 16); rk += __shfl_xor(rk, 32);
        const float rn = 1.0f / sqrtf(fmaxf(ss, 1e-24f));
#pragma unroll
        for (int ct = 0; ct < 4; ++ct) { const size_t o = (size_t)row * BW + c00 + 16 * ct; const f32x4 kk = kkv[ct] * rn; *(f32x4*)(KK + o) = kk; *(f32x4*)(KKA + o) = kk * av[ct]; }
        if (q == 0) RK[(size_t)row * 8 + w] = rk;
    }
#undef CPREP_LOAD_XS
    if (!samp) { if ((row0 + 32) % SEQ == 0) { const int b = row0 / SEQ; const bf16* src = P + (size_t)(row0 + 31) * NPRE + PC0; float* dst = a.out + O_SHP + (size_t)(l * 2 + b) * CSHIFT;
            for (int i = tid; i < CSHIFT; i += 512) dst[i] = __builtin_bit_cast(float, (unsigned)src[i] << 16); } }
    else { for (int i = tid; i < NSB * CSHIFT; i += 512) { const int sb = i / CSHIFT, c = i % CSHIFT; a.out[O_SHS + (size_t)(l * NSB + sb) * CSHIFT + c] = __builtin_bit_cast(float, (unsigned)P[(size_t)(MP + sb * 4 + 3) * NPRE + PC0 + c] << 16); } }
    __syncthreads();
}
__device__ __forceinline__ void dconv_item(Frame& F, const Args& a, int l, int item, const bf16* P, bf16* ACTD) {
    const int tid = F.tid, lane = F.lane, w = F.wave;
    LAS float* z = (LAS float*)F.lds;
    LAS float* red = (LAS float*)(F.lds + 62 * 512 * 4);
    const bool samp = item >= 256; const int sb = item - 256;
    const int rowbase = samp ? MP + sb * 4 : item * 32;
    const int t0 = samp ? 0 : (item * 32) % SEQ, ntok = samp ? 4 : 32;
    const float* conv0 = (const float*)a.in[7] + (size_t)(l * NSB + (samp ? sb : 0)) * 30 * 512;
    const int c = tid;
    const float* cw = (const float*)a.in[31] + (size_t)l * 31 * 512; const float cb = ((const float*)a.in[32])[l * 512 + c];
    const float lg = ((const float*)a.in[33])[l * 512 + c], lb = ((const float*)a.in[34])[l * 512 + c];
    float wv[31];
#pragma unroll
    for (int j = 0; j < 31; ++j) wv[j] = cw[j * 512 + c];
    {
        const int rs = tid >> 7, c4 = (tid & 127) * 4, nrow = 30 + ntok;
#pragma unroll
        for (int hb = 0; hb < 2; ++hb) {
            f32x4 va[8], ga[8];
#pragma unroll
            for (int jj = 0; jj < 8; ++jj) { const int i = rs + 4 * (hb * 8 + jj), t = t0 - 30 + i;
                va[jj] = (f32x4){0.f, 0.f, 0.f, 0.f}; ga[jj] = va[jj];
                if (i < nrow) {
                    if (t < 0) { if (samp) va[jj] = *(const f32x4*)(conv0 + (size_t)i * 512 + c4); }
                    else { const bf16* pr = P + (size_t)(rowbase - 30 + i) * NPRE + PD0 + c4; va[jj] = ldb4(pr); ga[jj] = ldb4(pr + 512); } } }
#pragma unroll
            for (int jj = 0; jj < 8; ++jj) { const int i = rs + 4 * (hb * 8 + jj), t = t0 - 30 + i;
                if (i < nrow) { f32x4 zv = va[jj];
                    if (t >= 0) { zv[0] *= sigmoidf_(ga[jj][0]); zv[1] *= sigmoidf_(ga[jj][1]); zv[2] *= sigmoidf_(ga[jj][2]); zv[3] *= sigmoidf_(ga[jj][3]); }
                    *(LAS f32x4*)(z + i * 512 + c4) = zv; } }
        }
    }
    LDS_WAIT(); __syncthreads();
    if (samp) { float* dst = a.out + O_CS + (size_t)(l * NSB + sb) * 30 * 512; for (int i = 0; i < 30; ++i) dst[(size_t)i * 512 + c] = z[(4 + i) * 512 + c]; }
    else if (t0 + 32 == SEQ) { float* dst = a.out + O_CP + (size_t)(l * 2 + (item * 32) / SEQ) * 30 * 512; for (int i = 0; i < 30; ++i) dst[(size_t)i * 512 + c] = z[(32 + i) * 512 + c]; }
    float y[32];
#pragma unroll
    for (int t = 0; t < 32; ++t) y[t] = cb;
#pragma unroll
    for (int i = 0; i < 62; ++i) {
        if (i < 30 + ntok) { const float zi = z[i * 512 + c];
#pragma unroll
            for (int t = 0; t < 32; ++t) { if (i - t >= 0 && i - t <= 30) y[t] = fmaf(zi, wv[i - t], y[t]); } }
    }
    {
        float u1[16], u2[16];
        { const bool hb = (lane & 32) != 0;
#pragma unroll
          for (int j = 0; j < 16; ++j) { const float ka = hb ? y[16 + j] : y[j], sa = hb ? y[j] : y[16 + j]; u1[j] = ka + __shfl_xor(sa, 32); u2[j] = ka * ka + __shfl_xor(sa * sa, 32); } }
        float v1[8], v2[8];
        { const bool hb = (lane & 16) != 0;
#pragma unroll
          for (int j = 0; j < 8; ++j) { v1[j] = (hb ? u1[8 + j] : u1[j]) + __shfl_xor(hb ? u1[j] : u1[8 + j], 16); v2[j] = (hb ? u2[8 + j] : u2[j]) + __shfl_xor(hb ? u2[j] : u2[8 + j], 16); } }
        float w1[4], w2[4];
        { const bool hb = (lane & 8) != 0;
#pragma unroll
          for (int j = 0; j < 4; ++j) { w1[j] = (hb ? v1[4 + j] : v1[j]) + __shfl_xor(hb ? v1[j] : v1[4 + j], 8); w2[j] = (hb ? v2[4 + j] : v2[j]) + __shfl_xor(hb ? v2[j] : v2[4 + j], 8); } }
        float x1[2], x2[2];
        { const bool hb = (lane & 4) != 0;
#pragma unroll
          for (int j = 0; j < 2; ++j) { x1[j] = (hb ? w1[2 + j] : w1[j]) + __shfl_xor(hb ? w1[j] : w1[2 + j], 4); x2[j] = (hb ? w2[2 + j] : w2[j]) + __shfl_xor(hb ? w2[j] : w2[2 + j], 4); } }
        float z1, z2;
        { const bool hb = (lane & 2) != 0; z1 = (hb ? x1[1] : x1[0]) + __shfl_xor(hb ? x1[0] : x1[1], 2); z2 = (hb ? x2[1] : x2[0]) + __shfl_xor(hb ? x2[0] : x2[1], 2); }
        z1 += __shfl_xor(z1, 1); z2 += __shfl_xor(z2, 1);
        const int trow = ((lane >> 5) & 1) * 16 + ((lane >> 4) & 1) * 8 + ((lane >> 3) & 1) * 4 + ((lane >> 2) & 1) * 2 + ((lane >> 1) & 1);
        if ((lane & 1) == 0) { red[(trow * 8 + w) * 2] = z1; red[(trow * 8 + w) * 2 + 1] = z2; }
    }
    LDS_WAIT(); __syncthreads();
    if (tid < 32) { float s1 = 0.f, s2 = 0.f;
#pragma unroll
        for (int j = 0; j < 8; ++j) { s1 += red[(tid * 8 + j) * 2]; s2 += red[(tid * 8 + j) * 2 + 1]; }
        const float mean = s1 * (1.f / 512.f), var = fmaxf(s2 * (1.f / 512.f) - mean * mean, 0.f);
        red[512 + tid * 2] = mean; red[512 + tid * 2 + 1] = 1.0f / sqrtf(var + 1e-5f); }
    LDS_WAIT(); __syncthreads();
#pragma unroll
    for (int t = 0; t < 32; ++t) { if (t < ntok) { const float v = (y[t] - red[512 + t * 2]) * red[512 + t * 2 + 1] * lg + lb; ACTD[(size_t)(rowbase + t) * BW + c] = (bf16)f2bf(v * sigmoidf_(v)); } }
    __syncthreads();
}

template <bool SK>
__device__ __forceinline__ void scan_task(const float* R, const float* W, const float* KX, const float* KK, const float* KKA, const float* V, float* OUT, float* STT, const float* S0, float* SOUT, int nstep, int lane) {
    float s[64];
    if (S0) {
#pragma unroll
        for (int k4 = 0; k4 < 16; ++k4) { const f32x4 v = *(const f32x4*)(S0 + lane * 64 + 4 * k4); s[4 * k4] = v[0]; s[4 * k4 + 1] = v[1]; s[4 * k4 + 2] = v[2]; s[4 * k4 + 3] = v[3]; }
    } else {
#pragma unroll
        for (int k = 0; k < 64; ++k) s[k] = SK ? 0.f : (k == lane ? 1.f : 0.f);
    }
    float pf0 = 0.f, pf1 = 0.f, pf2 = 0.f, pf3 = 0.f, pf4 = 0.f;
    for (int t = 0; t < nstep; ++t) {
        asm volatile("" :: "v"(pf0), "v"(pf1), "v"(pf2), "v"(pf3), "v"(pf4));
        { const int tp = (t + 2 < nstep) ? t + 2 : t; const size_t po = (size_t)tp * BW + lane;
          pf0 = KK[po]; pf1 = W[po]; pf2 = KKA[po]; pf3 = KX[po]; pf4 = R[po]; }
        cfloat* kk = (cfloat*)(KK + (size_t)t * BW); cfloat* w = (cfloat*)(W + (size_t)t * BW); cfloat* kka = (cfloat*)(KKA + (size_t)t * BW);
        cfloat* kx = (cfloat*)(KX + (size_t)t * BW); cfloat* r = (cfloat*)(R + (size_t)t * BW);
        float d0 = 0.f, d1 = 0.f;
#pragma unroll
        for (int k = 0; k < 64; k += 2) { d0 = fmaf(s[k], kk[k], d0); d1 = fmaf(s[k + 1], kk[k + 1], d1); }
        const float nd = -(d0 + d1);
        const float vt = SK ? V[(size_t)t * BW + lane] : 0.f;
        float o0 = 0.f, o1 = 0.f;
#pragma unroll
        for (int k = 0; k < 64; k += 2) {
            float x = s[k] * w[k]; x = fmaf(nd, kka[k], x); if (SK) x = fmaf(vt, kx[k], x); s[k] = x; o0 = fmaf(x, r[k], o0);
            float y = s[k + 1] * w[k + 1]; y = fmaf(nd, kka[k + 1], y); if (SK) y = fmaf(vt, kx[k + 1], y); s[k + 1] = y; o1 = fmaf(y, r[k + 1], o1);
        }
        OUT[(size_t)t * BW + lane] = o0 + o1;
    }
    asm volatile("" :: "v"(pf0), "v"(pf1), "v"(pf2), "v"(pf3), "v"(pf4));
    if (STT) {
#pragma unroll
        for (int k = 0; k < 64; ++k) STT[k * 64 + lane] = s[k];
    }
    if (SOUT) {
#pragma unroll
        for (int k4 = 0; k4 < 16; ++k4) *(f32x4*)(SOUT + lane * 64 + 4 * k4) = (f32x4){s[4 * k4], s[4 * k4 + 1], s[4 * k4 + 2], s[4 * k4 + 3]};
    }
}
__device__ __forceinline__ const float* uni_ptr(const float* p) { const unsigned long long v = (unsigned long long)p; const unsigned lo = __builtin_amdgcn_readfirstlane((unsigned)v), hi = __builtin_amdgcn_readfirstlane((unsigned)(v >> 32)); return (const float*)(((unsigned long long)hi << 32) | lo); }
__device__ __forceinline__ void scan_item(Frame& F, int l, int item, unsigned char* ws) {
    const int b = item >> 7, chunk = (item >> 1) & 63, hq = item & 1, h = hq * 4 + (F.wave & 3);
    const size_t ro = ((size_t)(b * SEQ + chunk * 64)) * BW + h * 64; const size_t so = ((size_t)((b * 8 + h) * 64 + chunk)) * 4096;
    const float* R = (const float*)(ws + WS_R + l * SZ_RWL) + ro; const float* W = (const float*)(ws + WS_W + l * SZ_RWL) + ro; const float* KX = (const float*)(ws + WS_KX + l * SZ_RWL) + ro;
    const float* KK = (const float*)(ws + WS_KK + l * SZ_RWL) + ro; const float* KKA = (const float*)(ws + WS_KKA + l * SZ_RWL) + ro; const float* V = (const float*)(ws + WS_V) + ro;
    if (F.wave >> 2) scan_task<true>(uni_ptr(R), uni_ptr(W), uni_ptr(KX), uni_ptr(KK), uni_ptr(KKA), V, (float*)(ws + WS_OL) + ro, (float*)(ws + WS_LC) + so, nullptr, nullptr, 64, F.lane);
    else scan_task<false>(uni_ptr(R), uni_ptr(W), uni_ptr(KX), uni_ptr(KK), uni_ptr(KKA), V, (float*)(ws + WS_PR) + ro, nullptr, nullptr, (float*)(ws + WS_PC) + so, 64, F.lane);
}
__device__ __forceinline__ void scan_sample_item(Frame& F, const Args& a, int l, int sb, unsigned char* ws) {
    const int h = F.wave; const size_t ro = ((size_t)(MP + sb * 4)) * BW + h * 64;
    const float* S0 = (const float*)a.in[5] + ((size_t)((l * NSB + sb) * 8 + h)) * 4096; float* SO = a.out + O_WS + ((size_t)((l * NSB + sb) * 8 + h)) * 4096;
    scan_task<true>(uni_ptr((const float*)(ws + WS_R + l * SZ_RWL) + ro), uni_ptr((const float*)(ws + WS_W + l * SZ_RWL) + ro), uni_ptr((const float*)(ws + WS_KX + l * SZ_RWL) + ro), uni_ptr((const float*)(ws + WS_KK + l * SZ_RWL) + ro), uni_ptr((const float*)(ws + WS_KKA + l * SZ_RWL) + ro),
                    (const float*)(ws + WS_V) + ro, (float*)(ws + WS_OL) + ro, nullptr, S0, SO, 4, F.lane);
}
__device__ __forceinline__ float4 ld4(const float* p) { return *(const float4*)p; }
__device__ __forceinline__ void decode_item(Frame& F, const Args& a, int l, int item, unsigned char* ws) {
    const int sb = item >> 6, seg = item & 63, lane = F.lane, w = F.wave, tid = F.tid;
    LAS float* OM = (LAS float*)F.lds; LAS float* BT = OM + 256 * 16; LAS float* SEGT = BT + 256 * 16;
    const float* QS = (const float*)(ws + WS_QS); const int* pt = (const int*)a.in[4] + sb * NPAGES;
    const float* ck = (const float*)a.in[2] + (size_t)l * NPHYS * 128 * 512; const float* cv = (const float*)a.in[3] + (size_t)l * NPHYS * 128 * 512;
    const float* bias = (const float*)a.in[17] + l * 4;
    f32x4 Qr[4][2];
#pragma unroll
    for (int qi = 0; qi < 4; ++qi)
#pragma unroll
        for (int g = 0; g < 2; ++g) Qr[qi][g] = *(const f32x4*)(QS + (size_t)(sb * 4 + qi) * BW + g * 256 + 4 * lane);
    const int page = pt[seg * 2 + (w >> 2)];
    const size_t rbase = ((size_t)page * 128 + (w & 3) * 32) * 512;
    const int b4 = (lane >> 4) & 1, b3 = (lane >> 3) & 1, b2 = (lane >> 2) & 1;
    const int vidx = b4 * 4 + b3 * 2 + b2, qi_m = vidx >> 1, head_m = (vidx & 1) * 2 + (lane >> 5);
    const float bias_m = bias[head_m] * LOG2E;
    {
        f32x4 ka[4][2], kb[4][2];
#define DEC_LOADK(dst, i0) do { asm volatile("" ::: "memory"); _Pragma("unroll") for (int u = 0; u < 4; ++u) { const float* kr = ck + rbase + (size_t)((i0) + u) * 512; dst[u][0] = __builtin_nontemporal_load((const f32x4*)(kr + 4 * lane)); dst[u][1] = __builtin_nontemporal_load((const f32x4*)(kr + 256 + 4 * lane)); } } while (0)
#define DEC_SCORE(src, i0) do { _Pragma("unroll") for (int u = 0; u < 4; ++u) { \
            float v[8]; \
            _Pragma("unroll") for (int qi = 0; qi < 4; ++qi) { const f32x4 p0 = src[u][0] * Qr[qi][0], p1 = src[u][1] * Qr[qi][1]; v[qi * 2] = (p0[0] + p0[1]) + (p0[2] + p0[3]); v[qi * 2 + 1] = (p1[0] + p1[1]) + (p1[2] + p1[3]); } \
            float r4[4], r2[2], r1; \
            _Pragma("unroll") for (int j = 0; j < 4; ++j) { const float snd = b4 ? v[j] : v[4 + j], kp = b4 ? v[4 + j] : v[j]; r4[j] = kp + __shfl_xor(snd, 16); } \
            _Pragma("unroll") for (int j = 0; j < 2; ++j) { const float snd = b3 ? r4[j] : r4[2 + j], kp = b3 ? r4[2 + j] : r4[j]; r2[j] = kp + __shfl_xor(snd, 8); } \
            { const float snd = b2 ? r2[0] : r2[1], kp = b2 ? r2[1] : r2[0]; r1 = kp + __shfl_xor(snd, 4); } \
            r1 += __shfl_xor(r1, 2); r1 += __shfl_xor(r1, 1); \
            const float e = ex2(r1 + bias_m), om = rcpf_(1.0f + e), bt = e * om; \
            if ((lane & 3) == 0) { const int kl = w * 32 + (i0) + u; OM[kl * 16 + qi_m * 4 + head_m] = om; BT[kl * 16 + qi_m * 4 + head_m] = bt; } } } while (0)
        DEC_LOADK(ka, 0); DEC_LOADK(kb, 4); DEC_SCORE(ka, 0); DEC_LOADK(ka, 8); DEC_SCORE(kb, 4); DEC_LOADK(kb, 12); DEC_SCORE(ka, 8); DEC_LOADK(ka, 16); DEC_SCORE(kb, 12); DEC_LOADK(kb, 20); DEC_SCORE(ka, 16); DEC_LOADK(ka, 24); DEC_SCORE(kb, 20); DEC_LOADK(kb, 28); DEC_SCORE(ka, 24); DEC_SCORE(kb, 28);
#undef DEC_LOADK
#undef DEC_SCORE
    }
    LDS_WAIT(); __syncthreads();
    {
        const int qh = tid & 15, sg = tid >> 4;
        float pr = 1.f;
#pragma unroll
        for (int j = 0; j < 8; ++j) pr *= OM[(sg * 8 + j) * 16 + qh];
        SEGT[sg * 16 + qh] = pr;
        LDS_WAIT(); __syncthreads();
        float suf = 1.f;
        for (int s2 = 31; s2 > sg; --s2) suf *= SEGT[s2 * 16 + qh];
#pragma unroll
        for (int j = 7; j >= 0; --j) { const int kl = sg * 8 + j; const float att = BT[kl * 16 + qh] * suf; suf *= OM[kl * 16 + qh]; BT[kl * 16 + qh] = att; }
        if (sg == 0) ((float*)(ws + WS_TSEG))[(size_t)(sb * 64 + seg) * 16 + qh] = suf;
    }
    LDS_WAIT(); __syncthreads();
    f32x4 O[4][2];
#pragma unroll
    for (int qi = 0; qi < 4; ++qi) { O[qi][0] = (f32x4){0.f, 0.f, 0.f, 0.f}; O[qi][1] = O[qi][0]; }
    const int hh = lane >> 5;
    {
        f32x4 va[4][2], vb[4][2];
#define DEC_LOADV(dst, i0) do { asm volatile("" ::: "memory"); _Pragma("unroll") for (int u = 0; u < 4; ++u) { const float* vr = cv + rbase + (size_t)((i0) + u) * 512; dst[u][0] = __builtin_nontemporal_load((const f32x4*)(vr + 4 * lane)); dst[u][1] = __builtin_nontemporal_load((const f32x4*)(vr + 256 + 4 * lane)); } } while (0)
#define DEC_ACC(src, i0) do { _Pragma("unroll") for (int u = 0; u < 4; ++u) { const int kl = w * 32 + (i0) + u; \
            _Pragma("unroll") for (int qi = 0; qi < 4; ++qi) { const float a0 = BT[kl * 16 + qi * 4 + hh], a1 = BT[kl * 16 + qi * 4 + 2 + hh]; O[qi][0] += src[u][0] * a0; O[qi][1] += src[u][1] * a1; } } } while (0)
        DEC_LOADV(va, 0); DEC_LOADV(vb, 4); DEC_ACC(va, 0); DEC_LOADV(va, 8); DEC_ACC(vb, 4); DEC_LOADV(vb, 12); DEC_ACC(va, 8); DEC_LOADV(va, 16); DEC_ACC(vb, 12); DEC_LOADV(vb, 20); DEC_ACC(va, 16); DEC_LOADV(va, 24); DEC_ACC(vb, 20); DEC_LOADV(vb, 28); DEC_ACC(va, 24); DEC_ACC(vb, 28);
#undef DEC_LOADV
#undef DEC_ACC
    }
    __syncthreads();
    LAS float* RED = (LAS float*)F.lds;
#pragma unroll
    for (int qi = 0; qi < 4; ++qi)
#pragma unroll
        for (int g = 0; g < 2; ++g) { LAS float* d = RED + ((w * 16 + qi * 4 + g * 2 + hh) * 128 + 4 * (lane & 31)); d[0] = O[qi][g][0]; d[1] = O[qi][g][1]; d[2] = O[qi][g][2]; d[3] = O[qi][g][3]; }
    LDS_WAIT(); __syncthreads();
    { f32x4 s = (f32x4){0.f, 0.f, 0.f, 0.f};
#pragma unroll
      for (int j = 0; j < 8; ++j) { const LAS float* p = RED + j * 2048 + tid * 4; s += (f32x4){p[0], p[1], p[2], p[3]}; }
      *(f32x4*)((float*)(ws + WS_OSEG) + (size_t)(sb * 64 + seg) * 2048 + tid * 4) = s; }
    __syncthreads();
}

__device__ __forceinline__ void attn_unit(Frame& F, int b, int h, int qt, int kb_lo, int nkb, const bf16* QB, const bf16* KB, const bf16* VT, bf16* OUT, float bias2, f32x4* part, float* tpart) {
    LAS bf16* Ks = (LAS bf16*)F.lds;
    LAS bf16* Vs = (LAS bf16*)(F.lds + 34816);
    const int w = F.wave, lane = F.lane, li = lane & 15, g = lane >> 4, tid = F.tid;
    const int q0 = qt * 128 + w * 16, qpos = q0 + li;
    bf16x8 qf[4];
    { const bf16* qp = QB + (size_t)(b * SEQ + qpos) * BW + h * 128 + 8 * g;
#pragma unroll
      for (int ks = 0; ks < 4; ++ks) qf[ks] = *(const bf16x8*)(qp + 32 * ks); }
    f32x4 oacc[8];
#pragma unroll
    for (int dt = 0; dt < 8; ++dt) oacc[dt] = (f32x4){0.f, 0.f, 0.f, 0.f};
    float carry = 1.f;
    const int kr0 = tid >> 4, kc0 = (tid & 15) * 8;
    const int vr0 = tid >> 3, vc0 = (tid & 7) * 8;
    const bf16* kg = KB + (size_t)(b * SEQ) * BW + h * 128 + kc0;
    const bf16* vg = VT + (size_t)((b * 4 + h) * 128) * SEQ + vc0;
    u32x4 lk[2], lv[2];
    { const int kb = kb_lo + nkb - 1;
      lk[0] = *(const u32x4*)(kg + (size_t)(kb * 64 + kr0) * BW); lk[1] = *(const u32x4*)(kg + (size_t)(kb * 64 + kr0 + 32) * BW);
      lv[0] = *(const u32x4*)(vg + (size_t)vr0 * SEQ + kb * 64); lv[1] = *(const u32x4*)(vg + (size_t)(vr0 + 64) * SEQ + kb * 64);
      *(LAS u32x4*)(Ks + kr0 * 136 + kc0) = lk[0]; *(LAS u32x4*)(Ks + (kr0 + 32) * 136 + kc0) = lk[1];
      *(LAS u32x4*)(Vs + vr0 * 72 + vc0) = lv[0]; *(LAS u32x4*)(Vs + (vr0 + 64) * 72 + vc0) = lv[1]; }
    LDS_WAIT(); __syncthreads();
    for (int it = 0; it < nkb; ++it) {
        const int kb = kb_lo + nkb - 1 - it, buf = it & 1; const bool more = (it + 1 < nkb);
        if (more) { const int k2 = kb - 1;
            lk[0] = *(const u32x4*)(kg + (size_t)(k2 * 64 + kr0) * BW); lk[1] = *(const u32x4*)(kg + (size_t)(k2 * 64 + kr0 + 32) * BW);
            lv[0] = *(const u32x4*)(vg + (size_t)vr0 * SEQ + k2 * 64); lv[1] = *(const u32x4*)(vg + (size_t)(vr0 + 64) * SEQ + k2 * 64); }
        if (kb * 64 < q0 + 15) {
            const LAS bf16* Kb = Ks + buf * (64 * 136); const LAS bf16* Vb = Vs + buf * (128 * 72);
            f32x4 s[4];
#pragma unroll
            for (int st = 0; st < 4; ++st) { s[st] = (f32x4){bias2, bias2, bias2, bias2};
#pragma unroll
                for (int ks = 0; ks < 4; ++ks) { const bf16x8 af = *(const LAS bf16x8*)(Kb + (16 * st + li) * 136 + 32 * ks + 8 * g); s[st] = __builtin_amdgcn_mfma_f32_16x16x32_bf16(af, qf[ks], s[st], 0, 0, 0); } }
            float om[4][4], bt[4][4], lt[4], X[4], GT[4];
            if (kb * 64 + 63 >= q0) {
                const int kbase = kb * 64 + 4 * g;
#pragma unroll
                for (int st = 0; st < 4; ++st)
#pragma unroll
                    for (int r = 0; r < 4; ++r) { const float e = ex2(s[st][r]); float o = rcpf_(1.0f + e), bb = e * o;
                        if (kbase + 16 * st + r >= qpos) { o = 1.f; bb = 0.f; }
                        om[st][r] = o; bt[st][r] = bb; }
            } else {
#pragma unroll
                for (int st = 0; st < 4; ++st)
#pragma unroll
                    for (int r = 0; r < 4; ++r) { const float e = ex2(s[st][r]); const float o = rcpf_(1.0f + e); om[st][r] = o; bt[st][r] = e * o; }
            }
#pragma unroll
            for (int st = 0; st < 4; ++st) {
                const float sp2 = om[st][3], sp1 = sp2 * om[st][2], sp0 = sp1 * om[st][1]; lt[st] = sp0 * om[st][0];
                bt[st][2] *= sp2; bt[st][1] *= sp1; bt[st][0] *= sp0;
                const float xa = __shfl_xor(lt[st], 16), xb = __shfl_xor(lt[st], 32), xc = __shfl_xor(lt[st], 48);
                X[st] = (g == 0) ? xa * xb * xc : (g == 1) ? xb * xc : (g == 2) ? xa : 1.f;
                GT[st] = lt[st] * xa * xb * xc;
            }
            const float Y3 = carry, Y2 = Y3 * GT[3], Y1 = Y2 * GT[2], Y0 = Y1 * GT[1];
            carry = Y0 * GT[0];
            const float f[4] = {Y0 * X[0], Y1 * X[1], Y2 * X[2], Y3 * X[3]};
            bf16x8 pf[2];
#pragma unroll
            for (int ks = 0; ks < 2; ++ks) { u32x4 pw; pw.x = pk2(bt[2 * ks][0] * f[2 * ks], bt[2 * ks][1] * f[2 * ks]); pw.y = pk2(bt[2 * ks][2] * f[2 * ks], bt[2 * ks][3] * f[2 * ks]);
                pw.z = pk2(bt[2 * ks + 1][0] * f[2 * ks + 1], bt[2 * ks + 1][1] * f[2 * ks + 1]); pw.w = pk2(bt[2 * ks + 1][2] * f[2 * ks + 1], bt[2 * ks + 1][3] * f[2 * ks + 1]); pf[ks] = __builtin_bit_cast(bf16x8, pw); }
#pragma unroll
            for (int dt = 0; dt < 8; ++dt)
#pragma unroll
                for (int ks = 0; ks < 2; ++ks) { const LAS bf16* vp = Vb + (16 * dt + li) * 72 + 32 * ks + 4 * g;
                    const u32x2 a0 = *(const LAS u32x2*)vp, a1 = *(const LAS u32x2*)(vp + 16); const u32x4 av = (u32x4){a0.x, a0.y, a1.x, a1.y};
                    oacc[dt] = __builtin_amdgcn_mfma_f32_16x16x32_bf16(__builtin_bit_cast(bf16x8, av), pf[ks], oacc[dt], 0, 0, 0); }
        }
        if (more) { const int nb = buf ^ 1;
            *(LAS u32x4*)(Ks + nb * (64 * 136) + kr0 * 136 + kc0) = lk[0]; *(LAS u32x4*)(Ks + nb * (64 * 136) + (kr0 + 32) * 136 + kc0) = lk[1];
            *(LAS u32x4*)(Vs + nb * (128 * 72) + vr0 * 72 + vc0) = lv[0]; *(LAS u32x4*)(Vs + nb * (128 * 72) + (vr0 + 64) * 72 + vc0) = lv[1]; }
        LDS_WAIT(); __syncthreads();
    }
    if (part) {
#pragma unroll
        for (int dt = 0; dt < 8; ++dt) part[(w * 8 + dt) * 64 + lane] = oacc[dt];
        if (tpart) tpart[w * 64 + lane] = carry;
    } else {
        bf16* op = OUT + (size_t)(b * SEQ + qpos) * BW + h * 128 + 4 * g;
#pragma unroll
        for (int dt = 0; dt < 8; ++dt) *(u32x2*)(op + 16 * dt) = (u32x2){pk2(oacc[dt][0], oacc[dt][1]), pk2(oacc[dt][2], oacc[dt][3])};
    }
}
__device__ __forceinline__ void attn_combine_item(Frame& F, int item, unsigned char* ws, bf16* OUT) {
    const int bh = item >> 4, q16 = item & 15, qt = 16 + q16, b = bh >> 2, h = bh & 3, w = F.wave, lane = F.lane, li = lane & 15, g = lane >> 4;
    const size_t base = (size_t)(bh * 16 + q16);
    const float* pl = (const float*)(ws + WS_OPART) + (base * 2 + 0) * 16384 + (size_t)(w * 8 * 64 + lane) * 4;
    const float* pr = (const float*)(ws + WS_OPART) + (base * 2 + 1) * 16384 + (size_t)(w * 8 * 64 + lane) * 4;
    const float t = ((const float*)(ws + WS_TPART))[base * 512 + w * 64 + lane];
    bf16* op = OUT + (size_t)(b * SEQ + qt * 128 + w * 16 + li) * BW + h * 128 + 4 * g;
#pragma unroll
    for (int dt = 0; dt < 8; ++dt) { const f32x4 a = *(const f32x4*)(pr + dt * 256), c = *(const f32x4*)(pl + dt * 256); const f32x4 o = a + c * t; *(u32x2*)(op + 16 * dt) = (u32x2){pk2(o[0], o[1]), pk2(o[2], o[3])}; }
}
#define CARRY_BAR() do { asm volatile("s_waitcnt lgkmcnt(0)" ::: "memory"); __builtin_amdgcn_s_barrier(); asm volatile("" ::: "memory"); } while (0)
__device__ __forceinline__ void carry_item(Frame& F, const Args& a, int l, int bh, unsigned char* ws) {
    const int lane = F.lane, w = F.wave, bi = w & 1, bj = (w >> 1) & 1, kh = w >> 2, l31 = lane & 31, hi = lane >> 5;
    LAS float* St = (LAS float*)F.lds;
    LAS float* Pp = (LAS float*)(F.lds + 16384);
    const float* PC = (const float*)(ws + WS_PC) + (size_t)bh * 64 * 4096; const float* LC = (const float*)(ws + WS_LC) + (size_t)bh * 64 * 4096; float* SS = (float*)(ws + WS_SS) + (size_t)bh * 64 * 4096;
    for (int i = F.tid; i < 4096; i += 512) { St[i] = 0.f; SS[i] = 0.f; }
    const int lo_p = (32 * kh + hi) * 64 + 32 * bi + l31, lo_s = (32 * kh + hi) * 64 + 32 * bj + l31, lo_o = (32 * bi + 4 * hi) * 64 + 32 * bj + l31;
    float afn[16], ltn[16];
#pragma unroll
    for (int kk2 = 0; kk2 < 16; ++kk2) afn[kk2] = PC[lo_p + kk2 * 128];
#pragma unroll
    for (int r = 0; r < 16; ++r) ltn[r] = (kh == 0) ? LC[lo_o + ((r & 3) + 8 * (r >> 2)) * 64] : 0.f;
    CARRY_BAR();
    for (int c = 0; c < 64; ++c) {
        float af[16], lt[16];
#pragma unroll
        for (int i = 0; i < 16; ++i) { af[i] = afn[i]; lt[i] = ltn[i]; }
        if (c < 63) {
            const float* Pn = PC + (size_t)(c + 1) * 4096; const float* Ln = LC + (size_t)(c + 1) * 4096;
#pragma unroll
            for (int kk2 = 0; kk2 < 16; ++kk2) afn[kk2] = Pn[lo_p + kk2 * 128];
            if (kh == 0) {
#pragma unroll
                for (int r = 0; r < 16; ++r) ltn[r] = Ln[lo_o + ((r & 3) + 8 * (r >> 2)) * 64];
            }
        }
        float bfv[16];
#pragma unroll
        for (int kk2 = 0; kk2 < 16; ++kk2) bfv[kk2] = St[lo_s + kk2 * 128];
        f32x16 acc0, acc1;
#pragma unroll
        for (int r = 0; r < 16; ++r) { acc0[r] = 0.f; acc1[r] = 0.f; }
#pragma unroll
        for (int kk2 = 0; kk2 < 16; kk2 += 2) { acc0 = __builtin_amdgcn_mfma_f32_32x32x2f32(af[kk2], bfv[kk2], acc0, 0, 0, 0); acc1 = __builtin_amdgcn_mfma_f32_32x32x2f32(af[kk2 + 1], bfv[kk2 + 1], acc1, 0, 0, 0); }
        if (kh == 1) {
#pragma unroll
            for (int r = 0; r < 16; ++r) Pp[(bj * 2 + bi) * 1024 + r * 64 + lane] = acc0[r] + acc1[r];
        }
        CARRY_BAR();
        if (kh == 0) {
            float* so = SS + (size_t)(c + 1) * 4096;
#pragma unroll
            for (int r = 0; r < 16; ++r) { const int jo = ((r & 3) + 8 * (r >> 2)) * 64;
                const float nv = (acc0[r] + acc1[r]) + Pp[(bj * 2 + bi) * 1024 + r * 64 + lane] + lt[r];
                St[lo_o + jo] = nv;
                if (c < 63) so[lo_o + jo] = nv;
                else { const int j = 32 * bi + (r & 3) + 8 * (r >> 2) + 4 * hi, v = 32 * bj + l31; a.out[O_WP + ((size_t)(l * 16 + bh)) * 4096 + v * 64 + j] = nv; } }
        }
        CARRY_BAR();
    }
}

__device__ __forceinline__ void fixup_item(Frame& F, const Args& a, int l, int item, unsigned char* ws, bf16* ACTC) {
    const int b = item >> 7, chunk = (item >> 1) & 63, h = (item & 1) * 4 + (F.wave >> 1), th = F.wave & 1, lane = F.lane, l31 = lane & 31, hi = lane >> 5;
    LAS float* pr = (LAS float*)(F.lds + F.wave * 8704);
    LAS float* stt = pr + 2080;
    const size_t ro = ((size_t)(b * SEQ + chunk * 64 + 32 * th)) * BW + h * 64;
    const float* PR = (const float*)(ws + WS_PR) + ro; const float* OL = (const float*)(ws + WS_OL) + ro;
    const float* St = (const float*)(ws + WS_SS) + ((size_t)((b * 8 + h) * 64 + chunk)) * 4096;
    f32x16 acc[2];
    const float gg = ((const float*)a.in[28])[l * 512 + h * 64 + lane], gb = ((const float*)a.in[29])[l * 512 + h * 64 + lane];
    const float* Vv = (const float*)(ws + WS_V) + ro; const float* GG = (const float*)(ws + WS_GG) + ro; const float* RK = (const float*)(ws + WS_RK) + ((size_t)(b * SEQ + chunk * 64 + 32 * th)) * 8 + h;
    float b0[32], b1[32];
    {
        float prv[32];
#pragma unroll
        for (int t = 0; t < 32; ++t) prv[t] = PR[(size_t)t * BW + lane];
#pragma unroll
        for (int vj = 0; vj < 2; ++vj)
#pragma unroll
            for (int r = 0; r < 16; ++r) acc[vj][r] = OL[(size_t)((r & 3) + 8 * (r >> 2) + 4 * hi) * BW + 32 * vj + l31];
        if (chunk > 0) {
#pragma unroll
            for (int j = 0; j < 32; ++j) { const int m = 2 * j + hi; b0[j] = St[m * 64 + l31]; b1[j] = St[m * 64 + 32 + l31]; }
        }
#pragma unroll
        for (int t = 0; t < 32; ++t) pr[t * 65 + lane] = prv[t];
    }
    LDS_WAIT();
    if (chunk > 0) {
#pragma unroll
        for (int j = 0; j < 32; ++j) { const int m = 2 * j + hi; const float a0 = pr[l31 * 65 + m];
            acc[0] = __builtin_amdgcn_mfma_f32_32x32x2f32(a0, b0[j], acc[0], 0, 0, 0); acc[1] = __builtin_amdgcn_mfma_f32_32x32x2f32(a0, b1[j], acc[1], 0, 0, 0); }
    }
    float vv[32], gv[32], rk[32];
#pragma unroll
    for (int t = 0; t < 32; ++t) { vv[t] = Vv[(size_t)t * BW + lane]; gv[t] = GG[(size_t)t * BW + lane]; rk[t] = RK[(size_t)t * 8]; }
#pragma unroll
    for (int vj = 0; vj < 2; ++vj)
#pragma unroll
        for (int r = 0; r < 16; ++r) pr[((r & 3) + 8 * (r >> 2) + 4 * hi) * 65 + 32 * vj + l31] = acc[vj][r];
    LDS_WAIT();
    if (lane < 32) { float s1 = 0.f;
#pragma unroll 16
        for (int v = 0; v < 64; ++v) s1 += pr[lane * 65 + v];
        const float mean = s1 * (1.f / 64.f); float s2 = 0.f;
#pragma unroll 16
        for (int v = 0; v < 64; ++v) { const float d = pr[lane * 65 + v] - mean; s2 = fmaf(d, d, s2); }
        stt[lane * 2] = mean; stt[lane * 2 + 1] = 1.0f / sqrtf(s2 * (1.f / 64.f) + 64e-5f); }
    LDS_WAIT();
    bf16* op = ACTC + (size_t)(b * SEQ + chunk * 64 + 32 * th) * BW + h * 64 + lane;
#pragma unroll
    for (int t = 0; t < 32; ++t) {
        const float y = ((pr[t * 65 + lane] - stt[t * 2]) * stt[t * 2 + 1] * gg + gb + rk[t] * vv[t]) * gv[t];
        op[(size_t)t * BW] = (bf16)f2bf(y); }
    LDS_WAIT();
}
__device__ __forceinline__ void cpost_sample_item(Frame& F, const Args& a, int l, int part, unsigned char* ws, bf16* ACTC) {
    const int h = F.wave, lane = F.lane;
    const float gg = ((const float*)a.in[28])[l * 512 + h * 64 + lane], gb = ((const float*)a.in[29])[l * 512 + h * 64 + lane];
    float xo[8], vv[8], gv[8], rk[8];
#pragma unroll
    for (int j = 0; j < 8; ++j) { const int r = part * 8 + j; const size_t o = (size_t)(MP + r) * BW + h * 64 + lane;
        xo[j] = ((const float*)(ws + WS_OL))[o]; vv[j] = ((const float*)(ws + WS_V))[o]; gv[j] = ((const float*)(ws + WS_GG))[o]; rk[j] = ((const float*)(ws + WS_RK))[(size_t)(MP + r) * 8 + h]; }
#pragma unroll
    for (int j = 0; j < 8; ++j) { const int r = part * 8 + j; const size_t o = (size_t)(MP + r) * BW + h * 64 + lane;
        float x = xo[j];
        const float mean = wave_sum(x) * (1.f / 64.f); x -= mean;
        const float rstd = 1.0f / sqrtf(wave_sum(x * x) * (1.f / 64.f) + 64e-5f);
        ACTC[o] = (bf16)f2bf((x * rstd * gg + gb + rk[j] * vv[j]) * gv[j]); }
}
__device__ __forceinline__ void decode_combine_item(Frame& F, const Args& a, int l, int qi, unsigned char* ws, bf16* ACTB) {
    const int sb = F.wave, lane = F.lane, hh = lane >> 5;
    const float* QS = (const float*)(ws + WS_QS); const float* OSEG = (const float*)(ws + WS_OSEG); const float* TSEG = (const float*)(ws + WS_TSEG);
    const float* bias = (const float*)a.in[17] + l * 4; const float bz[2] = {bias[hh] * LOG2E, bias[2 + hh] * LOG2E};
    const float* kn = a.out + O_KS + ((size_t)l * MS + sb * 4) * 512; const float* vn = a.out + O_VS + ((size_t)l * MS + sb * 4) * 512;
    float one = 1.f; asm volatile("" : "+v"(one));
    f32x4 O[2] = {(f32x4){0.f, 0.f, 0.f, 0.f}, (f32x4){0.f, 0.f, 0.f, 0.f}}; float carry[2] = {one, one};
    f32x4 q[2];
#pragma unroll
    for (int g = 0; g < 2; ++g) q[g] = *(const f32x4*)(QS + (size_t)(sb * 4 + qi) * BW + g * 256 + 4 * lane);
    for (int j = qi - 1; j >= 0; --j) {
#pragma unroll
        for (int g = 0; g < 2; ++g) {
            const f32x4 kv = *(const f32x4*)(kn + (size_t)j * 512 + g * 256 + 4 * lane), p = kv * q[g];
            float d = (p[0] + p[1]) + (p[2] + p[3]);
#pragma unroll
            for (int o = 1; o < 32; o <<= 1) d += __shfl_xor(d, o);
            const float e = ex2(d + bz[g]), om = rcpf_(1.0f + e), att = e * om * carry[g];
            O[g] += *(const f32x4*)(vn + (size_t)j * 512 + g * 256 + 4 * lane) * att; carry[g] *= om;
        }
    }
#pragma unroll 1
    for (int hs = 1; hs >= 0; --hs) {
        float tv[2][32];
#pragma unroll
        for (int g = 0; g < 2; ++g)
#pragma unroll
            for (int sg = 0; sg < 32; ++sg) tv[g][sg] = TSEG[(size_t)(sb * 64 + hs * 32 + sg) * 16 + qi * 4 + g * 2 + hh];
#pragma unroll
        for (int g = 0; g < 2; ++g) { float c = carry[g];
#pragma unroll
            for (int sg = 31; sg >= 0; --sg) { const float t = tv[g][sg]; tv[g][sg] = c; c *= t; }
            carry[g] = c; }
#pragma unroll
        for (int sb8 = 0; sb8 < 4; ++sb8) {
            f32x4 ov[2][8];
#pragma unroll
            for (int g = 0; g < 2; ++g)
#pragma unroll
                for (int j = 0; j < 8; ++j) { const int seg = hs * 32 + sb8 * 8 + j; ov[g][j] = *(const f32x4*)(OSEG + ((size_t)(sb * 64 + seg) * 16 + qi * 4 + g * 2 + hh) * 128 + 4 * (lane & 31)); }
#pragma unroll
            for (int g = 0; g < 2; ++g)
#pragma unroll
                for (int j = 0; j < 8; ++j) O[g] += ov[g][j] * tv[g][sb8 * 8 + j];
        }
    }
    bf16* op = ACTB + (size_t)(MP + sb * 4 + qi) * BW;
#pragma unroll
    for (int g = 0; g < 2; ++g) *(u32x2*)(op + g * 256 + 4 * lane) = (u32x2){pk2(O[g][0], O[g][1]), pk2(O[g][2], O[g][3])};
}

template <int MODE>
__device__ __forceinline__ void skinny_rows(Frame& F, const bf16* A, size_t sA, const bf16* Bt, size_t sB, int K, const bf16* G, bf16* MB, const float* res, float* out, bf16* Hn, const float* gn, float* rs) {
    constexpr int NBR = (MODE == 0) ? 4 : 1;
    const int u = F.vcu; if (u >= 256) return;
    const int rt = u & 1, ct = u >> 1, lane = F.lane, li = lane & 15, q = lane >> 4, w = F.wave;
    LAS f32x4* red = (LAS f32x4*)F.lds;
    f32x4 acc[NBR];
    const int nks = K / 32;
#pragma unroll
    for (int b = 0; b < NBR; ++b) {
        acc[b] = (f32x4){0.f, 0.f, 0.f, 0.f};
        const bf16* ap = A + (size_t)b * sA + (size_t)(MP + 16 * rt + li) * K + 8 * q;
        const bf16* bp = Bt + (size_t)b * sB + (size_t)(16 * ct + li) * K + 8 * q;
#pragma unroll 4
        for (int ks = w; ks < nks; ks += 8) {
            const bf16x8 av = *(const bf16x8*)(ap + 32 * ks), bv = *(const bf16x8*)(bp + 32 * ks);
            acc[b] = __builtin_amdgcn_mfma_f32_16x16x32_bf16(bv, av, acc[b], 0, 0, 0);
        }
        red[(w * NBR + b) * 64 + lane] = acc[b];
    }
    LDS_WAIT(); __syncthreads();
    if (w == 0) {
        const int row = MP + 16 * rt + li, col = 16 * ct + 4 * q;
        f32x4 tot = (f32x4){0.f, 0.f, 0.f, 0.f};
#pragma unroll
        for (int b = 0; b < NBR; ++b) {
            f32x4 v = red[b * 64 + lane];
#pragma unroll
            for (int j = 1; j < 8; ++j) v += red[(j * NBR + b) * 64 + lane];
            if (MODE == 0) { const u32x2 gw = *(const u32x2*)(G + (size_t)row * NGATE + (size_t)b * D + col);
                const f32x4 gf = (f32x4){__builtin_bit_cast(float, gw.x << 16), __builtin_bit_cast(float, gw.x & 0xffff0000u), __builtin_bit_cast(float, gw.y << 16), __builtin_bit_cast(float, gw.y & 0xffff0000u)};
                tot += v * gf; }
            else tot += v;
        }
        if (MODE == 0) *(u32x2*)(MB + (size_t)row * D + col) = (u32x2){pk2(tot[0], tot[1]), pk2(tot[2], tot[3])};
        else { const f32x4 v = *(const f32x4*)(res + (size_t)(row - MP) * D + col) + tot; *(f32x4*)(out + (size_t)(row - MP) * D + col) = v;
            if (Hn) { const f32x4 h = v * *(const f32x4*)(gn + col); *(u32x2*)(Hn + (size_t)row * D + col) = (u32x2){pk2(h[0], h[1]), pk2(h[2], h[3])};
                float ss = (v[0] * v[0] + v[1] * v[1]) + (v[2] * v[2] + v[3] * v[3]); ss += __shfl_xor(ss, 16); ss += __shfl_xor(ss, 32);
                if (q == 0) (void)__hip_atomic_fetch_add(rs + row, ss, __ATOMIC_RELAXED, __HIP_MEMORY_SCOPE_AGENT); } }
    }
    __syncthreads();
}

constexpr int NPH = 1 + NL * 11;
__global__ void __launch_bounds__(512, 2) mk_fwd(Args args) {
    extern __shared__ __attribute__((aligned(16))) unsigned char lds_raw[];
    Frame F; F.lds = (LAS unsigned char*)lds_raw; F.tid = threadIdx.x; F.lane = F.tid & 63; F.wave = __builtin_amdgcn_readfirstlane(F.tid >> 6);
    F.G = gridDim.x; { const int bx = blockIdx.x; F.vcu = (F.G % 8 == 0) ? (bx % 8) * (F.G / 8) + bx / 8 : bx; }
    unsigned char* ws = args.ws;
    volatile LAS unsigned* MISC = (volatile LAS unsigned*)(F.lds + LDS_CTL_OFF);
    for (int u = F.tid; u < (LDS_BYTES - LDS_CTL_OFF) / 4; u += 512) ((LAS unsigned*)(F.lds + LDS_CTL_OFF))[u] = 0u;
    __syncthreads();
    const bool single = (args.ph_hi - args.ph_lo) > 1;
    XcdBarrier bar; bar.bar = (unsigned*)(ws + WS_CTL) + CW_BAR; bar.x = 0; bar.st = nullptr;
    if (single) bar = xcd_barrier_post((unsigned*)(ws + WS_CTL) + CW_BAR, MISC + 8);
    const int lo = args.ph_lo, hi = args.ph_hi; const int sel = args.li ? args.li : 0xff;
#ifndef PH_MASK
#define PH_MASK 0xFFFu
#endif
#define IN(k) (lo <= (k) && (k) < hi)
#define EN(x) (((PH_MASK) >> (x)) & 1u)
#define SEAM(k) do { if (IN(k) && IN((k) + 1)) xcd_barrier(bar); } while (0)

#define PH_PTRS unsigned char* wsp = ws; int lp = l; asm volatile("" : "+s"(wsp), "+s"(lp)); Frame Fp = F; asm volatile("" : "+v"(Fp.tid), "+v"(Fp.lane), "+s"(Fp.wave), "+s"(Fp.vcu)); \
    bf16* H = (bf16*)(wsp + WS_H); bf16* P = (bf16*)(wsp + WS_P); bf16* G = (bf16*)(wsp + WS_G); bf16* ACT = (bf16*)(wsp + WS_ACT); float* MF = (float*)(wsp + WS_MF); bf16* MB = (bf16*)(wsp + WS_MB); \
    float* X1 = (float*)(wsp + WS_X1); bf16* HID = (bf16*)(wsp + WS_HID); float* XL = (float*)(wsp + WS_XL); bf16* QB = (bf16*)(wsp + WS_QB); bf16* KB = (bf16*)(wsp + WS_KB); bf16* VT = (bf16*)(wsp + WS_VT); float* QS = (float*)(wsp + WS_QS); \
    (void)H; (void)P; (void)G; (void)ACT; (void)MF; (void)MB; (void)X1; (void)HID; (void)XL; (void)QB; (void)KB; (void)VT; (void)QS;

    if (IN(0) && EN(11)) { const int l = 0; PH_PTRS; p0_convert(Fp, args); norm_phase(Fp, (const float*)args.in[0], (const float*)args.in[1], (const float*)args.in[8], H); }
    SEAM(0);
    for (int l = 0; l < NL; ++l) {
        const int pb = 1 + l * 11;
        if (IN(pb + 0) && EN(0)) { PH_PTRS;
            pg8::Gemm g{H, (const bf16*)(wsp + WS_WIN + lp * SZ_WIN), MPAD, INW, D, 0, 0}; pg8::StaticOrder S; S.init(MPAD, INW, F.G, (int)blockIdx.x);
            pg8::EpiIn E{P, G, lp > 0 ? (const float*)((unsigned*)(wsp + WS_CTL) + CW_RS + ((lp - 1) * 2 + 1) * MPAD) : nullptr};
            pg8::gemm_phase<pg8::EpiIn, pg8::StaticOrder, true>(Fp.tid, Fp.lds, g, S, E);
        }
        SEAM(pb + 0);
        if (IN(pb + 1) && EN(1)) {
            constexpr int N_C = 257, N_A = 257, N_D = 264, N_B = 257;
            unsigned* qctr = (unsigned*)(ws + WS_CTL) + CW_Q + 64 * (l * 16 + 0);
            volatile LAS int* qslot = (volatile LAS int*)(F.lds + LDS_CTL_OFF + 64);
            int it = F.vcu;
            while (it < N_C + N_A + N_D + N_B) {
                int nx = 0; if (F.tid == 0) nx = 256 + (int)__hip_atomic_fetch_add(qctr, 1u, __ATOMIC_RELAXED, __HIP_MEMORY_SCOPE_AGENT);
                int r = it; PH_PTRS;
                if (r < N_C) { if (sel & 1) cprep_item(Fp, args, lp, r, P, wsp); }
                else if ((r -= N_C) < N_A) { if (sel & 4) { if (r < 256) gmlp_item(Fp, args, lp, r >> 2, r & 3, P, ACT); else gmlp_sample_item(Fp, args, lp, P, ACT); } }
                else if ((r -= N_A) < N_D) { if (sel & 2) dconv_item(Fp, args, lp, r, P, ACT + (size_t)3 * MPAD * BW); }
                else { r -= N_D; if (sel & 8) bprep_item(Fp, args, lp, r, P, QB, KB, VT, QS); }
                if (F.tid == 0) *qslot = nx;
                __syncthreads(); it = __builtin_amdgcn_readfirstlane(*qslot); __syncthreads();
            }
        }
        SEAM(pb + 1);
        if (IN(pb + 2) && EN(2)) {
            for (int it = F.vcu; it < 256; it += F.G) {
                PH_PTRS;
                if (sel & 1) scan_item(Fp, lp, it, wsp);
            }
        }
        SEAM(pb + 2);
        if (IN(pb + 3) && EN(3)) {
            const int u = F.vcu;
            if (u < 256) {
                { PH_PTRS; const int bh = u >> 5, qt = u & 31; if (qt < 2 && (sel & 1)) carry_item(Fp, args, lp, bh * 2 + qt, wsp); }
                if ((u & 31) == 2 && (sel & 1)) { PH_PTRS; scan_sample_item(Fp, args, lp, u >> 5, wsp); }
                {
                    unsigned* actr = (unsigned*)(ws + WS_CTL) + CW_Q + 64 * (l * 16 + 2 + (u >> 5));
                    volatile LAS int* qslot = (volatile LAS int*)(F.lds + LDS_CTL_OFF + 64);
                    for (;;) {
                        if (F.tid == 0) *qslot = (int)__hip_atomic_fetch_add(actr, 1u, __ATOMIC_RELAXED, __HIP_MEMORY_SCOPE_AGENT);
                        __syncthreads(); const int qi = __builtin_amdgcn_readfirstlane(*qslot); __syncthreads();
                        if (qi >= 112) break;
                        const int blk = qi / 7, pos = qi % 7;
                        PH_PTRS; const int bh = u >> 5;
                        if (pos == 0 || pos == 3 || pos == 5) {
                            if (!(sel & 2)) continue;
                            const int pi = 3 * blk + (pos == 0 ? 0 : pos == 3 ? 1 : 2);
                            const float b2 = ((const float*)args.in[17])[lp * 4 + (bh & 3)] * LOG2E;
                            bf16* AO = ACT + (size_t)1 * MPAD * BW;
                            int qt, kb_lo, nkb; f32x4* part = nullptr; float* tp = nullptr;
                            if (pi < 8) { qt = 15 - pi; kb_lo = 0; nkb = 2 * qt + 2; }
                            else if (pi >= 40) { qt = 47 - pi; kb_lo = 0; nkb = 2 * qt + 2; }
                            else { qt = 31 - ((pi - 8) >> 1); const int right = (pi - 8) & 1, q16 = qt - 16; kb_lo = right ? qt + 1 : 0; nkb = qt + 1;
                                part = (f32x4*)(wsp + WS_OPART) + ((size_t)((bh * 16 + q16) * 2 + right)) * 4096;
                                if (right) tp = (float*)(wsp + WS_TPART) + (size_t)(bh * 16 + q16) * 512; }
                            attn_unit(Fp, bh >> 2, bh & 3, qt, kb_lo, nkb, QB, KB, VT, AO, b2, part, tp);
                        } else {
                            if (!(sel & 4)) continue;
                            const int di = 4 * blk + (pos == 1 ? 0 : pos == 2 ? 1 : pos == 4 ? 2 : 3);
                            decode_item(Fp, args, lp, bh * 64 + di, wsp);
                        }
                    }
                }
            }
        }
        SEAM(pb + 3);
        if (IN(pb + 4) && EN(4)) {
            for (int it = F.vcu; it < 256 + 8; it += F.G) {
                PH_PTRS;
                if (it < 256) { fixup_item(Fp, args, lp, it, wsp, ACT + (size_t)2 * MPAD * BW); __syncthreads(); }
                else if (it < 260) cpost_sample_item(Fp, args, lp, it - 256, wsp, ACT + (size_t)2 * MPAD * BW);
                else decode_combine_item(Fp, args, lp, it - 260, wsp, ACT + (size_t)1 * MPAD * BW);
            }
            { const int ci = 255 - F.vcu; if (ci < 128) { PH_PTRS; attn_combine_item(Fp, ci, wsp, ACT + (size_t)1 * MPAD * BW); } }
        }
        SEAM(pb + 4);
        if (IN(pb + 5) && EN(5)) { PH_PTRS;
            pg8::Gemm g{ACT, (const bf16*)(wsp + WS_WBO + lp * SZ_WBO), MP, D, BW, (size_t)MPAD * BW, (size_t)D * BW}; pg8::MergeOrder S; S.so.initn(MP / 256, D / 128, F.G, (int)blockIdx.x);
            pg8::EpiMerge E{G, MB};
            pg8::gemm_phase<pg8::EpiMerge, pg8::MergeOrder, true, 1>(Fp.tid, Fp.lds, g, S, E);
            skinny_rows<0>(Fp, ACT, (size_t)MPAD * BW, (const bf16*)(wsp + WS_WBO + lp * SZ_WBO), (size_t)D * BW, BW, G, MB, nullptr, nullptr, nullptr, nullptr, nullptr);
        }
        SEAM(pb + 5);
        if (IN(pb + 6) && EN(6)) { PH_PTRS;
            const float* xin0 = lp == 0 ? (const float*)args.in[0] : XL; const float* xin1 = lp == 0 ? (const float*)args.in[1] : XL + (size_t)MP * D;
            pg8::Gemm g{MB, (const bf16*)(wsp + WS_WMIX + lp * SZ_WMIX), MP, D, D, 0, 0}; pg8::StaticOrder S; S.init(MP, D, F.G, (int)blockIdx.x);
            float* rsp = (float*)((unsigned*)(wsp + WS_CTL) + CW_RS + (lp * 2 + 0) * MPAD); const float* gnp = (const float*)args.in[37] + lp * D;
            pg8::EpiRes E{xin0, X1, H, gnp, rsp};
            pg8::gemm_phase<pg8::EpiRes, pg8::StaticOrder, true>(Fp.tid, Fp.lds, g, S, E);
            skinny_rows<1>(Fp, MB, 0, (const bf16*)(wsp + WS_WMIX + lp * SZ_WMIX), 0, D, nullptr, nullptr, xin1, X1 + (size_t)MP * D, H, gnp, rsp);
        }
        SEAM(pb + 6);
        if (IN(pb + 8) && EN(8)) { PH_PTRS;
            pg8::Gemm g{H, (const bf16*)(wsp + WS_WGU + lp * SZ_WGU), MPAD, 2 * FF, D, 0, 0}; pg8::StaticOrder S; S.init(MPAD, 2 * FF, F.G, (int)blockIdx.x);
            pg8::EpiGU E{HID, (const float*)((unsigned*)(wsp + WS_CTL) + CW_RS + (lp * 2 + 0) * MPAD)};
            pg8::gemm_phase<pg8::EpiGU, pg8::StaticOrder, true>(Fp.tid, Fp.lds, g, S, E);
        }
        SEAM(pb + 8);
        if (IN(pb + 9) && EN(9)) { PH_PTRS;
            float* yout = lp == NL - 1 ? args.out + O_Y : XL;
            pg8::Gemm g{HID, (const bf16*)(wsp + WS_WDN + lp * SZ_WDN), MP, D, FF, 0, 0}; pg8::StaticOrder S; S.init(MP, D, F.G, (int)blockIdx.x);
            const bool nxt = lp + 1 < NL; float* rsp = (float*)((unsigned*)(wsp + WS_CTL) + CW_RS + (lp * 2 + 1) * MPAD); const float* gnp = (const float*)args.in[8] + (nxt ? lp + 1 : 0) * D;
            pg8::EpiRes E{X1, yout, nxt ? H : nullptr, gnp, rsp};
            pg8::gemm_phase<pg8::EpiRes, pg8::StaticOrder, true>(Fp.tid, Fp.lds, g, S, E);
            skinny_rows<1>(Fp, HID, 0, (const bf16*)(wsp + WS_WDN + lp * SZ_WDN), 0, FF, nullptr, nullptr, X1 + (size_t)MP * D, yout + (size_t)MP * D, nxt ? H : nullptr, gnp, rsp);
        }
        if (l + 1 < NL) SEAM(pb + 9);
    }
#undef IN
#undef SEAM
}

#ifndef MK_PER_PHASE
#define MK_PER_PHASE 0
#endif
extern "C" void kernel_launch(void* const* d_in, const int* in_sizes, int n_in, void* d_out, int out_size, void* d_ws, size_t ws_size, hipStream_t stream) {
    static int grid = 0;
    if (grid == 0) {
        if (n_in != 41 || (size_t)out_size != O_END || ws_size < WS_END) { fprintf(stderr, "kernel_launch: unexpected shapes: n_in %d out %d ws %zu (need %zu)\n", n_in, out_size, ws_size, (size_t)WS_END); grid = -1; return; }
        int dev = 0, cus = 0, per_cu = 0;
        if (hipGetDevice(&dev) != hipSuccess || hipDeviceGetAttribute(&cus, hipDeviceAttributeMultiprocessorCount, dev) != hipSuccess) { grid = -1; return; }
        if (hipFuncSetAttribute((const void*)mk_fwd, hipFuncAttributeMaxDynamicSharedMemorySize, LDS_BYTES) != hipSuccess) { fprintf(stderr, "kernel_launch: hipFuncSetAttribute failed\n"); grid = -1; return; }
        if (hipOccupancyMaxActiveBlocksPerMultiprocessor(&per_cu, (const void*)mk_fwd, 512, LDS_BYTES) != hipSuccess || per_cu < 1) fprintf(stderr, "kernel_launch: occupancy query reports %d\n", per_cu);
        (void)hipGetLastError();
        grid = cus;
        if (grid != 256) fprintf(stderr, "kernel_launch: %d CUs (built for 256)\n", grid);
    }
    if (grid < 0) return;
    (void)hipMemsetAsync((char*)d_ws + WS_CTL, 0, CTL_BYTES, stream);
    Args a{};
    for (int i = 0; i < 41; ++i) a.in[i] = d_in[i];
    a.out = (float*)d_out; a.ws = (unsigned char*)d_ws; a.li = 0; a.pad = 0;
#ifndef MAX_PH
#define MAX_PH NPH
#endif
#if MK_PER_PHASE
    for (int p = 0; p < MAX_PH; ++p) { a.ph_lo = p; a.ph_hi = p + 1; hipLaunchKernelGGL(mk_fwd, dim3(grid), dim3(512), LDS_BYTES, stream, a); }
#else
    a.ph_lo = 0; a.ph_hi = MAX_PH;
    hipLaunchKernelGGL(mk_fwd, dim3(grid), dim3(512), LDS_BYTES, stream, a);
#endif
#ifdef PROBE_PH
    for (int r = 0; r < PROBE_N; ++r) { a.ph_lo = (PROBE_PH < 0) ? 0 : 1 + (NL - 1) * 11 + PROBE_PH; a.ph_hi = a.ph_lo + 1; a.li = PROBE_SEL; hipLaunchKernelGGL(mk_fwd, dim3(grid), dim3(512), LDS_BYTES, stream, a); }
#endif
    const hipError_t le = hipPeekAtLastError();
    if (le != hipSuccess) fprintf(stderr, "kernel_launch: launch failed: %s\n", hipGetErrorName(le));
}
```

```cpp
#include <hip/hip_runtime.h>
#include <cstdio>
#include <cstdint>

#define LAS __attribute__((address_space(3)))
typedef unsigned short bf16;
typedef short bf16x8 __attribute__((ext_vector_type(8)));
typedef float f32x4 __attribute__((ext_vector_type(4)));
typedef float f32x16 __attribute__((ext_vector_type(16)));
typedef float f32x2 __attribute__((ext_vector_type(2)));
typedef unsigned u32x4 __attribute__((ext_vector_type(4)));
typedef unsigned u32x2 __attribute__((ext_vector_type(2)));
typedef const __attribute__((address_space(4))) float cfloat;

constexpr int D = 2048, SEQ = 4096, NL = 2, NSB = 8, NST = 4, NPAGES = 128, NPHYS = 1280;
constexpr int BW = 512, FF = 5632, INW = 13568, NPRE = 5376, NGATE = 8192, CSHIFT = 1792;
constexpr int MP = 8192, MS = 32, MR = 8224, MPAD = 8448;
constexpr int PA0 = 0, PB0 = 1024, PC0 = 2560, PD0 = 4352;
constexpr float LOG2E = 1.4426950408889634f;

constexpr size_t O_Y = 0, O_KP = 16842752, O_VP = 25231360, O_KS = 33619968, O_VS = 33652736, O_WP = 33685504, O_WS = 33816576,
                 O_SHP = 34340864, O_SHS = 34348032, O_CP = 34376704, O_CS = 34438144, O_GV = 34683904, O_END = 34716672;

constexpr size_t al(size_t x) { return (x + 1048575) & ~(size_t)1048575; }
constexpr size_t WS_CTL = 0, CTL_BYTES = 1048576;
constexpr size_t SZ_WIN = (size_t)INW * D * 2, SZ_WBO = (size_t)4 * D * BW * 2, SZ_WMIX = (size_t)D * D * 2, SZ_WGU = (size_t)2 * FF * D * 2, SZ_WDN = (size_t)D * FF * 2, SZ_LW = (size_t)512 * 256 * 2;
constexpr size_t WS_WIN = al(WS_CTL + CTL_BYTES);
constexpr size_t WS_WBO = al(WS_WIN + NL * SZ_WIN);
constexpr size_t WS_WMIX = al(WS_WBO + NL * SZ_WBO);
constexpr size_t WS_WGU = al(WS_WMIX + NL * SZ_WMIX);
constexpr size_t WS_WDN = al(WS_WGU + NL * SZ_WGU);
constexpr size_t WS_LW = al(WS_WDN + NL * SZ_WDN);
constexpr size_t WS_H = al(WS_LW + NL * SZ_LW);
constexpr size_t WS_P = al(WS_H + (size_t)MPAD * D * 2);
constexpr size_t WS_G = al(WS_P + (size_t)MPAD * NPRE * 2);
constexpr size_t WS_ACT = al(WS_G + (size_t)MPAD * NGATE * 2);
constexpr size_t WS_MF = al(WS_ACT + (size_t)4 * MPAD * BW * 2);
constexpr size_t WS_MB = al(WS_MF + 1048576);
constexpr size_t WS_X1 = al(WS_MB + (size_t)MPAD * D * 2);
constexpr size_t WS_HID = al(WS_X1 + (size_t)MPAD * D * 4);
constexpr size_t WS_XL = al(WS_HID + (size_t)MPAD * FF * 2);
constexpr size_t WS_QB = al(WS_XL + (size_t)MPAD * D * 4);
constexpr size_t WS_KB = al(WS_QB + (size_t)MP * BW * 2);
constexpr size_t WS_VT = al(WS_KB + (size_t)MP * BW * 2);
constexpr size_t WS_QS = al(WS_VT + (size_t)MP * BW * 2);
constexpr size_t WS_OSEG = al(WS_QS + (size_t)MS * BW * 4);
constexpr size_t WS_TSEG = al(WS_OSEG + (size_t)8 * 64 * 16 * 128 * 4);
constexpr size_t SZ_RW = (size_t)MR * BW * 4;
constexpr size_t WS_R = al(WS_TSEG + 8 * 64 * 16 * 4);
constexpr size_t SZ_RWL = al(SZ_RW);
constexpr size_t WS_W = WS_R + NL * SZ_RWL, WS_KX = WS_W + NL * SZ_RWL, WS_V = WS_KX + NL * SZ_RWL, WS_KK = al(WS_V + SZ_RW), WS_KKA = WS_KK + NL * SZ_RWL, WS_GG = WS_KKA + NL * SZ_RWL;
constexpr size_t WS_OL = al(WS_GG + SZ_RW), WS_PR = al(WS_OL + SZ_RW);
constexpr size_t WS_RK = al(WS_PR + SZ_RW);
constexpr size_t SZ_CH = (size_t)16 * 64 * 4096 * 4;
constexpr size_t WS_PC = al(WS_RK + (size_t)MR * 8 * 4), WS_LC = al(WS_PC + SZ_CH), WS_SS = al(WS_LC + SZ_CH);
constexpr size_t WS_OPART = al(WS_SS + SZ_CH);
constexpr size_t WS_TPART = al(WS_OPART + (size_t)8 * 16 * 2 * 8 * 8 * 64 * 16);
constexpr size_t WS_END = al(WS_TPART + (size_t)8 * 16 * 8 * 64 * 4);

constexpr int CW_BAR = 4096;
constexpr int CW_RS = 16384;
constexpr int CW_Q = 8192;

constexpr int LDS_BYTES = 147456, LDS_CTL_OFF = 143360;

__device__ __forceinline__ unsigned f2bf(float f) { unsigned u = __builtin_bit_cast(unsigned, f); return (u + 0x7fffu + ((u >> 16) & 1u)) >> 16; }
typedef __bf16 bf16x2_t __attribute__((ext_vector_type(2)));
__device__ __forceinline__ unsigned pk2(float lo, float hi) { const f32x2 v = {lo, hi}; const bf16x2_t b = __builtin_convertvector(v, bf16x2_t); return __builtin_bit_cast(unsigned, b); }
__device__ __forceinline__ float wave_sum(float v) {
#pragma unroll
    for (int o = 1; o < 64; o <<= 1) v += __shfl_xor(v, o);
    return v;
}
__device__ __forceinline__ float ex2(float x) { return __builtin_amdgcn_exp2f(x); }
__device__ __forceinline__ float rcpf_(float x) { return __builtin_amdgcn_rcpf(x); }
__device__ __forceinline__ float sigmoidf_(float x) { return rcpf_(1.0f + ex2(-x * LOG2E)); }
__device__ __forceinline__ float gelu_tanh(float x) {
    const float u = 0.7978845608028654f * (x + 0.044715f * x * x * x);
    const float t = 1.0f - 2.0f * rcpf_(1.0f + ex2(2.0f * LOG2E * u));
    return 0.5f * x * (1.0f + t);
}
__device__ __forceinline__ f32x4 ldb4(const bf16* p) { const u32x2 w = *(const u32x2*)p; return (f32x4){__builtin_bit_cast(float, w.x << 16), __builtin_bit_cast(float, w.x & 0xffff0000u), __builtin_bit_cast(float, w.y << 16), __builtin_bit_cast(float, w.y & 0xffff0000u)}; }
#define GAS1 __attribute__((address_space(1)))
#define LDS_WAIT() asm volatile("s_waitcnt lgkmcnt(0)" ::: "memory")
#define VM_WAIT() asm volatile("s_waitcnt vmcnt(0)" ::: "memory")

namespace pg8 {
typedef unsigned short bf16_t;
constexpr int BM = 256, BK = 64, HALF = 128, HTB = HALF * BK * 2, STAGE_BYTES = 8 * HTB, NXCD = 8, WGM = 8;
__host__ __device__ __forceinline__ int lds_byte(int r, int c) { const int st = (r >> 4) * 2 + (c >> 5), rr = r & 15, cc = c & 31, ob = rr * 64 + cc * 2; return st * 1024 + (ob ^ (((ob >> 9) & 1) << 5)); }
__host__ __device__ __forceinline__ void stage_rc(int b, int& R, int& C) { const int st = b / 1024, sb = b % 1024, swz = sb ^ (((sb >> 9) & 1) << 5); R = (st >> 1) * 16 + swz / 64; C = (st & 1) * 32 + (swz % 64) / 2; }
__host__ __device__ __forceinline__ int perm32(int rho) { const int n = rho >> 4, i = rho & 15; return 8 * (i >> 2) + 4 * n + (i & 3); }
struct Unit { int pm, pn, pb; };
struct Gemm { const bf16_t* A; const bf16_t* Bt; int M, N, K; size_t sA, sB; };
struct StaticOrder {
    int nM, nN, nwg, G, c;
    __host__ __device__ void init(int M, int N, int G_, int c_) { nM = M / BM; nN = N / BM; nwg = nM * nN; G = G_; c = c_; }
    __host__ __device__ void initn(int nM_, int nN_, int G_, int c_) { nM = nM_; nN = nN_; nwg = nM * nN; G = G_; c = c_; }
    __host__ __device__ bool next(int i, Unit& u) const {
        const long L = (long)i * G + c; if (L >= nwg) return false;
        int wgid = (int)L; { const int q = nwg / NXCD, r = nwg % NXCD, xcd = wgid % NXCD, off = wgid / NXCD; wgid = (xcd < r ? xcd * (q + 1) : r * (q + 1) + (xcd - r) * q) + off; }
        const int nig = WGM * nN, gid = wgid / nig, fm = gid * WGM, gsz = (nM - fm) < WGM ? (nM - fm) : WGM;
        u.pm = fm + ((wgid % nig) % gsz); u.pn = (wgid % nig) / gsz; u.pb = 0; return true;
    }
};
struct MergeOrder {
    StaticOrder so;
    __host__ __device__ bool next(int i, Unit& u) const { if (!so.next(i >> 2, u)) return false; u.pb = i & 3; return true; }
};
__device__ __forceinline__ unsigned cvt_pk_bf16(float lo, float hi) { return pk2(lo, hi); }

template <class Epi, class Sched, bool ALIGN_EPI, int NB = 2>
__device__ __forceinline__ void gemm_phase(const int tid, LAS unsigned char* lds, const Gemm g, const Sched& S, const Epi& E) {
    const int wid = __builtin_amdgcn_readfirstlane(tid >> 6), lane = tid & 63, wr = wid >> 2, wc = wid & 3, fr = lane & 15, fq = lane >> 4;
    const int K = g.K, nt = K / BK;
    unsigned voffA[2], voffB[2];
#pragma unroll
    for (int i = 0; i < 2; ++i) { int R, C; stage_rc(tid * 16 + i * 8192, R, C); const int Rb = (R & ~31) + perm32(R & 31);
        voffA[i] = (unsigned)(R * K + C) * 2u; voffB[i] = (unsigned)(Rb * K + C) * 2u; }
    const size_t kstep = (size_t)(BK * 2);
    const size_t hstep = (size_t)HALF * K * 2;
    const size_t tstep = 2 * hstep;
    const size_t bstep = (NB == 2) ? tstep : hstep;
    const unsigned ldsw = (unsigned)wid * 1024u;
    const int aoff = lds_byte(wr * 64 + fr, fq * 8), boff = lds_byte(wc * 32 + fr, fq * 8);
#define PG8_SA(b, h) (((b) * 2 + (h)) * HTB)
#define PG8_SB(b, h) ((4 + (b) * 2 + (h)) * HTB)
#define PG8_STAGE(bufoff, gbase, voff) do { _Pragma("unroll") for (int _i = 0; _i < 2; ++_i) \
        __builtin_amdgcn_global_load_lds((const unsigned*)((const char*)(gbase) + (voff)[_i]), (LAS unsigned*)(lds + (bufoff) + ldsw + _i * 8192), 16, 0, 0); } while (0)
#define PG8_LDA(dst, b, h) do { _Pragma("unroll") for (int m = 0; m < 4; ++m) _Pragma("unroll") for (int k = 0; k < 2; ++k) dst[m][k] = *(const LAS bf16x8*)(lds + PG8_SA(b, h) + aoff + m * 2048 + k * 1024); } while (0)
#define PG8_LDB(dst, b, h) do { _Pragma("unroll") for (int n = 0; n < 2; ++n) _Pragma("unroll") for (int k = 0; k < 2; ++k) dst[n][k] = *(const LAS bf16x8*)(lds + PG8_SB(b, h) + boff + n * 2048 + k * 1024); } while (0)
#define PG8_MMA(ai, bj, At, Bt) do { __builtin_amdgcn_s_setprio(1); _Pragma("unroll") for (int m = 0; m < 4; ++m) _Pragma("unroll") for (int n = 0; n < 2; ++n) _Pragma("unroll") for (int k = 0; k < 2; ++k) \
        acc[ai][bj][m][n] = __builtin_amdgcn_mfma_f32_16x16x32_bf16(Bt[n][k], At[m][k], acc[ai][bj][m][n], 0, 0, 0); __builtin_amdgcn_s_setprio(0); } while (0)
#define PG8_WAIT_V(n) asm volatile("s_waitcnt vmcnt(" #n ")" ::: "memory")
#define PG8_WAIT_L(n) asm volatile("s_waitcnt lgkmcnt(" #n ")" ::: "memory")
#define PG8_BAR __builtin_amdgcn_s_barrier()
#define PG8_SCHED __builtin_amdgcn_sched_barrier(0)
    Unit cur, nxt; int ui = 0;
    if (!S.next(0, cur)) return;
    f32x4 acc[2][NB][4][2];
    f32x4 xreg[NB == 1 ? 2 : 1][NB == 1 ? 4 : 1][NB == 1 ? 2 : 1];
#pragma unroll
    for (int a = 0; a < 2; ++a)
#pragma unroll
        for (int b = 0; b < NB; ++b)
#pragma unroll
            for (int m = 0; m < 4; ++m)
#pragma unroll
                for (int n = 0; n < 2; ++n) acc[a][b][m][n] = (f32x4){0.f, 0.f, 0.f, 0.f};
    bf16x8 At[4][2], B0[2][2], B1[NB == 2 ? 2 : 1][2];
    const char* cA = (const char*)(g.A + (size_t)cur.pb * g.sA) + (size_t)cur.pm * tstep; const char* cB = (const char*)(g.Bt + (size_t)cur.pb * g.sB) + (size_t)cur.pn * bstep;
    if constexpr (NB == 2) {
        PG8_STAGE(PG8_SB(0, 0), cB, voffB); PG8_STAGE(PG8_SB(0, 1), cB + hstep, voffB); PG8_STAGE(PG8_SA(0, 0), cA, voffA); PG8_STAGE(PG8_SA(0, 1), cA + hstep, voffA);
        if (wr == 1) PG8_BAR;
        PG8_WAIT_V(2); PG8_BAR;
        PG8_STAGE(PG8_SB(1, 0), cB + kstep, voffB); PG8_STAGE(PG8_SA(1, 0), cA + kstep, voffA); PG8_STAGE(PG8_SB(1, 1), cB + hstep + kstep, voffB);
        PG8_WAIT_V(6); PG8_BAR;
    } else {
        PG8_STAGE(PG8_SB(0, 0), cB, voffB); PG8_STAGE(PG8_SA(0, 0), cA, voffA); PG8_STAGE(PG8_SA(0, 1), cA + hstep, voffA);
        if (wr == 1) PG8_BAR;
        PG8_WAIT_V(2); PG8_BAR;
        PG8_STAGE(PG8_SB(1, 0), cB + kstep, voffB); PG8_STAGE(PG8_SA(1, 0), cA + kstep, voffA);
        PG8_WAIT_V(4); PG8_BAR;
    }
    for (;;) {
        const bool has_next = S.next(ui + 1, nxt);
        const char* nA = has_next ? (const char*)(g.A + (size_t)nxt.pb * g.sA) + (size_t)nxt.pm * tstep : cA; const char* nB = has_next ? (const char*)(g.Bt + (size_t)nxt.pb * g.sB) + (size_t)nxt.pn * bstep : cB;
        for (int t = 0; t < nt; t += 2) {
            const bool last = (t == nt - 2);
            const char* a1 = cA + (size_t)(t + 1) * kstep;
            const char* a2 = last ? nA : cA + (size_t)(t + 2) * kstep; const char* b2 = last ? nB : cB + (size_t)(t + 2) * kstep;
            const char* a3 = a2 + kstep; const char* b3 = b2 + kstep;
            if constexpr (NB == 2) {
            PG8_LDB(B0, 0, 0); PG8_LDB(B1, 0, 1); PG8_SCHED; PG8_LDA(At, 0, 0); PG8_STAGE(PG8_SA(1, 1), a1 + hstep, voffA);
            PG8_WAIT_V(8); PG8_WAIT_L(0); PG8_BAR; PG8_MMA(0, 0, At, B0); PG8_MMA(0, 1, At, B1); PG8_BAR; PG8_SCHED;
            PG8_LDA(At, 0, 1); PG8_STAGE(PG8_SB(0, 0), b2, voffB); PG8_STAGE(PG8_SB(0, 1), b2 + hstep, voffB); PG8_STAGE(PG8_SA(0, 0), a2, voffA);
            PG8_WAIT_V(8); PG8_WAIT_L(0); PG8_BAR; PG8_MMA(1, 0, At, B0); PG8_MMA(1, 1, At, B1); PG8_BAR; PG8_SCHED;
            PG8_LDB(B0, 1, 0); PG8_LDB(B1, 1, 1); PG8_SCHED; PG8_LDA(At, 1, 0); PG8_STAGE(PG8_SA(0, 1), a2 + hstep, voffA);
            PG8_WAIT_V(8); PG8_WAIT_L(0); PG8_BAR; PG8_MMA(0, 0, At, B0); PG8_MMA(0, 1, At, B1); PG8_BAR; PG8_SCHED;
            PG8_LDA(At, 1, 1); PG8_STAGE(PG8_SB(1, 0), b3, voffB); PG8_STAGE(PG8_SB(1, 1), b3 + hstep, voffB); PG8_STAGE(PG8_SA(1, 0), a3, voffA);
            PG8_WAIT_V(8); PG8_WAIT_L(0); PG8_BAR; PG8_MMA(1, 0, At, B0); PG8_MMA(1, 1, At, B1); PG8_BAR; PG8_SCHED;
            } else {
            PG8_LDB(B0, 0, 0); PG8_SCHED; PG8_LDA(At, 0, 0); PG8_STAGE(PG8_SA(1, 1), a1 + hstep, voffA);
            PG8_WAIT_V(6); PG8_WAIT_L(0); PG8_BAR; PG8_MMA(0, 0, At, B0); PG8_BAR; PG8_SCHED;
            PG8_LDA(At, 0, 1); PG8_STAGE(PG8_SB(0, 0), b2, voffB); PG8_STAGE(PG8_SA(0, 0), a2, voffA);
            PG8_WAIT_V(6); PG8_WAIT_L(0); PG8_BAR; PG8_MMA(1, 0, At, B0); PG8_BAR; PG8_SCHED;
            PG8_LDB(B0, 1, 0); PG8_SCHED; PG8_LDA(At, 1, 0); PG8_STAGE(PG8_SA(0, 1), a2 + hstep, voffA);
            PG8_WAIT_V(6); PG8_WAIT_L(0); PG8_BAR; PG8_MMA(0, 0, At, B0); PG8_BAR; PG8_SCHED;
            PG8_LDA(At, 1, 1); PG8_STAGE(PG8_SB(1, 0), b3, voffB); PG8_STAGE(PG8_SA(1, 0), a3, voffA);
            PG8_WAIT_V(6); PG8_WAIT_L(0); PG8_BAR; PG8_MMA(1, 0, At, B0); PG8_BAR; PG8_SCHED;
            }
        }
        if constexpr (ALIGN_EPI) { if (wr == 0) PG8_BAR; }
        if constexpr (NB == 2) E(acc, cur, wr, wc, fr, fq); else E(acc, xreg, cur, wr, wc, fr, fq);
        if (!has_next) break;
#pragma unroll
        for (int a = 0; a < 2; ++a)
#pragma unroll
            for (int b = 0; b < NB; ++b)
#pragma unroll
                for (int m = 0; m < 4; ++m)
#pragma unroll
                    for (int n = 0; n < 2; ++n) acc[a][b][m][n] = (f32x4){0.f, 0.f, 0.f, 0.f};
        cur = nxt; cA = nA; cB = nB; ++ui;
        if constexpr (ALIGN_EPI) { if (wr == 1) PG8_BAR; }
    }
    PG8_WAIT_V(0);
    if constexpr (!ALIGN_EPI) { if (wr == 0) PG8_BAR; }
    PG8_BAR;
#undef PG8_SA
#undef PG8_SB
#undef PG8_STAGE
#undef PG8_LDA
#undef PG8_LDB
#undef PG8_MMA
#undef PG8_WAIT_V
#undef PG8_WAIT_L
#undef PG8_BAR
#undef PG8_SCHED
}

struct EpiIn {
    bf16_t* P; bf16_t* G; const float* rs;
    __device__ __forceinline__ void operator()(const f32x4 (&acc)[2][2][4][2], const Unit& u, int wr, int wc, int fr, int fq) const {
        const int row0 = u.pm * BM + wr * 64 + fr;
        float scv[2][4];
#pragma unroll
        for (int ai = 0; ai < 2; ++ai)
#pragma unroll
            for (int m = 0; m < 4; ++m) scv[ai][m] = rs ? rs[row0 + ai * HALF + m * 16] : 0.f;
#pragma unroll
        for (int ai = 0; ai < 2; ++ai)
#pragma unroll
            for (int m = 0; m < 4; ++m) scv[ai][m] = rs ? 1.0f / sqrtf(scv[ai][m] * (1.0f / D) + 1e-6f) : 1.0f;
        if (u.pn < 21) {
            const int col0 = u.pn * BM + wc * 32 + 8 * fq;
#pragma unroll
            for (int ai = 0; ai < 2; ++ai)
#pragma unroll
                for (int m = 0; m < 4; ++m) { bf16_t* rowp = P + (size_t)(row0 + ai * HALF + m * 16) * NPRE + col0;
                    const float sc = scv[ai][m];
#pragma unroll
                    for (int bj = 0; bj < 2; ++bj) { const f32x4 v0 = acc[ai][bj][m][0] * sc, v1 = acc[ai][bj][m][1] * sc;
                        u32x4 w; w.x = cvt_pk_bf16(v0[0], v0[1]); w.y = cvt_pk_bf16(v0[2], v0[3]); w.z = cvt_pk_bf16(v1[0], v1[1]); w.w = cvt_pk_bf16(v1[2], v1[3]);
                        *(u32x4*)(rowp + bj * HALF) = w; } }
        } else {
            const int col0 = (u.pn - 21) * BM + wc * 32 + 8 * fq;
#pragma unroll
            for (int ai = 0; ai < 2; ++ai)
#pragma unroll
                for (int m = 0; m < 4; ++m) { bf16_t* rowp = G + (size_t)(row0 + ai * HALF + m * 16) * NGATE + col0;
                    const float sc = scv[ai][m];
#pragma unroll
                    for (int bj = 0; bj < 2; ++bj) { const f32x4 v0 = acc[ai][bj][m][0] * sc, v1 = acc[ai][bj][m][1] * sc;
                        u32x4 w; w.x = cvt_pk_bf16(sigmoidf_(v0[0]), sigmoidf_(v0[1])); w.y = cvt_pk_bf16(sigmoidf_(v0[2]), sigmoidf_(v0[3]));
                        w.z = cvt_pk_bf16(sigmoidf_(v1[0]), sigmoidf_(v1[1])); w.w = cvt_pk_bf16(sigmoidf_(v1[2]), sigmoidf_(v1[3]));
                        *(u32x4*)(rowp + bj * HALF) = w; } }
        }
    }
};
__device__ __forceinline__ f32x4 bf4lo(u32x4 g) { return (f32x4){__builtin_bit_cast(float, g.x << 16), __builtin_bit_cast(float, g.x & 0xffff0000u), __builtin_bit_cast(float, g.y << 16), __builtin_bit_cast(float, g.y & 0xffff0000u)}; }
__device__ __forceinline__ f32x4 bf4hi(u32x4 g) { return (f32x4){__builtin_bit_cast(float, g.z << 16), __builtin_bit_cast(float, g.z & 0xffff0000u), __builtin_bit_cast(float, g.w << 16), __builtin_bit_cast(float, g.w & 0xffff0000u)}; }
struct EpiMerge {
    const bf16_t* G; bf16_t* MB;
    __device__ __forceinline__ void operator()(const f32x4 (&acc)[2][1][4][2], f32x4 (&mr)[2][4][2], const Unit& u, int wr, int wc, int fr, int fq) const {
        const int row0 = u.pm * BM + wr * 64 + fr, col0 = u.pn * HALF + wc * 32 + 8 * fq;
        u32x4 gv[2][4];
#pragma unroll
        for (int ai = 0; ai < 2; ++ai)
#pragma unroll
            for (int m = 0; m < 4; ++m) gv[ai][m] = *(const u32x4*)(G + (size_t)(row0 + ai * HALF + m * 16) * NGATE + (size_t)u.pb * D + col0);
#pragma unroll
        for (int ai = 0; ai < 2; ++ai)
#pragma unroll
            for (int m = 0; m < 4; ++m) {
                const f32x4 p0 = acc[ai][0][m][0] * bf4lo(gv[ai][m]), p1 = acc[ai][0][m][1] * bf4hi(gv[ai][m]);
                if (u.pb == 0) { mr[ai][m][0] = p0; mr[ai][m][1] = p1; } else { mr[ai][m][0] += p0; mr[ai][m][1] += p1; }
                if (u.pb == 3) { const f32x4 v0 = mr[ai][m][0], v1 = mr[ai][m][1];
                    u32x4 w; w.x = cvt_pk_bf16(v0[0], v0[1]); w.y = cvt_pk_bf16(v0[2], v0[3]); w.z = cvt_pk_bf16(v1[0], v1[1]); w.w = cvt_pk_bf16(v1[2], v1[3]);
                    *(u32x4*)(MB + (size_t)(row0 + ai * HALF + m * 16) * D + col0) = w; } }
    }
};
struct EpiRes {
    const float* r0; float* out; bf16_t* Hn; const float* gn; float* rs;
    __device__ __forceinline__ void operator()(const f32x4 (&acc)[2][2][4][2], const Unit& u, int wr, int wc, int fr, int fq) const {
        const int row0 = u.pm * BM + wr * 64 + fr, col0 = u.pn * BM + wc * 32 + 8 * fq;
        f32x4 gv[2][2];
        if (Hn) {
#pragma unroll
            for (int bj = 0; bj < 2; ++bj) { gv[bj][0] = *(const f32x4*)(gn + col0 + bj * HALF); gv[bj][1] = *(const f32x4*)(gn + col0 + bj * HALF + 4); } }
#pragma unroll
        for (int aih = 0; aih < 4; ++aih) { const int ai = aih >> 1, m0 = (aih & 1) * 2;
            f32x4 rv[4][2][2];
#pragma unroll
            for (int m = m0; m < m0 + 2; ++m) { const float* rp = r0 + (size_t)(row0 + ai * HALF + m * 16) * D + col0;
#pragma unroll
                for (int bj = 0; bj < 2; ++bj) { rv[m][bj][0] = *(const f32x4*)(rp + bj * HALF); rv[m][bj][1] = *(const f32x4*)(rp + bj * HALF + 4); } }
#pragma unroll
            for (int m = m0; m < m0 + 2; ++m) { const int row = row0 + ai * HALF + m * 16;
                float ss = 0.f;
#pragma unroll
                for (int bj = 0; bj < 2; ++bj) { const f32x4 v0 = acc[ai][bj][m][0] + rv[m][bj][0], v1 = acc[ai][bj][m][1] + rv[m][bj][1];
                    float* op = out + (size_t)row * D + col0 + bj * HALF; *(f32x4*)op = v0; *(f32x4*)(op + 4) = v1;
                    if (Hn) { ss += (v0[0] * v0[0] + v0[1] * v0[1]) + (v0[2] * v0[2] + v0[3] * v0[3]) + (v1[0] * v1[0] + v1[1] * v1[1]) + (v1[2] * v1[2] + v1[3] * v1[3]);
                        const f32x4 h0 = v0 * gv[bj][0], h1 = v1 * gv[bj][1];
                        u32x4 w; w.x = cvt_pk_bf16(h0[0], h0[1]); w.y = cvt_pk_bf16(h0[2], h0[3]); w.z = cvt_pk_bf16(h1[0], h1[1]); w.w = cvt_pk_bf16(h1[2], h1[3]);
                        *(u32x4*)(Hn + (size_t)row * D + col0 + bj * HALF) = w; } }
                if (Hn) { ss += __shfl_xor(ss, 16); ss += __shfl_xor(ss, 32); if (fq == 0) (void)__hip_atomic_fetch_add(rs + row, ss, __ATOMIC_RELAXED, __HIP_MEMORY_SCOPE_AGENT); }
            }
        }
    }
};
struct EpiGU {
    bf16_t* HID; const float* rs;
    __device__ __forceinline__ void operator()(const f32x4 (&acc)[2][2][4][2], const Unit& u, int wr, int wc, int fr, int fq) const {
        const int row0 = u.pm * BM + wr * 64 + fr, col0 = u.pn * HALF + wc * 32 + 8 * fq;
        float scv[2][4];
#pragma unroll
        for (int ai = 0; ai < 2; ++ai)
#pragma unroll
            for (int m = 0; m < 4; ++m) scv[ai][m] = rs[row0 + ai * HALF + m * 16];
#pragma unroll
        for (int ai = 0; ai < 2; ++ai)
#pragma unroll
            for (int m = 0; m < 4; ++m) { const size_t row = (size_t)(row0 + ai * HALF + m * 16);
                const float sc = 1.0f / sqrtf(scv[ai][m] * (1.0f / D) + 1e-6f);
                const f32x4 g0 = acc[ai][0][m][0] * sc, g1 = acc[ai][0][m][1] * sc, u0 = acc[ai][1][m][0] * sc, u1 = acc[ai][1][m][1] * sc;
                float o[8];
#pragma unroll
                for (int j = 0; j < 4; ++j) { o[j] = g0[j] * sigmoidf_(g0[j]) * u0[j]; o[4 + j] = g1[j] * sigmoidf_(g1[j]) * u1[j]; }
                u32x4 w; w.x = cvt_pk_bf16(o[0], o[1]); w.y = cvt_pk_bf16(o[2], o[3]); w.z = cvt_pk_bf16(o[4], o[5]); w.w = cvt_pk_bf16(o[6], o[7]);
                *(u32x4*)(HID + row * FF + col0) = w; }
    }
};
}

#define XB_TMO      128
#define XB_XCNT(j)  (256  + 64 * (j))
#define XB_XSUB(j)  (1280 + 64 * (j))
#define XB_XGEN(j)  (2304 + 64 * (j))
#define XB_TOP      3328
#define XB_TOPGEN   3392
#define XCD_BAR_WORDS 3456
#define XB_SPIN_CAP (1u << 18)
__device__ __forceinline__ unsigned xb_ld(unsigned* p)              { return __hip_atomic_load(p, __ATOMIC_RELAXED, __HIP_MEMORY_SCOPE_AGENT); }
__device__ __forceinline__ unsigned xb_add(unsigned* p, unsigned v) { return __hip_atomic_fetch_add(p, v, __ATOMIC_RELAXED, __HIP_MEMORY_SCOPE_AGENT); }
__device__ __forceinline__ unsigned xb_xcc_id() { return (unsigned)__builtin_amdgcn_s_getreg((3 << 11) | 20) & 0xFu; }
#define XB_SPIN(cond, bar) do { unsigned _sp = 0; while (cond) { __builtin_amdgcn_s_sleep(1); \
    if ((++_sp & 255u) == 0u) { if (xb_ld(&(bar)[XB_TMO])) break; if (_sp > XB_SPIN_CAP) { atomicAdd(&(bar)[XB_TMO], 1u); break; } } } } while (0)
struct XcdBarrier { unsigned* bar; unsigned x; volatile LAS unsigned* st; };
__device__ __forceinline__ XcdBarrier xcd_barrier_post(unsigned* bar, volatile LAS unsigned* st) {
    XcdBarrier b; b.bar = bar; b.x = xb_xcc_id(); b.st = st;
    if (threadIdx.x == 0) (void)xb_add(&bar[XB_XCNT(b.x)], 1u);
    return b;
}
__device__ __forceinline__ void xcd_barrier_complete(unsigned* bar, unsigned x, unsigned& nloc, unsigned& nx) {
    const unsigned G = gridDim.x * gridDim.y * gridDim.z;
    unsigned sum, cnt, mine, sp = 0u;
    for (;;) {
        sum = 0u; cnt = 0u; mine = 0u;
#pragma unroll
        for (unsigned j = 0; j < 16; ++j) { const unsigned c = xb_ld(&bar[XB_XCNT(j)]); sum += c; cnt += (c > 0u) ? 1u : 0u; mine = (j == x) ? c : mine; }
        if (sum == G) break;
        __builtin_amdgcn_s_sleep(1);
        if ((++sp & 255u) == 0u) { if (xb_ld(&bar[XB_TMO])) break; if (sp > XB_SPIN_CAP) { atomicAdd(&bar[XB_TMO], 1u); break; } }
    }
    nloc = mine > 0u ? mine : 1u; nx = cnt > 0u ? cnt : 1u;
}
__device__ __forceinline__ void xcd_barrier(const XcdBarrier& b) {
    asm volatile("s_waitcnt vmcnt(0)" ::: "memory");
    __syncthreads();
    if (threadIdx.x == 0) {
        unsigned* bar = b.bar;
        __builtin_amdgcn_s_waitcnt(0);
        unsigned nloc = b.st[0], nx = b.st[1];
        if (nloc == 0u) { xcd_barrier_complete(bar, b.x, nloc, nx); b.st[0] = nloc; b.st[1] = nx; }
        const unsigned old = xb_add(&bar[XB_XSUB(b.x)], 1u);
        const unsigned gen = old / nloc;
        if (old + 1u == (gen + 1u) * nloc) {
            __builtin_amdgcn_fence(__ATOMIC_RELEASE, "agent");
            asm volatile("s_waitcnt vmcnt(0)" ::: "memory");
            const unsigned og = xb_add(&bar[XB_TOP], 1u);
            const unsigned tg = og / nx;
            if (og + 1u == (tg + 1u) * nx) xb_add(&bar[XB_TOPGEN], 1u);
            else XB_SPIN(xb_ld(&bar[XB_TOPGEN]) == tg, bar);
            __builtin_amdgcn_fence(__ATOMIC_ACQUIRE, "agent");
            xb_add(&bar[XB_XGEN(b.x)], 1u);
            asm volatile("s_waitcnt vmcnt(0)" ::: "memory");
        } else {
            XB_SPIN(xb_ld(&bar[XB_XGEN(b.x)]) == gen, bar);
            __builtin_amdgcn_fence(__ATOMIC_ACQUIRE, "agent");
            asm volatile("s_waitcnt vmcnt(0)" ::: "memory");
        }
    }
    __syncthreads();
}

struct Args { const GAS1 void* in[41]; GAS1 float* out; GAS1 unsigned char* ws; int ph_lo, ph_hi, li, pad; };
struct Frame {
    LAS unsigned char* lds;
    int tid, lane, wave, vcu, G;
};
constexpr int NW = 8;

__device__ __forceinline__ void cvt_item(const float* W, int N, bf16* WT, int Kd, int k0, int n0, int drow0, int kd0, LAS float* scr, int lane) {
    const int lr = lane >> 4, lc = (lane & 15) * 4;
    f32x4 v[16];
#pragma unroll
    for (int i = 0; i < 16; ++i) v[i] = __builtin_nontemporal_load((const f32x4*)(W + (size_t)(k0 + 4 * i + lr) * N + n0 + lc));
#pragma unroll
    for (int i = 0; i < 16; ++i) { LAS float* s = scr + (4 * i + lr) * 65 + lc; s[0] = v[i][0]; s[1] = v[i][1]; s[2] = v[i][2]; s[3] = v[i][3]; }
    LDS_WAIT(); asm volatile("" ::: "memory");
    const int c = lane & 7;
#pragma unroll
    for (int j = 0; j < 8; ++j) { const int n = (lane >> 3) + 8 * j; const LAS float* s = scr + (8 * c) * 65 + n;
        u32x4 o; o.x = pk2(s[0 * 65], s[1 * 65]); o.y = pk2(s[2 * 65], s[3 * 65]); o.z = pk2(s[4 * 65], s[5 * 65]); o.w = pk2(s[6 * 65], s[7 * 65]);
        *(u32x4*)(WT + (size_t)(drow0 + n) * Kd + kd0 + 8 * c) = o; }
    LDS_WAIT(); asm volatile("" ::: "memory");
}
__device__ __forceinline__ void p0_convert(Frame& F, const Args& a) {
    LAS float* scr = (LAS float*)(F.lds + F.wave * 16640);
    const int gw = F.vcu * NW + F.wave, NGW = F.G * NW;
    constexpr int I_IN = 32 * 212, I_BO = 8 * 32, I_MIX = 32 * 32, I_G = 32 * 88, I_DN = 88 * 32, I_LW = 8, I_LG = 16;
    constexpr int PER_L = I_IN + 4 * I_BO + I_MIX + 2 * I_G + I_DN + 2 * I_LW + I_LG;
    for (int it = gw; it < NL * PER_L; it += NGW) {
        const int l = it / PER_L; int r = it % PER_L;
        unsigned char* ws = ((unsigned char*)a.ws);
        if (r < I_IN) { const int kb = r / 212, nb = r % 212; cvt_item((const float*)a.in[9] + (size_t)l * D * INW, INW, (bf16*)(ws + WS_WIN + l * SZ_WIN), D, kb * 64, nb * 64, nb * 64, kb * 64, scr, F.lane); continue; } r -= I_IN;
        if (r < 4 * I_BO) { const int b = r / I_BO, q = r % I_BO, kb = q / 32, nb = q % 32; const int idx = (b == 0) ? 14 : (b == 1) ? 18 : (b == 2) ? 30 : 35;
            cvt_item((const float*)a.in[idx] + (size_t)l * BW * D, D, (bf16*)(ws + WS_WBO + l * SZ_WBO) + (size_t)b * D * BW, BW, kb * 64, nb * 64, nb * 64, kb * 64, scr, F.lane); continue; } r -= 4 * I_BO;
        if (r < I_MIX) { const int kb = r / 32, nb = r % 32; cvt_item((const float*)a.in[36] + (size_t)l * D * D, D, (bf16*)(ws + WS_WMIX + l * SZ_WMIX), D, kb * 64, nb * 64, nb * 64, kb * 64, scr, F.lane); continue; } r -= I_MIX;
        if (r < 2 * I_G) { const int up = r / I_G, q = r % I_G, kb = q / 88, nb = q % 88, n0 = nb * 64;
            cvt_item((const float*)a.in[up ? 39 : 38] + (size_t)l * D * FF, FF, (bf16*)(ws + WS_WGU + l * SZ_WGU), D, kb * 64, n0, (n0 / 128) * 256 + up * 128 + (n0 % 128), kb * 64, scr, F.lane); continue; } r -= 2 * I_G;
        if (r < I_DN) { const int kb = r / 32, nb = r % 32; cvt_item((const float*)a.in[40] + (size_t)l * FF * D, D, (bf16*)(ws + WS_WDN + l * SZ_WDN), FF, kb * 64, nb * 64, nb * 64, kb * 64, scr, F.lane); continue; } r -= I_DN;
        bf16* lw = (bf16*)(ws + WS_LW + l * SZ_LW);
        if (r < I_LW) { cvt_item((const float*)a.in[21] + (size_t)l * 64 * 512, 512, lw, 256, 0, r * 64, r * 64, 0, scr, F.lane); continue; } r -= I_LW;
        if (r < I_LW) { cvt_item((const float*)a.in[23] + (size_t)l * 64 * 512, 512, lw, 256, 0, r * 64, r * 64, 64, scr, F.lane); continue; } r -= I_LW;
        { const int kb = r / 8, nb = r % 8; cvt_item((const float*)a.in[24] + (size_t)l * 128 * 512, 512, lw, 256, kb * 64, nb * 64, nb * 64, 128 + kb * 64, scr, F.lane); }
    }
}

__device__ __forceinline__ void norm_phase(Frame& F, const float* s0, const float* s1, const float* gain, bf16* H) {
    const int gw = F.vcu * NW + F.wave, NGW = F.G * NW;
    f32x4 gv[8];
#pragma unroll
    for (int j = 0; j < 8; ++j) gv[j] = *(const f32x4*)(gain + (j * 64 + F.lane) * 4);
    for (int m = gw; m < MPAD; m += NGW) {
        u32x2* o = (u32x2*)(H + (size_t)m * D) + F.lane;
        if (m >= MR) {
#pragma unroll
            for (int j = 0; j < 8; ++j) o[64 * j] = (u32x2){0u, 0u};
            continue; }
        const f32x4* xr = (const f32x4*)((m < MP) ? s0 + (size_t)m * D : s1 + (size_t)(m - MP) * D) + F.lane;
        f32x4 v[8]; float ss = 0.f;
#pragma unroll
        for (int j = 0; j < 8; ++j) { v[j] = xr[64 * j]; ss += (v[j][0] * v[j][0] + v[j][1] * v[j][1]) + (v[j][2] * v[j][2] + v[j][3] * v[j][3]); }
        const float rs = 1.0f / sqrtf(wave_sum(ss) * (1.0f / D) + 1e-6f);
#pragma unroll
        for (int j = 0; j < 8; ++j) { const f32x4 y = v[j] * rs * gv[j]; o[64 * j] = (u32x2){pk2(y[0], y[1]), pk2(y[2], y[3])}; }
    }
}

__device__ __forceinline__ void gmlp_item(Frame& F, const Args& a, int l, int chunk, int g, const bf16* P, bf16* ACTA) {
    LAS bf16* Vt = (LAS bf16*)F.lds;
    const int lane = F.lane, w = F.wave;
    const float* lng = (const float*)a.in[10] + l * 512; const float* lnb = (const float*)a.in[11] + l * 512;
    const float* ws_ = (const float*)a.in[12] + (size_t)(l * 4 + g) * 128 * 128; const float* bs = (const float*)a.in[13] + (l * 4 + g) * 128;
    const int row0 = chunk * 128;
    f32x4 uv[8]; float btv[8];
    { const int li_ = lane & 15, q_ = lane >> 4, c0_ = 128 * g + 16 * w + 4 * q_;
#pragma unroll
      for (int tt = 0; tt < 8; ++tt) { const int t = 16 * tt + li_; uv[tt] = ldb4(P + (size_t)(row0 + t) * NPRE + PA0 + c0_); btv[tt] = bs[t]; } }
    const int myj = g >> 1, mylo = (g & 1) * 32;
    const f32x4 lgv = *(const f32x4*)(lng + myj * 256 + 4 * lane), lbv = *(const f32x4*)(lnb + myj * 256 + 4 * lane);
#pragma unroll 1
    for (int i0 = 0; i0 < 16; i0 += 8) {
        f32x4 xa[8], xb[8];
#pragma unroll
        for (int i = 0; i < 8; ++i) { const bf16* pr = P + (size_t)(row0 + w * 16 + i0 + i) * NPRE + PA0 + 512; xa[i] = ldb4(pr + 4 * lane); xb[i] = ldb4(pr + 256 + 4 * lane); }
#pragma unroll
        for (int i = 0; i < 8; ++i) {
            const int s = w * 16 + i0 + i; f32x4 x0 = xa[i], x1 = xb[i];
#pragma unroll
            for (int j = 0; j < 4; ++j) { x0[j] = gelu_tanh(x0[j]); x1[j] = gelu_tanh(x1[j]); }
            const float mean = wave_sum((x0[0] + x0[1]) + (x0[2] + x0[3]) + (x1[0] + x1[1]) + (x1[2] + x1[3])) * (1.f / 512.f);
            x0 -= mean; x1 -= mean;
            const float var = wave_sum((x0[0] * x0[0] + x0[1] * x0[1]) + (x0[2] * x0[2] + x0[3] * x0[3]) + (x1[0] * x1[0] + x1[1] * x1[1]) + (x1[2] * x1[2] + x1[3] * x1[3])) * (1.f / 512.f);
            const float rstd = 1.0f / sqrtf(var + 1e-5f);
            const f32x4 xm = myj ? x1 : x0;
            if ((lane >> 5) == (g & 1)) {
                const int cl = 4 * (lane - mylo);
#pragma unroll
                for (int j = 0; j < 4; ++j) Vt[(cl + j) * 136 + s] = (bf16)f2bf(xm[j] * rstd * lgv[j] + lbv[j]);
            }
        }
    }
    LDS_WAIT(); __syncthreads();
    const int li = lane & 15, q = lane >> 4;
    f32x4 acc[8];
#pragma unroll
    for (int tt = 0; tt < 8; ++tt) acc[tt] = (f32x4){0.f, 0.f, 0.f, 0.f};
#pragma unroll
    for (int ks = 0; ks < 4; ++ks) {
        const bf16x8 af = *(const LAS bf16x8*)(Vt + (16 * w + li) * 136 + 32 * ks + 8 * q);
        const int s0 = 32 * ks + 8 * q;
        f32x4 wl[8][2];
#pragma unroll
        for (int tt = 0; tt < 8; ++tt) { if (32 * ks > 16 * tt + 15) continue; const int t = 16 * tt + li; wl[tt][0] = *(const f32x4*)(ws_ + t * 128 + s0); wl[tt][1] = *(const f32x4*)(ws_ + t * 128 + s0 + 4); }
#pragma unroll
        for (int tt = 0; tt < 8; ++tt) {
            if (32 * ks > 16 * tt + 15) continue;
            const int t = 16 * tt + li;
            float wv[8] = {wl[tt][0][0], wl[tt][0][1], wl[tt][0][2], wl[tt][0][3], wl[tt][1][0], wl[tt][1][1], wl[tt][1][2], wl[tt][1][3]};
#pragma unroll
            for (int j = 0; j < 8; ++j) if (s0 + j > t) wv[j] = 0.f;
            u32x4 bw; bw.x = pk2(wv[0], wv[1]); bw.y = pk2(wv[2], wv[3]); bw.z = pk2(wv[4], wv[5]); bw.w = pk2(wv[6], wv[7]);
            acc[tt] = __builtin_amdgcn_mfma_f32_16x16x32_bf16(af, __builtin_bit_cast(bf16x8, bw), acc[tt], 0, 0, 0);
        }
    }
    {
        const int c0 = 128 * g + 16 * w + 4 * q;
#pragma unroll
        for (int tt = 0; tt < 8; ++tt) {
            const int t = 16 * tt + li; float o[4];
#pragma unroll
            for (int j = 0; j < 4; ++j) o[j] = gelu_tanh(uv[tt][j]) * (acc[tt][j] + btv[tt]);
            *(u32x2*)(ACTA + (size_t)(row0 + t) * BW + c0) = (u32x2){pk2(o[0], o[1]), pk2(o[2], o[3])};
        }
    }
    __syncthreads();
}
__device__ __forceinline__ void gmlp_sample_item(Frame& F, const Args& a, int l, const bf16* P, bf16* ACTA) {
    const int lane = F.lane, sb = F.wave;
    const float* lng = (const float*)a.in[10] + l * 512; const float* lnb = (const float*)a.in[11] + l * 512;
    float vn[4][8], uu[4][8];
#pragma unroll
    for (int t = 0; t < 4; ++t) {
        const bf16* pr = P + (size_t)(MP + sb * 4 + t) * NPRE + PA0;
        f32x4 u0 = ldb4(pr + 4 * lane), u1 = ldb4(pr + 256 + 4 * lane), x0 = ldb4(pr + 512 + 4 * lane), x1 = ldb4(pr + 768 + 4 * lane);
#pragma unroll
        for (int j = 0; j < 4; ++j) { x0[j] = gelu_tanh(x0[j]); x1[j] = gelu_tanh(x1[j]); uu[t][j] = gelu_tanh(u0[j]); uu[t][4 + j] = gelu_tanh(u1[j]); }
        const float mean = wave_sum((x0[0] + x0[1]) + (x0[2] + x0[3]) + (x1[0] + x1[1]) + (x1[2] + x1[3])) * (1.f / 512.f);
        x0 -= mean; x1 -= mean;
        const float var = wave_sum((x0[0] * x0[0] + x0[1] * x0[1]) + (x0[2] * x0[2] + x0[3] * x0[3]) + (x1[0] * x1[0] + x1[1] * x1[1]) + (x1[2] * x1[2] + x1[3] * x1[3])) * (1.f / 512.f);
        const float rstd = 1.0f / sqrtf(var + 1e-5f);
        const f32x4 g0 = *(const f32x4*)(lng + 4 * lane), g1 = *(const f32x4*)(lng + 256 + 4 * lane), b0 = *(const f32x4*)(lnb + 4 * lane), b1 = *(const f32x4*)(lnb + 256 + 4 * lane);
        f32x4 y0 = x0 * rstd * g0 + b0, y1 = x1 * rstd * g1 + b1;
        float* gv = ((float*)a.out) + O_GV + (size_t)((l * NSB + sb) * NST + t) * 512;
        *(f32x4*)(gv + 4 * lane) = y0; *(f32x4*)(gv + 256 + 4 * lane) = y1;
#pragma unroll
        for (int j = 0; j < 4; ++j) { vn[t][j] = y0[j]; vn[t][4 + j] = y1[j]; }
    }
#pragma unroll
    for (int t = 0; t < 4; ++t) {
        float o[8];
#pragma unroll
        for (int hf = 0; hf < 2; ++hf) {
            const int g = hf * 2 + (lane >> 5);
            const float* wg = (const float*)a.in[12] + (size_t)(l * 4 + g) * 128 * 128; const float bt = ((const float*)a.in[13])[(l * 4 + g) * 128 + t];
#pragma unroll
            for (int j = 0; j < 4; ++j) { float s = bt;
#pragma unroll
                for (int s2 = 0; s2 <= t; ++s2) s += wg[t * 128 + s2] * vn[s2][hf * 4 + j];
                o[hf * 4 + j] = uu[t][hf * 4 + j] * s; }
        }
        bf16* op = ACTA + (size_t)(MP + sb * 4 + t) * BW;
        *(u32x2*)(op + 4 * lane) = (u32x2){pk2(o[0], o[1]), pk2(o[2], o[3])}; *(u32x2*)(op + 256 + 4 * lane) = (u32x2){pk2(o[4], o[5]), pk2(o[6], o[7])};
    }
}
__device__ __forceinline__ void bprep_item(Frame& F, const Args& a, int l, int item, const bf16* P, bf16* QB, bf16* KB, bf16* VT, float* QS) {
    const int lane = F.lane, w = F.wave; const bool samp = (item == 256); const int row0 = item * 32;
    LAS float* vs = (LAS float*)F.lds;
    const float* qn = (const float*)a.in[15] + l * 128; const float* kn = (const float*)a.in[16] + l * 128;
    const f32x4 qg = *(const f32x4*)(qn + 4 * (lane & 31)), kg = *(const f32x4*)(kn + 4 * (lane & 31));
    const float qs = 0.08838834764831845f * LOG2E;
    f32x4 xall[4][6];
#pragma unroll
    for (int i = 0; i < 4; ++i) { const bf16* pr = P + (size_t)(row0 + w * 4 + i) * NPRE + PB0;
#pragma unroll
        for (int j = 0; j < 6; ++j) xall[i][j] = ldb4(pr + j * 256 + 4 * lane); }
#pragma unroll
    for (int i = 0; i < 4; ++i) {
        const int r = w * 4 + i, row = row0 + r;
        f32x4 x[6];
#pragma unroll
        for (int j = 0; j < 6; ++j) x[j] = xall[i][j];
        float* ko; float* vo;
        if (!samp) { ko = ((float*)a.out) + O_KP + ((size_t)l * MP + row) * 512; vo = ((float*)a.out) + O_VP + ((size_t)l * MP + row) * 512; }
        else { ko = ((float*)a.out) + O_KS + ((size_t)l * MS + r) * 512; vo = ((float*)a.out) + O_VS + ((size_t)l * MS + r) * 512; }
#pragma unroll
        for (int j = 0; j < 4; ++j) {
            float ss = (x[j][0] * x[j][0] + x[j][1] * x[j][1]) + (x[j][2] * x[j][2] + x[j][3] * x[j][3]);
#pragma unroll
            for (int o = 1; o < 32; o <<= 1) ss += __shfl_xor(ss, o);
            const float rs = 1.0f / sqrtf(ss * (1.f / 128.f) + 1e-6f);
            if (j < 2) { const f32x4 y = x[j] * rs * qg * qs;
                if (!samp) *(u32x2*)(QB + (size_t)row * BW + j * 256 + 4 * lane) = (u32x2){pk2(y[0], y[1]), pk2(y[2], y[3])};
                else *(f32x4*)(QS + (size_t)r * BW + j * 256 + 4 * lane) = y; }
            else { const f32x4 y = x[j] * rs * kg; *(f32x4*)(ko + (j - 2) * 256 + 4 * lane) = y;
                if (!samp) *(u32x2*)(KB + (size_t)row * BW + (j - 2) * 256 + 4 * lane) = (u32x2){pk2(y[0], y[1]), pk2(y[2], y[3])}; }
        }
#pragma unroll
        for (int j = 4; j < 6; ++j) { *(f32x4*)(vo + (j - 4) * 256 + 4 * lane) = x[j];
            if (!samp) { LAS float* s = vs + r * 513 + (j - 4) * 256 + 4 * lane; s[0] = x[j][0]; s[1] = x[j][1]; s[2] = x[j][2]; s[3] = x[j][3]; } }
    }
    if (!samp) {
        LDS_WAIT(); __syncthreads();
        const int n = F.tid, b = row0 / SEQ, t0 = row0 % SEQ, h = n >> 7, d = n & 127;
        bf16* vp = VT + ((size_t)((b * 4 + h) * 128 + d)) * SEQ + t0;
#pragma unroll
        for (int c = 0; c < 4; ++c) { const LAS float* s = vs + (8 * c) * 513 + n;
            u32x4 o; o.x = pk2(s[0], s[513]); o.y = pk2(s[2 * 513], s[3 * 513]); o.z = pk2(s[4 * 513], s[5 * 513]); o.w = pk2(s[6 * 513], s[7 * 513]);
            *(u32x4*)(vp + 8 * c) = o; }
        LDS_WAIT(); __syncthreads();
    }
}
__device__ __forceinline__ void cprep_item(Frame& F, const Args& a, int l, int item, const bf16* P, unsigned char* ws) {
    const int lane = F.lane, w = F.wave, tid = F.tid; const bool samp = (item == 256); const int row0 = item * 32;
    LAS bf16* act = (LAS bf16*)F.lds;
    const float* mu = (const float*)a.in[19] + l * CSHIFT;
    const float* sh0 = (const float*)a.in[6] + (size_t)l * NSB * CSHIFT;
    {
        const int r = tid >> 4, cg = tid & 15, row = row0 + r;
        const bool first = samp ? ((r & 3) == 0) : ((row % SEQ) == 0);
        const bf16* pc = P + (size_t)row * NPRE + PC0 + 1536 + cg * 16;
        const float* ps = sh0 + (size_t)(r >> 2) * CSHIFT + 1536 + cg * 16;
        unsigned o[8];
#pragma unroll
        for (int j = 0; j < 4; ++j) {
            const f32x4 c = ldb4(pc + 4 * j); f32x4 p = first ? (samp ? *(const f32x4*)(ps + 4 * j) : (f32x4){0.f, 0.f, 0.f, 0.f}) : ldb4(pc - NPRE + 4 * j); const f32x4 m = *(const f32x4*)(mu + 1536 + cg * 16 + 4 * j);
            f32x4 x = c + (p - c) * m;
#pragma unroll
            for (int e = 0; e < 4; ++e) { if (cg < 4) x[e] = 1.0f - 2.0f * rcpf_(1.0f + ex2(2.0f * LOG2E * x[e])); else if (cg >= 8) x[e] = sigmoidf_(x[e]); }
            o[2 * j] = pk2(x[0], x[1]); o[2 * j + 1] = pk2(x[2], x[3]);
        }
        LAS u32x4* dst = (LAS u32x4*)(act + r * 264 + cg * 16);
        dst[0] = (u32x4){o[0], o[1], o[2], o[3]}; dst[1] = (u32x4){o[4], o[5], o[6], o[7]};
    }
    LDS_WAIT(); __syncthreads();
    const int li = lane & 15, q = lane >> 4;
    const bf16* lw = (const bf16*)(ws + WS_LW + l * SZ_LW);
    const float* w0 = (const float*)a.in[20] + l * 512; const float* a0 = (const float*)a.in[22] + l * 512;
    const float* k_k = (const float*)a.in[25] + l * 512; const float* k_a = (const float*)a.in[26] + l * 512; const float* r_k = (const float*)a.in[27] + l * 512;
    float* Rr = (float*)(ws + WS_R + l * SZ_RWL); float* Ww = (float*)(ws + WS_W + l * SZ_RWL); float* KX = (float*)(ws + WS_KX + l * SZ_RWL); float* Vv = (float*)(ws + WS_V);
    float* KK = (float*)(ws + WS_KK + l * SZ_RWL); float* KKA = (float*)(ws + WS_KKA + l * SZ_RWL); float* GG = (float*)(ws + WS_GG); float* RK = (float*)(ws + WS_RK);
    int lwo = (64 * w + li) * 256 + 8 * q, aco = li * 264 + 8 * q, c00 = 64 * w + 4 * q;
    asm volatile("" : "+v"(lwo), "+v"(aco), "+v"(c00));
    f32x4 xsv[2][4][3];
    int rows[2];
#define CPREP_LOAD_XS(mt) do { const int r = 16 * (mt) + li, row = row0 + r; rows[mt] = row; \
        const bool first = samp ? ((r & 3) == 0) : ((row % SEQ) == 0); \
        const bf16* pc = P + (size_t)row * NPRE + PC0; \
        const float* ps = sh0 + (size_t)(r >> 2) * CSHIFT; \
        _Pragma("unroll") for (int ct = 0; ct < 4; ++ct) _Pragma("unroll") for (int j = 0; j < 3; ++j) { const int c0 = c00 + 16 * ct; const f32x4 c = ldb4(pc + j * 512 + c0); \
            const f32x4 p = first ? (samp ? *(const f32x4*)(ps + j * 512 + c0) : (f32x4){0.f, 0.f, 0.f, 0.f}) : ldb4(pc - NPRE + j * 512 + c0); xsv[mt][ct][j] = c + (p - c) * *(const f32x4*)(mu + j * 512 + c0); } } while (0)
    CPREP_LOAD_XS(0);
    f32x4 aw[2][4], aa[2][4], ag[2][4];
#pragma unroll
    for (int mt = 0; mt < 2; ++mt)
#pragma unroll
        for (int ct = 0; ct < 4; ++ct) { aw[mt][ct] = (f32x4){0.f, 0.f, 0.f, 0.f}; aa[mt][ct] = aw[mt][ct]; ag[mt][ct] = aw[mt][ct]; }
#pragma unroll
    for (int hb = 0; hb < 4; ++hb) {
        bf16x8 af[2][4];
#pragma unroll
        for (int k2 = 0; k2 < 2; ++k2)
#pragma unroll
            for (int ct = 0; ct < 4; ++ct) af[k2][ct] = *(const bf16x8*)(lw + lwo + ct * 16 * 256 + 32 * (hb * 2 + k2));
#pragma unroll
        for (int k2 = 0; k2 < 2; ++k2) { const int ks = hb * 2 + k2;
#pragma unroll
            for (int mt = 0; mt < 2; ++mt) { const bf16x8 bfr = *(const LAS bf16x8*)(act + aco + mt * 16 * 264 + 32 * ks);
#pragma unroll
                for (int ct = 0; ct < 4; ++ct) {
                    if (ks < 2) aw[mt][ct] = __builtin_amdgcn_mfma_f32_16x16x32_bf16(af[k2][ct], bfr, aw[mt][ct], 0, 0, 0);
                    else if (ks < 4) aa[mt][ct] = __builtin_amdgcn_mfma_f32_16x16x32_bf16(af[k2][ct], bfr, aa[mt][ct], 0, 0, 0);
                    else ag[mt][ct] = __builtin_amdgcn_mfma_f32_16x16x32_bf16(af[k2][ct], bfr, ag[mt][ct], 0, 0, 0);
                } } }
        asm volatile("" ::: "memory");
    }
#pragma unroll
    for (int mt = 0; mt < 2; ++mt) {
        if (mt == 1) { asm volatile("" ::: "memory"); CPREP_LOAD_XS(1); }
        const int row = rows[mt];
        f32x4 kkv[4], av[4]; float ss = 0.f, rk = 0.f;
#pragma unroll
        for (int ct = 0; ct < 4; ++ct) {
            const int c0 = c00 + 16 * ct;
            f32x4 xs[3];
#pragma unroll
            for (int j = 0; j < 3; ++j) xs[j] = xsv[mt][ct][j];
            const f32x4 w0v = *(const f32x4*)(w0 + c0), a0v = *(const f32x4*)(a0 + c0), kkw = *(const f32x4*)(k_k + c0), kaw = *(const f32x4*)(k_a + c0), rkw = *(const f32x4*)(r_k + c0);
            f32x4 dec;
#pragma unroll
            for (int e = 0; e < 4; ++e) {
                const float x = -(w0v[e] + aw[mt][ct][e]);
                const float sp = fmaxf(x, 0.f) + 0.6931471805599453f * __builtin_amdgcn_logf(1.0f + ex2(-fabsf(x) * LOG2E));
                dec[e] = ex2(-LOG2E * ex2(LOG2E * (-sp - 0.5f)));
                av[ct][e] = sigmoidf_(a0v[e] + aa[mt][ct][e]);
            }
            kkv[ct] = xs[1] * kkw;
            const f32x4 kxv = xs[1] * (1.0f + (av[ct] - 1.0f) * kaw);
            ss += (kkv[ct][0] * kkv[ct][0] + kkv[ct][1] * kkv[ct][1]) + (kkv[ct][2] * kkv[ct][2] + kkv[ct][3] * kkv[ct][3]);
            const f32x4 t = xs[0] * kxv * rkw; rk += (t[0] + t[1]) + (t[2] + t[3]);
            const size_t o = (size_t)row * BW + c0;
            *(f32x4*)(Rr + o) = xs[0]; *(f32x4*)(Ww + o) = dec; *(f32x4*)(KX + o) = kxv; *(f32x4*)(Vv + o) = xs[2]; *(f32x4*)(GG + o) = ag[mt][ct];
        }
        ss += __shfl_xor(ss, 16); ss += __shfl_xor(ss, 32); rk += __shfl_xor(rk, 16); rk += __shfl_xor(rk, 32);
        const float rn = 1.0f / sqrtf(fmaxf(ss, 1e-24f));
#pragma unroll
        for (int ct = 0; ct < 4; ++ct) { const size_t o = (size_t)row * BW + c00 + 16 * ct; const f32x4 kk = kkv[ct] * rn; *(f32x4*)(KK + o) = kk; *(f32x4*)(KKA + o) = kk * av[ct]; }
        if (q == 0) RK[(size_t)row * 8 + w] = rk;
    }
#undef CPREP_LOAD_XS
    if (!samp) { if ((row0 + 32) % SEQ == 0) { const int b = row0 / SEQ; const bf16* src = P + (size_t)(row0 + 31) * NPRE + PC0; float* dst = ((float*)a.out) + O_SHP + (size_t)(l * 2 + b) * CSHIFT;
            for (int i = tid; i < CSHIFT; i += 512) dst[i] = __builtin_bit_cast(float, (unsigned)src[i] << 16); } }
    else { for (int i = tid; i < NSB * CSHIFT; i += 512) { const int sb = i / CSHIFT, c = i % CSHIFT; ((float*)a.out)[O_SHS + (size_t)(l * NSB + sb) * CSHIFT + c] = __builtin_bit_cast(float, (unsigned)P[(size_t)(MP + sb * 4 + 3) * NPRE + PC0 + c] << 16); } }
    __syncthreads();
}
__device__ __forceinline__ void dconv_item(Frame& F, const Args& a, int l, int item, const bf16* P, bf16* ACTD) {
    const int tid = F.tid, lane = F.lane, w = F.wave;
    LAS float* z = (LAS float*)F.lds;
    LAS float* red = (LAS float*)(F.lds + 62 * 512 * 4);
    const bool samp = item >= 256; const int sb = item - 256;
    const int rowbase = samp ? MP + sb * 4 : item * 32;
    const int t0 = samp ? 0 : (item * 32) % SEQ, ntok = samp ? 4 : 32;
    const float* conv0 = (const float*)a.in[7] + (size_t)(l * NSB + (samp ? sb : 0)) * 30 * 512;
    const int c = tid;
    const float* cw = (const float*)a.in[31] + (size_t)l * 31 * 512; const float cb = ((const float*)a.in[32])[l * 512 + c];
    const float lg = ((const float*)a.in[33])[l * 512 + c], lb = ((const float*)a.in[34])[l * 512 + c];
    float wv[31];
#pragma unroll
    for (int j = 0; j < 31; ++j) wv[j] = cw[j * 512 + c];
    {
        const int rs = tid >> 7, c4 = (tid & 127) * 4, nrow = 30 + ntok;
#pragma unroll
        for (int hb = 0; hb < 2; ++hb) {
            f32x4 va[8], ga[8];
#pragma unroll
            for (int jj = 0; jj < 8; ++jj) { const int i = rs + 4 * (hb * 8 + jj), t = t0 - 30 + i;
                va[jj] = (f32x4){0.f, 0.f, 0.f, 0.f}; ga[jj] = va[jj];
                if (i < nrow) {
                    if (t < 0) { if (samp) va[jj] = *(const f32x4*)(conv0 + (size_t)i * 512 + c4); }
                    else { const bf16* pr = P + (size_t)(rowbase - 30 + i) * NPRE + PD0 + c4; va[jj] = ldb4(pr); ga[jj] = ldb4(pr + 512); } } }
#pragma unroll
            for (int jj = 0; jj < 8; ++jj) { const int i = rs + 4 * (hb * 8 + jj), t = t0 - 30 + i;
                if (i < nrow) { f32x4 zv = va[jj];
                    if (t >= 0) { zv[0] *= sigmoidf_(ga[jj][0]); zv[1] *= sigmoidf_(ga[jj][1]); zv[2] *= sigmoidf_(ga[jj][2]); zv[3] *= sigmoidf_(ga[jj][3]); }
                    *(LAS f32x4*)(z + i * 512 + c4) = zv; } }
        }
    }
    LDS_WAIT(); __syncthreads();
    if (samp) { float* dst = ((float*)a.out) + O_CS + (size_t)(l * NSB + sb) * 30 * 512; for (int i = 0; i < 30; ++i) dst[(size_t)i * 512 + c] = z[(4 + i) * 512 + c]; }
    else if (t0 + 32 == SEQ) { float* dst = ((float*)a.out) + O_CP + (size_t)(l * 2 + (item * 32) / SEQ) * 30 * 512; for (int i = 0; i < 30; ++i) dst[(size_t)i * 512 + c] = z[(32 + i) * 512 + c]; }
    float y[32];
#pragma unroll
    for (int t = 0; t < 32; ++t) y[t] = cb;
#pragma unroll
    for (int i = 0; i < 62; ++i) {
        if (i < 30 + ntok) { const float zi = z[i * 512 + c];
#pragma unroll
            for (int t = 0; t < 32; ++t) { if (i - t >= 0 && i - t <= 30) y[t] = fmaf(zi, wv[i - t], y[t]); } }
    }
    {
        float u1[16], u2[16];
        { const bool hb = (lane & 32) != 0;
#pragma unroll
          for (int j = 0; j < 16; ++j) { const float ka = hb ? y[16 + j] : y[j], sa = hb ? y[j] : y[16 + j]; u1[j] = ka + __shfl_xor(sa, 32); u2[j] = ka * ka + __shfl_xor(sa * sa, 32); } }
        float v1[8], v2[8];
        { const bool hb = (lane & 16) != 0;
#pragma unroll
          for (int j = 0; j < 8; ++j) { v1[j] = (hb ? u1[8 + j] : u1[j]) + __shfl_xor(hb ? u1[j] : u1[8 + j], 16); v2[j] = (hb ? u2[8 + j] : u2[j]) + __shfl_xor(hb ? u2[j] : u2[8 + j], 16); } }
        float w1[4], w2[4];
        { const bool hb = (lane & 8) != 0;
#pragma unroll
          for (int j = 0; j < 4; ++j) { w1[j] = (hb ? v1[4 + j] : v1[j]) + __shfl_xor(hb ? v1[j] : v1[4 + j], 8); w2[j] = (hb ? v2[4 + j] : v2[j]) + __shfl_xor(hb ? v2[j] : v2[4 + j], 8); } }
        float x1[2], x2[2];
        { const bool hb = (lane & 4) != 0;
#pragma unroll
          for (int j = 0; j < 2; ++j) { x1[j] = (hb ? w1[2 + j] : w1[j]) + __shfl_xor(hb ? w1[j] : w1[2 + j], 4); x2[j] = (hb ? w2[2 + j] : w2[j]) + __shfl_xor(hb ? w2[j] : w2[2 + j], 4); } }
        float z1, z2;
        { const bool hb = (lane & 2) != 0; z1 = (hb ? x1[1] : x1[0]) + __shfl_xor(hb ? x1[0] : x1[1], 2); z2 = (hb ? x2[1] : x2[0]) + __shfl_xor(hb ? x2[0] : x2[1], 2); }
        z1 += __shfl_xor(z1, 1); z2 += __shfl_xor(z2, 1);
        const int trow = ((lane >> 5) & 1) * 16 + ((lane >> 4) & 1) * 8 + ((lane >> 3) & 1) * 4 + ((lane >> 2) & 1) * 2 + ((lane >> 1) & 1);
        if ((lane & 1) == 0) { red[(trow * 8 + w) * 2] = z1; red[(trow * 8 + w) * 2 + 1] = z2; }
    }
    LDS_WAIT(); __syncthreads();
    if (tid < 32) { float s1 = 0.f, s2 = 0.f;
#pragma unroll
        for (int j = 0; j < 8; ++j) { s1 += red[(tid * 8 + j) * 2]; s2 += red[(tid * 8 + j) * 2 + 1]; }
        const float mean = s1 * (1.f / 512.f), var = fmaxf(s2 * (1.f / 512.f) - mean * mean, 0.f);
        red[512 + tid * 2] = mean; red[512 + tid * 2 + 1] = 1.0f / sqrtf(var + 1e-5f); }
    LDS_WAIT(); __syncthreads();
#pragma unroll
    for (int t = 0; t < 32; ++t) { if (t < ntok) { const float v = (y[t] - red[512 + t * 2]) * red[512 + t * 2 + 1] * lg + lb; ACTD[(size_t)(rowbase + t) * BW + c] = (bf16)f2bf(v * sigmoidf_(v)); } }
    __syncthreads();
}

template <bool SK>
__device__ __forceinline__ void scan_task(const float* R, const float* W, const float* KX, const float* KK, const float* KKA, const float* V, float* OUT, float* STT, const float* S0, float* SOUT, int nstep, int lane) {
    float s[64];
    if (S0) {
#pragma unroll
        for (int k4 = 0; k4 < 16; ++k4) { const f32x4 v = *(const f32x4*)(S0 + lane * 64 + 4 * k4); s[4 * k4] = v[0]; s[4 * k4 + 1] = v[1]; s[4 * k4 + 2] = v[2]; s[4 * k4 + 3] = v[3]; }
    } else {
#pragma unroll
        for (int k = 0; k < 64; ++k) s[k] = SK ? 0.f : (k == lane ? 1.f : 0.f);
    }
    float pf0 = 0.f, pf1 = 0.f, pf2 = 0.f, pf3 = 0.f, pf4 = 0.f;
    for (int t = 0; t < nstep; ++t) {
        asm volatile("" :: "v"(pf0), "v"(pf1), "v"(pf2), "v"(pf3), "v"(pf4));
        { const int tp = (t + 2 < nstep) ? t + 2 : t; const size_t po = (size_t)tp * BW + lane;
          pf0 = KK[po]; pf1 = W[po]; pf2 = KKA[po]; pf3 = KX[po]; pf4 = R[po]; }
        cfloat* kk = (cfloat*)(KK + (size_t)t * BW); cfloat* w = (cfloat*)(W + (size_t)t * BW); cfloat* kka = (cfloat*)(KKA + (size_t)t * BW);
        cfloat* kx = (cfloat*)(KX + (size_t)t * BW); cfloat* r = (cfloat*)(R + (size_t)t * BW);
        float d0 = 0.f, d1 = 0.f;
#pragma unroll
        for (int k = 0; k < 64; k += 2) { d0 = fmaf(s[k], kk[k], d0); d1 = fmaf(s[k + 1], kk[k + 1], d1); }
        const float nd = -(d0 + d1);
        const float vt = SK ? V[(size_t)t * BW + lane] : 0.f;
        float o0 = 0.f, o1 = 0.f;
#pragma unroll
        for (int k = 0; k < 64; k += 2) {
            float x = s[k] * w[k]; x = fmaf(nd, kka[k], x); if (SK) x = fmaf(vt, kx[k], x); s[k] = x; o0 = fmaf(x, r[k], o0);
            float y = s[k + 1] * w[k + 1]; y = fmaf(nd, kka[k + 1], y); if (SK) y = fmaf(vt, kx[k + 1], y); s[k + 1] = y; o1 = fmaf(y, r[k + 1], o1);
        }
        OUT[(size_t)t * BW + lane] = o0 + o1;
    }
    asm volatile("" :: "v"(pf0), "v"(pf1), "v"(pf2), "v"(pf3), "v"(pf4));
    if (STT) {
#pragma unroll
        for (int k = 0; k < 64; ++k) STT[k * 64 + lane] = s[k];
    }
    if (SOUT) {
#pragma unroll
        for (int k4 = 0; k4 < 16; ++k4) *(f32x4*)(SOUT + lane * 64 + 4 * k4) = (f32x4){s[4 * k4], s[4 * k4 + 1], s[4 * k4 + 2], s[4 * k4 + 3]};
    }
}
__device__ __forceinline__ const float* uni_ptr(const float* p) { const unsigned long long v = (unsigned long long)p; const unsigned lo = __builtin_amdgcn_readfirstlane((unsigned)v), hi = __builtin_amdgcn_readfirstlane((unsigned)(v >> 32)); return (const float*)(((unsigned long long)hi << 32) | lo); }
__device__ __forceinline__ void scan_item(Frame& F, int l, int item, unsigned char* ws) {
    const int b = item >> 7, chunk = (item >> 1) & 63, hq = item & 1, h = hq * 4 + (F.wave & 3);
    const size_t ro = ((size_t)(b * SEQ + chunk * 64)) * BW + h * 64; const size_t so = ((size_t)((b * 8 + h) * 64 + chunk)) * 4096;
    const float* R = (const float*)(ws + WS_R + l * SZ_RWL) + ro; const float* W = (const float*)(ws + WS_W + l * SZ_RWL) + ro; const float* KX = (const float*)(ws + WS_KX + l * SZ_RWL) + ro;
    const float* KK = (const float*)(ws + WS_KK + l * SZ_RWL) + ro; const float* KKA = (const float*)(ws + WS_KKA + l * SZ_RWL) + ro; const float* V = (const float*)(ws + WS_V) + ro;
    if (F.wave >> 2) scan_task<true>(uni_ptr(R), uni_ptr(W), uni_ptr(KX), uni_ptr(KK), uni_ptr(KKA), V, (float*)(ws + WS_OL) + ro, (float*)(ws + WS_LC) + so, nullptr, nullptr, 64, F.lane);
    else scan_task<false>(uni_ptr(R), uni_ptr(W), uni_ptr(KX), uni_ptr(KK), uni_ptr(KKA), V, (float*)(ws + WS_PR) + ro, nullptr, nullptr, (float*)(ws + WS_PC) + so, 64, F.lane);
}
__device__ __forceinline__ void scan_sample_item(Frame& F, const Args& a, int l, int sb, unsigned char* ws) {
    const int h = F.wave; const size_t ro = ((size_t)(MP + sb * 4)) * BW + h * 64;
    const float* S0 = (const float*)a.in[5] + ((size_t)((l * NSB + sb) * 8 + h)) * 4096; float* SO = ((float*)a.out) + O_WS + ((size_t)((l * NSB + sb) * 8 + h)) * 4096;
    scan_task<true>(uni_ptr((const float*)(ws + WS_R + l * SZ_RWL) + ro), uni_ptr((const float*)(ws + WS_W + l * SZ_RWL) + ro), uni_ptr((const float*)(ws + WS_KX + l * SZ_RWL) + ro), uni_ptr((const float*)(ws + WS_KK + l * SZ_RWL) + ro), uni_ptr((const float*)(ws + WS_KKA + l * SZ_RWL) + ro),
                    (const float*)(ws + WS_V) + ro, (float*)(ws + WS_OL) + ro, nullptr, S0, SO, 4, F.lane);
}
__device__ __forceinline__ float4 ld4(const float* p) { return *(const float4*)p; }
__device__ __forceinline__ void decode_item(Frame& F, const Args& a, int l, int item, unsigned char* ws) {
    const int sb = item >> 6, seg = item & 63, lane = F.lane, w = F.wave, tid = F.tid;
    LAS float* OM = (LAS float*)F.lds; LAS float* BT = OM + 256 * 16; LAS float* SEGT = BT + 256 * 16;
    const float* QS = (const float*)(ws + WS_QS); const int* pt = (const int*)a.in[4] + sb * NPAGES;
    const float* ck = (const float*)a.in[2] + (size_t)l * NPHYS * 128 * 512; const float* cv = (const float*)a.in[3] + (size_t)l * NPHYS * 128 * 512;
    const float* bias = (const float*)a.in[17] + l * 4;
    f32x4 Qr[4][2];
#pragma unroll
    for (int qi = 0; qi < 4; ++qi)
#pragma unroll
        for (int g = 0; g < 2; ++g) Qr[qi][g] = *(const f32x4*)(QS + (size_t)(sb * 4 + qi) * BW + g * 256 + 4 * lane);
    const int page = pt[seg * 2 + (w >> 2)];
    const size_t rbase = ((size_t)page * 128 + (w & 3) * 32) * 512;
    const int b4 = (lane >> 4) & 1, b3 = (lane >> 3) & 1, b2 = (lane >> 2) & 1;
    const int vidx = b4 * 4 + b3 * 2 + b2, qi_m = vidx >> 1, head_m = (vidx & 1) * 2 + (lane >> 5);
    const float bias_m = bias[head_m] * LOG2E;
    {
        f32x4 ka[4][2], kb[4][2];
#define DEC_LOADK(dst, i0) do { asm volatile("" ::: "memory"); _Pragma("unroll") for (int u = 0; u < 4; ++u) { const float* kr = ck + rbase + (size_t)((i0) + u) * 512; dst[u][0] = __builtin_nontemporal_load((const f32x4*)(kr + 4 * lane)); dst[u][1] = __builtin_nontemporal_load((const f32x4*)(kr + 256 + 4 * lane)); } } while (0)
#define DEC_SCORE(src, i0) do { _Pragma("unroll") for (int u = 0; u < 4; ++u) { \
            float v[8]; \
            _Pragma("unroll") for (int qi = 0; qi < 4; ++qi) { const f32x4 p0 = src[u][0] * Qr[qi][0], p1 = src[u][1] * Qr[qi][1]; v[qi * 2] = (p0[0] + p0[1]) + (p0[2] + p0[3]); v[qi * 2 + 1] = (p1[0] + p1[1]) + (p1[2] + p1[3]); } \
            float r4[4], r2[2], r1; \
            _Pragma("unroll") for (int j = 0; j < 4; ++j) { const float snd = b4 ? v[j] : v[4 + j], kp = b4 ? v[4 + j] : v[j]; r4[j] = kp + __shfl_xor(snd, 16); } \
            _Pragma("unroll") for (int j = 0; j < 2; ++j) { const float snd = b3 ? r4[j] : r4[2 + j], kp = b3 ? r4[2 + j] : r4[j]; r2[j] = kp + __shfl_xor(snd, 8); } \
            { const float snd = b2 ? r2[0] : r2[1], kp = b2 ? r2[1] : r2[0]; r1 = kp + __shfl_xor(snd, 4); } \
            r1 += __shfl_xor(r1, 2); r1 += __shfl_xor(r1, 1); \
            const float e = ex2(r1 + bias_m), om = rcpf_(1.0f + e), bt = e * om; \
            if ((lane & 3) == 0) { const int kl = w * 32 + (i0) + u; OM[kl * 16 + qi_m * 4 + head_m] = om; BT[kl * 16 + qi_m * 4 + head_m] = bt; } } } while (0)
        DEC_LOADK(ka, 0); DEC_LOADK(kb, 4); DEC_SCORE(ka, 0); DEC_LOADK(ka, 8); DEC_SCORE(kb, 4); DEC_LOADK(kb, 12); DEC_SCORE(ka, 8); DEC_LOADK(ka, 16); DEC_SCORE(kb, 12); DEC_LOADK(kb, 20); DEC_SCORE(ka, 16); DEC_LOADK(ka, 24); DEC_SCORE(kb, 20); DEC_LOADK(kb, 28); DEC_SCORE(ka, 24); DEC_SCORE(kb, 28);
#undef DEC_LOADK
#undef DEC_SCORE
    }
    LDS_WAIT(); __syncthreads();
    {
        const int qh = tid & 15, sg = tid >> 4;
        float pr = 1.f;
#pragma unroll
        for (int j = 0; j < 8; ++j) pr *= OM[(sg * 8 + j) * 16 + qh];
        SEGT[sg * 16 + qh] = pr;
        LDS_WAIT(); __syncthreads();
        float suf = 1.f;
        for (int s2 = 31; s2 > sg; --s2) suf *= SEGT[s2 * 16 + qh];
#pragma unroll
        for (int j = 7; j >= 0; --j) { const int kl = sg * 8 + j; const float att = BT[kl * 16 + qh] * suf; suf *= OM[kl * 16 + qh]; BT[kl * 16 + qh] = att; }
        if (sg == 0) ((float*)(ws + WS_TSEG))[(size_t)(sb * 64 + seg) * 16 + qh] = suf;
    }
    LDS_WAIT(); __syncthreads();
    f32x4 O[4][2];
#pragma unroll
    for (int qi = 0; qi < 4; ++qi) { O[qi][0] = (f32x4){0.f, 0.f, 0.f, 0.f}; O[qi][1] = O[qi][0]; }
    const int hh = lane >> 5;
    {
        f32x4 va[4][2], vb[4][2];
#define DEC_LOADV(dst, i0) do { asm volatile("" ::: "memory"); _Pragma("unroll") for (int u = 0; u < 4; ++u) { const float* vr = cv + rbase + (size_t)((i0) + u) * 512; dst[u][0] = __builtin_nontemporal_load((const f32x4*)(vr + 4 * lane)); dst[u][1] = __builtin_nontemporal_load((const f32x4*)(vr + 256 + 4 * lane)); } } while (0)
#define DEC_ACC(src, i0) do { _Pragma("unroll") for (int u = 0; u < 4; ++u) { const int kl = w * 32 + (i0) + u; \
            _Pragma("unroll") for (int qi = 0; qi < 4; ++qi) { const float a0 = BT[kl * 16 + qi * 4 + hh], a1 = BT[kl * 16 + qi * 4 + 2 + hh]; O[qi][0] += src[u][0] * a0; O[qi][1] += src[u][1] * a1; } } } while (0)
        DEC_LOADV(va, 0); DEC_LOADV(vb, 4); DEC_ACC(va, 0); DEC_LOADV(va, 8); DEC_ACC(vb, 4); DEC_LOADV(vb, 12); DEC_ACC(va, 8); DEC_LOADV(va, 16); DEC_ACC(vb, 12); DEC_LOADV(vb, 20); DEC_ACC(va, 16); DEC_LOADV(va, 24); DEC_ACC(vb, 20); DEC_LOADV(vb, 28); DEC_ACC(va, 24); DEC_ACC(vb, 28);
#undef DEC_LOADV
#undef DEC_ACC
    }
    __syncthreads();
    LAS float* RED = (LAS float*)F.lds;
#pragma unroll
    for (int qi = 0; qi < 4; ++qi)
#pragma unroll
        for (int g = 0; g < 2; ++g) { LAS float* d = RED + ((w * 16 + qi * 4 + g * 2 + hh) * 128 + 4 * (lane & 31)); d[0] = O[qi][g][0]; d[1] = O[qi][g][1]; d[2] = O[qi][g][2]; d[3] = O[qi][g][3]; }
    LDS_WAIT(); __syncthreads();
    { f32x4 s = (f32x4){0.f, 0.f, 0.f, 0.f};
#pragma unroll
      for (int j = 0; j < 8; ++j) { const LAS float* p = RED + j * 2048 + tid * 4; s += (f32x4){p[0], p[1], p[2], p[3]}; }
      *(f32x4*)((float*)(ws + WS_OSEG) + (size_t)(sb * 64 + seg) * 2048 + tid * 4) = s; }
    __syncthreads();
}

__device__ __forceinline__ void attn_unit(Frame& F, int b, int h, int qt, int kb_lo, int nkb, const bf16* QB, const bf16* KB, const bf16* VT, bf16* OUT, float bias2, f32x4* part, float* tpart) {
    LAS bf16* Ks = (LAS bf16*)F.lds;
    LAS bf16* Vs = (LAS bf16*)(F.lds + 34816);
    const int w = F.wave, lane = F.lane, li = lane & 15, g = lane >> 4, tid = F.tid;
    const int q0 = qt * 128 + w * 16, qpos = q0 + li;
    bf16x8 qf[4];
    { const bf16* qp = QB + (size_t)(b * SEQ + qpos) * BW + h * 128 + 8 * g;
#pragma unroll
      for (int ks = 0; ks < 4; ++ks) qf[ks] = *(const bf16x8*)(qp + 32 * ks); }
    f32x4 oacc[8];
#pragma unroll
    for (int dt = 0; dt < 8; ++dt) oacc[dt] = (f32x4){0.f, 0.f, 0.f, 0.f};
    float carry = 1.f;
    const int kr0 = tid >> 4, kc0 = (tid & 15) * 8;
    const int vr0 = tid >> 3, vc0 = (tid & 7) * 8;
    const bf16* kg = KB + (size_t)(b * SEQ) * BW + h * 128 + kc0;
    const bf16* vg = VT + (size_t)((b * 4 + h) * 128) * SEQ + vc0;
    u32x4 lk[2], lv[2];
    { const int kb = kb_lo + nkb - 1;
      lk[0] = *(const u32x4*)(kg + (size_t)(kb * 64 + kr0) * BW); lk[1] = *(const u32x4*)(kg + (size_t)(kb * 64 + kr0 + 32) * BW);
      lv[0] = *(const u32x4*)(vg + (size_t)vr0 * SEQ + kb * 64); lv[1] = *(const u32x4*)(vg + (size_t)(vr0 + 64) * SEQ + kb * 64);
      *(LAS u32x4*)(Ks + kr0 * 136 + kc0) = lk[0]; *(LAS u32x4*)(Ks + (kr0 + 32) * 136 + kc0) = lk[1];
      *(LAS u32x4*)(Vs + vr0 * 72 + vc0) = lv[0]; *(LAS u32x4*)(Vs + (vr0 + 64) * 72 + vc0) = lv[1]; }
    LDS_WAIT(); __syncthreads();
    for (int it = 0; it < nkb; ++it) {
        const int kb = kb_lo + nkb - 1 - it, buf = it & 1; const bool more = (it + 1 < nkb);
        if (more) { const int k2 = kb - 1;
            lk[0] = *(const u32x4*)(kg + (size_t)(k2 * 64 + kr0) * BW); lk[1] = *(const u32x4*)(kg + (size_t)(k2 * 64 + kr0 + 32) * BW);
            lv[0] = *(const u32x4*)(vg + (size_t)vr0 * SEQ + k2 * 64); lv[1] = *(const u32x4*)(vg + (size_t)(vr0 + 64) * SEQ + k2 * 64); }
        if (kb * 64 < q0 + 15) {
            const LAS bf16* Kb = Ks + buf * (64 * 136); const LAS bf16* Vb = Vs + buf * (128 * 72);
            f32x4 s[4];
#pragma unroll
            for (int st = 0; st < 4; ++st) { s[st] = (f32x4){bias2, bias2, bias2, bias2};
#pragma unroll
                for (int ks = 0; ks < 4; ++ks) { const bf16x8 af = *(const LAS bf16x8*)(Kb + (16 * st + li) * 136 + 32 * ks + 8 * g); s[st] = __builtin_amdgcn_mfma_f32_16x16x32_bf16(af, qf[ks], s[st], 0, 0, 0); } }
            float om[4][4], bt[4][4], lt[4], X[4], GT[4];
            if (kb * 64 + 63 >= q0) {
                const int kbase = kb * 64 + 4 * g;
#pragma unroll
                for (int st = 0; st < 4; ++st)
#pragma unroll
                    for (int r = 0; r < 4; ++r) { const float e = ex2(s[st][r]); float o = rcpf_(1.0f + e), bb = e * o;
                        if (kbase + 16 * st + r >= qpos) { o = 1.f; bb = 0.f; }
                        om[st][r] = o; bt[st][r] = bb; }
            } else {
#pragma unroll
                for (int st = 0; st < 4; ++st)
#pragma unroll
                    for (int r = 0; r < 4; ++r) { const float e = ex2(s[st][r]); const float o = rcpf_(1.0f + e); om[st][r] = o; bt[st][r] = e * o; }
            }
#pragma unroll
            for (int st = 0; st < 4; ++st) {
                const float sp2 = om[st][3], sp1 = sp2 * om[st][2], sp0 = sp1 * om[st][1]; lt[st] = sp0 * om[st][0];
                bt[st][2] *= sp2; bt[st][1] *= sp1; bt[st][0] *= sp0;
                const float xa = __shfl_xor(lt[st], 16), xb = __shfl_xor(lt[st], 32), xc = __shfl_xor(lt[st], 48);
                X[st] = (g == 0) ? xa * xb * xc : (g == 1) ? xb * xc : (g == 2) ? xa : 1.f;
                GT[st] = lt[st] * xa * xb * xc;
            }
            const float Y3 = carry, Y2 = Y3 * GT[3], Y1 = Y2 * GT[2], Y0 = Y1 * GT[1];
            carry = Y0 * GT[0];
            const float f[4] = {Y0 * X[0], Y1 * X[1], Y2 * X[2], Y3 * X[3]};
            bf16x8 pf[2];
#pragma unroll
            for (int ks = 0; ks < 2; ++ks) { u32x4 pw; pw.x = pk2(bt[2 * ks][0] * f[2 * ks], bt[2 * ks][1] * f[2 * ks]); pw.y = pk2(bt[2 * ks][2] * f[2 * ks], bt[2 * ks][3] * f[2 * ks]);
                pw.z = pk2(bt[2 * ks + 1][0] * f[2 * ks + 1], bt[2 * ks + 1][1] * f[2 * ks + 1]); pw.w = pk2(bt[2 * ks + 1][2] * f[2 * ks + 1], bt[2 * ks + 1][3] * f[2 * ks + 1]); pf[ks] = __builtin_bit_cast(bf16x8, pw); }
#pragma unroll
            for (int dt = 0; dt < 8; ++dt)
#pragma unroll
                for (int ks = 0; ks < 2; ++ks) { const LAS bf16* vp = Vb + (16 * dt + li) * 72 + 32 * ks + 4 * g;
                    const u32x2 a0 = *(const LAS u32x2*)vp, a1 = *(const LAS u32x2*)(vp + 16); const u32x4 av = (u32x4){a0.x, a0.y, a1.x, a1.y};
                    oacc[dt] = __builtin_amdgcn_mfma_f32_16x16x32_bf16(__builtin_bit_cast(bf16x8, av), pf[ks], oacc[dt], 0, 0, 0); }
        }
        if (more) { const int nb = buf ^ 1;
            *(LAS u32x4*)(Ks + nb * (64 * 136) + kr0 * 136 + kc0) = lk[0]; *(LAS u32x4*)(Ks + nb * (64 * 136) + (kr0 + 32) * 136 + kc0) = lk[1];
            *(LAS u32x4*)(Vs + nb * (128 * 72) + vr0 * 72 + vc0) = lv[0]; *(LAS u32x4*)(Vs + nb * (128 * 72) + (vr0 + 64) * 72 + vc0) = lv[1]; }
        LDS_WAIT(); __syncthreads();
    }
    if (part) {
#pragma unroll
        for (int dt = 0; dt < 8; ++dt) part[(w * 8 + dt) * 64 + lane] = oacc[dt];
        if (tpart) tpart[w * 64 + lane] = carry;
    } else {
        bf16* op = OUT + (size_t)(b * SEQ + qpos) * BW + h * 128 + 4 * g;
#pragma unroll
        for (int dt = 0; dt < 8; ++dt) *(u32x2*)(op + 16 * dt) = (u32x2){pk2(oacc[dt][0], oacc[dt][1]), pk2(oacc[dt][2], oacc[dt][3])};
    }
}
__device__ __forceinline__ void attn_combine_item(Frame& F, int item, unsigned char* ws, bf16* OUT) {
    const int bh = item >> 4, q16 = item & 15, qt = 16 + q16, b = bh >> 2, h = bh & 3, w = F.wave, lane = F.lane, li = lane & 15, g = lane >> 4;
    const size_t base = (size_t)(bh * 16 + q16);
    const float* pl = (const float*)(ws + WS_OPART) + (base * 2 + 0) * 16384 + (size_t)(w * 8 * 64 + lane) * 4;
    const float* pr = (const float*)(ws + WS_OPART) + (base * 2 + 1) * 16384 + (size_t)(w * 8 * 64 + lane) * 4;
    const float t = ((const float*)(ws + WS_TPART))[base * 512 + w * 64 + lane];
    bf16* op = OUT + (size_t)(b * SEQ + qt * 128 + w * 16 + li) * BW + h * 128 + 4 * g;
#pragma unroll
    for (int dt = 0; dt < 8; ++dt) { const f32x4 a = *(const f32x4*)(pr + dt * 256), c = *(const f32x4*)(pl + dt * 256); const f32x4 o = a + c * t; *(u32x2*)(op + 16 * dt) = (u32x2){pk2(o[0], o[1]), pk2(o[2], o[3])}; }
}
#define CARRY_BAR() do { asm volatile("s_waitcnt lgkmcnt(0)" ::: "memory"); __builtin_amdgcn_s_barrier(); asm volatile("" ::: "memory"); } while (0)
__device__ __forceinline__ void carry_item(Frame& F, const Args& a, int l, int bh, unsigned char* ws) {
    const int lane = F.lane, w = F.wave, bi = w & 1, bj = (w >> 1) & 1, kh = w >> 2, l31 = lane & 31, hi = lane >> 5;
    LAS float* St = (LAS float*)F.lds;
    LAS float* Pp = (LAS float*)(F.lds + 16384);
    const float* PC = (const float*)(ws + WS_PC) + (size_t)bh * 64 * 4096; const float* LC = (const float*)(ws + WS_LC) + (size_t)bh * 64 * 4096; float* SS = (float*)(ws + WS_SS) + (size_t)bh * 64 * 4096;
    for (int i = F.tid; i < 4096; i += 512) { St[i] = 0.f; SS[i] = 0.f; }
    const int lo_p = (32 * kh + hi) * 64 + 32 * bi + l31, lo_s = (32 * kh + hi) * 64 + 32 * bj + l31, lo_o = (32 * bi + 4 * hi) * 64 + 32 * bj + l31;
    float afn[16], ltn[16];
#pragma unroll
    for (int kk2 = 0; kk2 < 16; ++kk2) afn[kk2] = PC[lo_p + kk2 * 128];
#pragma unroll
    for (int r = 0; r < 16; ++r) ltn[r] = (kh == 0) ? LC[lo_o + ((r & 3) + 8 * (r >> 2)) * 64] : 0.f;
    CARRY_BAR();
    for (int c = 0; c < 64; ++c) {
        float af[16], lt[16];
#pragma unroll
        for (int i = 0; i < 16; ++i) { af[i] = afn[i]; lt[i] = ltn[i]; }
        if (c < 63) {
            const float* Pn = PC + (size_t)(c + 1) * 4096; const float* Ln = LC + (size_t)(c + 1) * 4096;
#pragma unroll
            for (int kk2 = 0; kk2 < 16; ++kk2) afn[kk2] = Pn[lo_p + kk2 * 128];
            if (kh == 0) {
#pragma unroll
                for (int r = 0; r < 16; ++r) ltn[r] = Ln[lo_o + ((r & 3) + 8 * (r >> 2)) * 64];
            }
        }
        float bfv[16];
#pragma unroll
        for (int kk2 = 0; kk2 < 16; ++kk2) bfv[kk2] = St[lo_s + kk2 * 128];
        f32x16 acc0, acc1;
#pragma unroll
        for (int r = 0; r < 16; ++r) { acc0[r] = 0.f; acc1[r] = 0.f; }
#pragma unroll
        for (int kk2 = 0; kk2 < 16; kk2 += 2) { acc0 = __builtin_amdgcn_mfma_f32_32x32x2f32(af[kk2], bfv[kk2], acc0, 0, 0, 0); acc1 = __builtin_amdgcn_mfma_f32_32x32x2f32(af[kk2 + 1], bfv[kk2 + 1], acc1, 0, 0, 0); }
        if (kh == 1) {
#pragma unroll
            for (int r = 0; r < 16; ++r) Pp[(bj * 2 + bi) * 1024 + r * 64 + lane] = acc0[r] + acc1[r];
        }
        CARRY_BAR();
        if (kh == 0) {
            float* so = SS + (size_t)(c + 1) * 4096;
#pragma unroll
            for (int r = 0; r < 16; ++r) { const int jo = ((r & 3) + 8 * (r >> 2)) * 64;
                const float nv = (acc0[r] + acc1[r]) + Pp[(bj * 2 + bi) * 1024 + r * 64 + lane] + lt[r];
                St[lo_o + jo] = nv;
                if (c < 63) so[lo_o + jo] = nv;
                else { const int j = 32 * bi + (r & 3) + 8 * (r >> 2) + 4 * hi, v = 32 * bj + l31; ((float*)a.out)[O_WP + ((size_t)(l * 16 + bh)) * 4096 + v * 64 + j] = nv; } }
        }
        CARRY_BAR();
    }
}

__device__ __forceinline__ void fixup_item(Frame& F, const Args& a, int l, int item, unsigned char* ws, bf16* ACTC) {
    const int b = item >> 7, chunk = (item >> 1) & 63, h = (item & 1) * 4 + (F.wave >> 1), th = F.wave & 1, lane = F.lane, l31 = lane & 31, hi = lane >> 5;
    LAS float* pr = (LAS float*)(F.lds + F.wave * 8704);
    LAS float* stt = pr + 2080;
    const size_t ro = ((size_t)(b * SEQ + chunk * 64 + 32 * th)) * BW + h * 64;
    const float* PR = (const float*)(ws + WS_PR) + ro; const float* OL = (const float*)(ws + WS_OL) + ro;
    const float* St = (const float*)(ws + WS_SS) + ((size_t)((b * 8 + h) * 64 + chunk)) * 4096;
    f32x16 acc[2];
    const float gg = ((const float*)a.in[28])[l * 512 + h * 64 + lane], gb = ((const float*)a.in[29])[l * 512 + h * 64 + lane];
    const float* Vv = (const float*)(ws + WS_V) + ro; const float* GG = (const float*)(ws + WS_GG) + ro; const float* RK = (const float*)(ws + WS_RK) + ((size_t)(b * SEQ + chunk * 64 + 32 * th)) * 8 + h;
    float b0[32], b1[32];
    {
        float prv[32];
#pragma unroll
        for (int t = 0; t < 32; ++t) prv[t] = PR[(size_t)t * BW + lane];
#pragma unroll
        for (int vj = 0; vj < 2; ++vj)
#pragma unroll
            for (int r = 0; r < 16; ++r) acc[vj][r] = OL[(size_t)((r & 3) + 8 * (r >> 2) + 4 * hi) * BW + 32 * vj + l31];
        if (chunk > 0) {
#pragma unroll
            for (int j = 0; j < 32; ++j) { const int m = 2 * j + hi; b0[j] = St[m * 64 + l31]; b1[j] = St[m * 64 + 32 + l31]; }
        }
#pragma unroll
        for (int t = 0; t < 32; ++t) pr[t * 65 + lane] = prv[t];
    }
    LDS_WAIT();
    if (chunk > 0) {
#pragma unroll
        for (int j = 0; j < 32; ++j) { const int m = 2 * j + hi; const float a0 = pr[l31 * 65 + m];
            acc[0] = __builtin_amdgcn_mfma_f32_32x32x2f32(a0, b0[j], acc[0], 0, 0, 0); acc[1] = __builtin_amdgcn_mfma_f32_32x32x2f32(a0, b1[j], acc[1], 0, 0, 0); }
    }
    float vv[32], gv[32], rk[32];
#pragma unroll
    for (int t = 0; t < 32; ++t) { vv[t] = Vv[(size_t)t * BW + lane]; gv[t] = GG[(size_t)t * BW + lane]; rk[t] = RK[(size_t)t * 8]; }
#pragma unroll
    for (int vj = 0; vj < 2; ++vj)
#pragma unroll
        for (int r = 0; r < 16; ++r) pr[((r & 3) + 8 * (r >> 2) + 4 * hi) * 65 + 32 * vj + l31] = acc[vj][r];
    LDS_WAIT();
    if (lane < 32) { float s1 = 0.f;
#pragma unroll 16
        for (int v = 0; v < 64; ++v) s1 += pr[lane * 65 + v];
        const float mean = s1 * (1.f / 64.f); float s2 = 0.f;
#pragma unroll 16
        for (int v = 0; v < 64; ++v) { const float d = pr[lane * 65 + v] - mean; s2 = fmaf(d, d, s2); }
        stt[lane * 2] = mean; stt[lane * 2 + 1] = 1.0f / sqrtf(s2 * (1.f / 64.f) + 64e-5f); }
    LDS_WAIT();
    bf16* op = ACTC + (size_t)(b * SEQ + chunk * 64 + 32 * th) * BW + h * 64 + lane;
#pragma unroll
    for (int t = 0; t < 32; ++t) {
        const float y = ((pr[t * 65 + lane] - stt[t * 2]) * stt[t * 2 + 1] * gg + gb + rk[t] * vv[t]) * gv[t];
        op[(size_t)t * BW] = (bf16)f2bf(y); }
    LDS_WAIT();
}
__device__ __forceinline__ void cpost_sample_item(Frame& F, const Args& a, int l, int part, unsigned char* ws, bf16* ACTC) {
    const int h = F.wave, lane = F.lane;
    const float gg = ((const float*)a.in[28])[l * 512 + h * 64 + lane], gb = ((const float*)a.in[29])[l * 512 + h * 64 + lane];
    float xo[8], vv[8], gv[8], rk[8];
#pragma unroll
    for (int j = 0; j < 8; ++j) { const int r = part * 8 + j; const size_t o = (size_t)(MP + r) * BW + h * 64 + lane;
        xo[j] = ((const float*)(ws + WS_OL))[o]; vv[j] = ((const float*)(ws + WS_V))[o]; gv[j] = ((const float*)(ws + WS_GG))[o]; rk[j] = ((const float*)(ws + WS_RK))[(size_t)(MP + r) * 8 + h]; }
#pragma unroll
    for (int j = 0; j < 8; ++j) { const int r = part * 8 + j; const size_t o = (size_t)(MP + r) * BW + h * 64 + lane;
        float x = xo[j];
        const float mean = wave_sum(x) * (1.f / 64.f); x -= mean;
        const float rstd = 1.0f / sqrtf(wave_sum(x * x) * (1.f / 64.f) + 64e-5f);
        ACTC[o] = (bf16)f2bf((x * rstd * gg + gb + rk[j] * vv[j]) * gv[j]); }
}
__device__ __forceinline__ void decode_combine_item(Frame& F, const Args& a, int l, int qi, unsigned char* ws, bf16* ACTB) {
    const int sb = F.wave, lane = F.lane, hh = lane >> 5;
    const float* QS = (const float*)(ws + WS_QS); const float* OSEG = (const float*)(ws + WS_OSEG); const float* TSEG = (const float*)(ws + WS_TSEG);
    const float* bias = (const float*)a.in[17] + l * 4; const float bz[2] = {bias[hh] * LOG2E, bias[2 + hh] * LOG2E};
    const float* kn = ((float*)a.out) + O_KS + ((size_t)l * MS + sb * 4) * 512; const float* vn = ((float*)a.out) + O_VS + ((size_t)l * MS + sb * 4) * 512;
    float one = 1.f; asm volatile("" : "+v"(one));
    f32x4 O[2] = {(f32x4){0.f, 0.f, 0.f, 0.f}, (f32x4){0.f, 0.f, 0.f, 0.f}}; float carry[2] = {one, one};
    f32x4 q[2];
#pragma unroll
    for (int g = 0; g < 2; ++g) q[g] = *(const f32x4*)(QS + (size_t)(sb * 4 + qi) * BW + g * 256 + 4 * lane);
    for (int j = qi - 1; j >= 0; --j) {
#pragma unroll
        for (int g = 0; g < 2; ++g) {
            const f32x4 kv = *(const f32x4*)(kn + (size_t)j * 512 + g * 256 + 4 * lane), p = kv * q[g];
            float d = (p[0] + p[1]) + (p[2] + p[3]);
#pragma unroll
            for (int o = 1; o < 32; o <<= 1) d += __shfl_xor(d, o);
            const float e = ex2(d + bz[g]), om = rcpf_(1.0f + e), att = e * om * carry[g];
            O[g] += *(const f32x4*)(vn + (size_t)j * 512 + g * 256 + 4 * lane) * att; carry[g] *= om;
        }
    }
#pragma unroll 1
    for (int hs = 1; hs >= 0; --hs) {
        float tv[2][32];
#pragma unroll
        for (int g = 0; g < 2; ++g)
#pragma unroll
            for (int sg = 0; sg < 32; ++sg) tv[g][sg] = TSEG[(size_t)(sb * 64 + hs * 32 + sg) * 16 + qi * 4 + g * 2 + hh];
#pragma unroll
        for (int g = 0; g < 2; ++g) { float c = carry[g];
#pragma unroll
            for (int sg = 31; sg >= 0; --sg) { const float t = tv[g][sg]; tv[g][sg] = c; c *= t; }
            carry[g] = c; }
#pragma unroll
        for (int sb8 = 0; sb8 < 4; ++sb8) {
            f32x4 ov[2][8];
#pragma unroll
            for (int g = 0; g < 2; ++g)
#pragma unroll
                for (int j = 0; j < 8; ++j) { const int seg = hs * 32 + sb8 * 8 + j; ov[g][j] = *(const f32x4*)(OSEG + ((size_t)(sb * 64 + seg) * 16 + qi * 4 + g * 2 + hh) * 128 + 4 * (lane & 31)); }
#pragma unroll
            for (int g = 0; g < 2; ++g)
#pragma unroll
                for (int j = 0; j < 8; ++j) O[g] += ov[g][j] * tv[g][sb8 * 8 + j];
        }
    }
    bf16* op = ACTB + (size_t)(MP + sb * 4 + qi) * BW;
#pragma unroll
    for (int g = 0; g < 2; ++g) *(u32x2*)(op + g * 256 + 4 * lane) = (u32x2){pk2(O[g][0], O[g][1]), pk2(O[g][2], O[g][3])};
}

template <int MODE>
__device__ __forceinline__ void skinny_rows(Frame& F, const bf16* A, size_t sA, const bf16* Bt, size_t sB, int K, const bf16* G, bf16* MB, const float* res, float* out, bf16* Hn, const float* gn, float* rs) {
    constexpr int NBR = (MODE == 0) ? 4 : 1;
    const int u = F.vcu; if (u >= 256) return;
    const int rt = u & 1, ct = u >> 1, lane = F.lane, li = lane & 15, q = lane >> 4, w = F.wave;
    LAS f32x4* red = (LAS f32x4*)F.lds;
    f32x4 acc[NBR];
    const int nks = K / 32;
#pragma unroll
    for (int b = 0; b < NBR; ++b) {
        acc[b] = (f32x4){0.f, 0.f, 0.f, 0.f};
        const bf16* ap = A + (size_t)b * sA + (size_t)(MP + 16 * rt + li) * K + 8 * q;
        const bf16* bp = Bt + (size_t)b * sB + (size_t)(16 * ct + li) * K + 8 * q;
#pragma unroll 4
        for (int ks = w; ks < nks; ks += 8) {
            const bf16x8 av = *(const bf16x8*)(ap + 32 * ks), bv = *(const bf16x8*)(bp + 32 * ks);
            acc[b] = __builtin_amdgcn_mfma_f32_16x16x32_bf16(bv, av, acc[b], 0, 0, 0);
        }
        red[(w * NBR + b) * 64 + lane] = acc[b];
    }
    LDS_WAIT(); __syncthreads();
    if (w == 0) {
        const int row = MP + 16 * rt + li, col = 16 * ct + 4 * q;
        f32x4 tot = (f32x4){0.f, 0.f, 0.f, 0.f};
#pragma unroll
        for (int b = 0; b < NBR; ++b) {
            f32x4 v = red[b * 64 + lane];
#pragma unroll
            for (int j = 1; j < 8; ++j) v += red[(j * NBR + b) * 64 + lane];
            if (MODE == 0) { const u32x2 gw = *(const u32x2*)(G + (size_t)row * NGATE + (size_t)b * D + col);
                const f32x4 gf = (f32x4){__builtin_bit_cast(float, gw.x << 16), __builtin_bit_cast(float, gw.x & 0xffff0000u), __builtin_bit_cast(float, gw.y << 16), __builtin_bit_cast(float, gw.y & 0xffff0000u)};
                tot += v * gf; }
            else tot += v;
        }
        if (MODE == 0) *(u32x2*)(MB + (size_t)row * D + col) = (u32x2){pk2(tot[0], tot[1]), pk2(tot[2], tot[3])};
        else { const f32x4 v = *(const f32x4*)(res + (size_t)(row - MP) * D + col) + tot; *(f32x4*)(out + (size_t)(row - MP) * D + col) = v;
            if (Hn) { const f32x4 h = v * *(const f32x4*)(gn + col); *(u32x2*)(Hn + (size_t)row * D + col) = (u32x2){pk2(h[0], h[1]), pk2(h[2], h[3])};
                float ss = (v[0] * v[0] + v[1] * v[1]) + (v[2] * v[2] + v[3] * v[3]); ss += __shfl_xor(ss, 16); ss += __shfl_xor(ss, 32);
                if (q == 0) (void)__hip_atomic_fetch_add(rs + row, ss, __ATOMIC_RELAXED, __HIP_MEMORY_SCOPE_AGENT); } }
    }
    __syncthreads();
}

constexpr int NPH = 1 + NL * 11;
__global__ void __launch_bounds__(512, 2) mk_fwd(Args args) {
    extern __shared__ __attribute__((aligned(16))) unsigned char lds_raw[];
    Frame F; F.lds = (LAS unsigned char*)lds_raw; F.tid = threadIdx.x; F.lane = F.tid & 63; F.wave = __builtin_amdgcn_readfirstlane(F.tid >> 6);
    F.G = gridDim.x; { const int bx = blockIdx.x; F.vcu = (F.G % 8 == 0) ? (bx % 8) * (F.G / 8) + bx / 8 : bx; }
    unsigned char* ws = (unsigned char*)args.ws;
    volatile LAS unsigned* MISC = (volatile LAS unsigned*)(F.lds + LDS_CTL_OFF);
    for (int u = F.tid; u < (LDS_BYTES - LDS_CTL_OFF) / 4; u += 512) ((LAS unsigned*)(F.lds + LDS_CTL_OFF))[u] = 0u;
    __syncthreads();
    const bool single = (args.ph_hi - args.ph_lo) > 1;
    XcdBarrier bar; bar.bar = (unsigned*)(ws + WS_CTL) + CW_BAR; bar.x = 0; bar.st = nullptr;
    if (single) bar = xcd_barrier_post((unsigned*)(ws + WS_CTL) + CW_BAR, MISC + 8);
    const int lo = args.ph_lo, hi = args.ph_hi; const int sel = args.li ? args.li : 0xff;
#ifndef PH_MASK
#define PH_MASK 0xFFFu
#endif
#define IN(k) (lo <= (k) && (k) < hi)
#define EN(x) (((PH_MASK) >> (x)) & 1u)
#define SEAM(k) do { if (IN(k) && IN((k) + 1)) xcd_barrier(bar); } while (0)

#define PH_PTRS GAS1 unsigned char* wsg_ = args.ws; int lp = l; asm volatile("" : "+s"(wsg_), "+s"(lp)); unsigned char* wsp = (unsigned char*)wsg_; Frame Fp = F; asm volatile("" : "+v"(Fp.tid), "+v"(Fp.lane), "+s"(Fp.wave), "+s"(Fp.vcu)); \
    bf16* H = (bf16*)(wsp + WS_H); bf16* P = (bf16*)(wsp + WS_P); bf16* G = (bf16*)(wsp + WS_G); bf16* ACT = (bf16*)(wsp + WS_ACT); float* MF = (float*)(wsp + WS_MF); bf16* MB = (bf16*)(wsp + WS_MB); \
    float* X1 = (float*)(wsp + WS_X1); bf16* HID = (bf16*)(wsp + WS_HID); float* XL = (float*)(wsp + WS_XL); bf16* QB = (bf16*)(wsp + WS_QB); bf16* KB = (bf16*)(wsp + WS_KB); bf16* VT = (bf16*)(wsp + WS_VT); float* QS = (float*)(wsp + WS_QS); \
    (void)H; (void)P; (void)G; (void)ACT; (void)MF; (void)MB; (void)X1; (void)HID; (void)XL; (void)QB; (void)KB; (void)VT; (void)QS;

    if (IN(0) && EN(11)) { const int l = 0; PH_PTRS; p0_convert(Fp, args); norm_phase(Fp, (const float*)args.in[0], (const float*)args.in[1], (const float*)args.in[8], H); }
    SEAM(0);
    for (int l = 0; l < NL; ++l) {
        const int pb = 1 + l * 11;
        if (IN(pb + 0) && EN(0)) { PH_PTRS;
            pg8::Gemm g{H, (const bf16*)(wsp + WS_WIN + lp * SZ_WIN), MPAD, INW, D, 0, 0}; pg8::StaticOrder S; S.init(MPAD, INW, F.G, (int)blockIdx.x);
            pg8::EpiIn E{P, G, lp > 0 ? (const float*)((unsigned*)(wsp + WS_CTL) + CW_RS + ((lp - 1) * 2 + 1) * MPAD) : nullptr};
            pg8::gemm_phase<pg8::EpiIn, pg8::StaticOrder, true>(Fp.tid, Fp.lds, g, S, E);
        }
        SEAM(pb + 0);
        if (IN(pb + 1) && EN(1)) {
            constexpr int N_C = 257, N_A = 257, N_D = 264, N_B = 257;
            unsigned* qctr = (unsigned*)(ws + WS_CTL) + CW_Q + 64 * (l * 16 + 0);
            volatile LAS int* qslot = (volatile LAS int*)(F.lds + LDS_CTL_OFF + 64);
            int it = F.vcu;
            while (it < N_C + N_A + N_D + N_B) {
                int nx = 0; if (F.tid == 0) nx = 256 + (int)__hip_atomic_fetch_add(qctr, 1u, __ATOMIC_RELAXED, __HIP_MEMORY_SCOPE_AGENT);
                int r = it; PH_PTRS;
                if (r < N_C) { if (sel & 1) cprep_item(Fp, args, lp, r, P, wsp); }
                else if ((r -= N_C) < N_A) { if (sel & 4) { if (r < 256) gmlp_item(Fp, args, lp, r >> 2, r & 3, P, ACT); else gmlp_sample_item(Fp, args, lp, P, ACT); } }
                else if ((r -= N_A) < N_D) { if (sel & 2) dconv_item(Fp, args, lp, r, P, ACT + (size_t)3 * MPAD * BW); }
                else { r -= N_D; if (sel & 8) bprep_item(Fp, args, lp, r, P, QB, KB, VT, QS); }
                if (F.tid == 0) *qslot = nx;
                __syncthreads(); it = __builtin_amdgcn_readfirstlane(*qslot); __syncthreads();
            }
        }
        SEAM(pb + 1);
        if (IN(pb + 2) && EN(2)) {
            for (int it = F.vcu; it < 256; it += F.G) {
                PH_PTRS;
                if (sel & 1) scan_item(Fp, lp, it, wsp);
            }
        }
        SEAM(pb + 2);
        if (IN(pb + 3) && EN(3)) {
            const int u = F.vcu;
            if (u < 256) {
                { PH_PTRS; const int bh = u >> 5, qt = u & 31; if (qt < 2 && (sel & 1)) carry_item(Fp, args, lp, bh * 2 + qt, wsp); }
                if ((u & 31) == 2 && (sel & 1)) { PH_PTRS; scan_sample_item(Fp, args, lp, u >> 5, wsp); }
                {
                    unsigned* actr = (unsigned*)(ws + WS_CTL) + CW_Q + 64 * (l * 16 + 2 + (u >> 5));
                    volatile LAS int* qslot = (volatile LAS int*)(F.lds + LDS_CTL_OFF + 64);
                    for (;;) {
                        if (F.tid == 0) *qslot = (int)__hip_atomic_fetch_add(actr, 1u, __ATOMIC_RELAXED, __HIP_MEMORY_SCOPE_AGENT);
                        __syncthreads(); const int qi = __builtin_amdgcn_readfirstlane(*qslot); __syncthreads();
                        if (qi >= 112) break;
                        const int blk = qi / 7, pos = qi % 7;
                        PH_PTRS; const int bh = u >> 5;
                        if (pos == 0 || pos == 3 || pos == 5) {
                            if (!(sel & 2)) continue;
                            const int pi = 3 * blk + (pos == 0 ? 0 : pos == 3 ? 1 : 2);
                            const float b2 = ((const float*)args.in[17])[lp * 4 + (bh & 3)] * LOG2E;
                            bf16* AO = ACT + (size_t)1 * MPAD * BW;
                            int qt, kb_lo, nkb; f32x4* part = nullptr; float* tp = nullptr;
                            if (pi < 8) { qt = 15 - pi; kb_lo = 0; nkb = 2 * qt + 2; }
                            else if (pi >= 40) { qt = 47 - pi; kb_lo = 0; nkb = 2 * qt + 2; }
                            else { qt = 31 - ((pi - 8) >> 1); const int right = (pi - 8) & 1, q16 = qt - 16; kb_lo = right ? qt + 1 : 0; nkb = qt + 1;
                                part = (f32x4*)(wsp + WS_OPART) + ((size_t)((bh * 16 + q16) * 2 + right)) * 4096;
                                if (right) tp = (float*)(wsp + WS_TPART) + (size_t)(bh * 16 + q16) * 512; }
                            attn_unit(Fp, bh >> 2, bh & 3, qt, kb_lo, nkb, QB, KB, VT, AO, b2, part, tp);
                        } else {
                            if (!(sel & 4)) continue;
                            const int di = 4 * blk + (pos == 1 ? 0 : pos == 2 ? 1 : pos == 4 ? 2 : 3);
                            decode_item(Fp, args, lp, bh * 64 + di, wsp);
                        }
                    }
                }
            }
        }
        SEAM(pb + 3);
        if (IN(pb + 4) && EN(4)) {
            for (int it = F.vcu; it < 256 + 8; it += F.G) {
                PH_PTRS;
                if (it < 256) { fixup_item(Fp, args, lp, it, wsp, ACT + (size_t)2 * MPAD * BW); __syncthreads(); }
                else if (it < 260) cpost_sample_item(Fp, args, lp, it - 256, wsp, ACT + (size_t)2 * MPAD * BW);
                else decode_combine_item(Fp, args, lp, it - 260, wsp, ACT + (size_t)1 * MPAD * BW);
            }
            { const int ci = 255 - F.vcu; if (ci < 128) { PH_PTRS; attn_combine_item(Fp, ci, wsp, ACT + (size_t)1 * MPAD * BW); } }
        }
        SEAM(pb + 4);
        if (IN(pb + 5) && EN(5)) { PH_PTRS;
            pg8::Gemm g{ACT, (const bf16*)(wsp + WS_WBO + lp * SZ_WBO), MP, D, BW, (size_t)MPAD * BW, (size_t)D * BW}; pg8::MergeOrder S; S.so.initn(MP / 256, D / 128, F.G, (int)blockIdx.x);
            pg8::EpiMerge E{G, MB};
            pg8::gemm_phase<pg8::EpiMerge, pg8::MergeOrder, true, 1>(Fp.tid, Fp.lds, g, S, E);
            skinny_rows<0>(Fp, ACT, (size_t)MPAD * BW, (const bf16*)(wsp + WS_WBO + lp * SZ_WBO), (size_t)D * BW, BW, G, MB, nullptr, nullptr, nullptr, nullptr, nullptr);
        }
        SEAM(pb + 5);
        if (IN(pb + 6) && EN(6)) { PH_PTRS;
            const float* xin0 = lp == 0 ? (const float*)args.in[0] : XL; const float* xin1 = lp == 0 ? (const float*)args.in[1] : XL + (size_t)MP * D;
            pg8::Gemm g{MB, (const bf16*)(wsp + WS_WMIX + lp * SZ_WMIX), MP, D, D, 0, 0}; pg8::StaticOrder S; S.init(MP, D, F.G, (int)blockIdx.x);
            float* rsp = (float*)((unsigned*)(wsp + WS_CTL) + CW_RS + (lp * 2 + 0) * MPAD); const float* gnp = (const float*)args.in[37] + lp * D;
            pg8::EpiRes E{xin0, X1, H, gnp, rsp};
            pg8::gemm_phase<pg8::EpiRes, pg8::StaticOrder, true>(Fp.tid, Fp.lds, g, S, E);
            skinny_rows<1>(Fp, MB, 0, (const bf16*)(wsp + WS_WMIX + lp * SZ_WMIX), 0, D, nullptr, nullptr, xin1, X1 + (size_t)MP * D, H, gnp, rsp);
        }
        SEAM(pb + 6);
        if (IN(pb + 8) && EN(8)) { PH_PTRS;
            pg8::Gemm g{H, (const bf16*)(wsp + WS_WGU + lp * SZ_WGU), MPAD, 2 * FF, D, 0, 0}; pg8::StaticOrder S; S.init(MPAD, 2 * FF, F.G, (int)blockIdx.x);
            pg8::EpiGU E{HID, (const float*)((unsigned*)(wsp + WS_CTL) + CW_RS + (lp * 2 + 0) * MPAD)};
            pg8::gemm_phase<pg8::EpiGU, pg8::StaticOrder, true>(Fp.tid, Fp.lds, g, S, E);
        }
        SEAM(pb + 8);
        if (IN(pb + 9) && EN(9)) { PH_PTRS;
            float* yout = lp == NL - 1 ? ((float*)args.out) + O_Y : XL;
            pg8::Gemm g{HID, (const bf16*)(wsp + WS_WDN + lp * SZ_WDN), MP, D, FF, 0, 0}; pg8::StaticOrder S; S.init(MP, D, F.G, (int)blockIdx.x);
            const bool nxt = lp + 1 < NL; float* rsp = (float*)((unsigned*)(wsp + WS_CTL) + CW_RS + (lp * 2 + 1) * MPAD); const float* gnp = (const float*)args.in[8] + (nxt ? lp + 1 : 0) * D;
            pg8::EpiRes E{X1, yout, nxt ? H : nullptr, gnp, rsp};
            pg8::gemm_phase<pg8::EpiRes, pg8::StaticOrder, true>(Fp.tid, Fp.lds, g, S, E);
            skinny_rows<1>(Fp, HID, 0, (const bf16*)(wsp + WS_WDN + lp * SZ_WDN), 0, FF, nullptr, nullptr, X1 + (size_t)MP * D, yout + (size_t)MP * D, nxt ? H : nullptr, gnp, rsp);
        }
        if (l + 1 < NL) SEAM(pb + 9);
    }
#undef IN
#undef SEAM
}

#ifndef MK_PER_PHASE
#define MK_PER_PHASE 0
#endif
extern "C" void kernel_launch(void* const* d_in, const int* in_sizes, int n_in, void* d_out, int out_size, void* d_ws, size_t ws_size, hipStream_t stream) {
    static int grid = 0;
    if (grid == 0) {
        if (n_in != 41 || (size_t)out_size != O_END || ws_size < WS_END) { fprintf(stderr, "kernel_launch: unexpected shapes: n_in %d out %d ws %zu (need %zu)\n", n_in, out_size, ws_size, (size_t)WS_END); grid = -1; return; }
        int dev = 0, cus = 0, per_cu = 0;
        if (hipGetDevice(&dev) != hipSuccess || hipDeviceGetAttribute(&cus, hipDeviceAttributeMultiprocessorCount, dev) != hipSuccess) { grid = -1; return; }
        if (hipFuncSetAttribute((const void*)mk_fwd, hipFuncAttributeMaxDynamicSharedMemorySize, LDS_BYTES) != hipSuccess) { fprintf(stderr, "kernel_launch: hipFuncSetAttribute failed\n"); grid = -1; return; }
        if (hipOccupancyMaxActiveBlocksPerMultiprocessor(&per_cu, (const void*)mk_fwd, 512, LDS_BYTES) != hipSuccess || per_cu < 1) fprintf(stderr, "kernel_launch: occupancy query reports %d\n", per_cu);
        (void)hipGetLastError();
        grid = cus;
        if (grid != 256) fprintf(stderr, "kernel_launch: %d CUs (built for 256)\n", grid);
    }
    if (grid < 0) return;
    (void)hipMemsetAsync((char*)d_ws + WS_CTL, 0, CTL_BYTES, stream);
    Args a{};
    for (int i = 0; i < 41; ++i) a.in[i] = (const GAS1 void*)d_in[i];
    a.out = (GAS1 float*)d_out; a.ws = (GAS1 unsigned char*)d_ws; a.li = 0; a.pad = 0;
#ifndef MAX_PH
#define MAX_PH NPH
#endif
#if MK_PER_PHASE
    for (int p = 0; p < MAX_PH; ++p) { a.ph_lo = p; a.ph_hi = p + 1; hipLaunchKernelGGL(mk_fwd, dim3(grid), dim3(512), LDS_BYTES, stream, a); }
#else
    a.ph_lo = 0; a.ph_hi = MAX_PH;
    hipLaunchKernelGGL(mk_fwd, dim3(grid), dim3(512), LDS_BYTES, stream, a);
#endif
#ifdef PROBE_PH
    for (int r = 0; r < PROBE_N; ++r) { a.ph_lo = (PROBE_PH < 0) ? 0 : 1 + (NL - 1) * 11 + PROBE_PH; a.ph_hi = a.ph_lo + 1; a.li = PROBE_SEL; hipLaunchKernelGGL(mk_fwd, dim3(grid), dim3(512), LDS_BYTES, stream, a); }
#endif
    const hipError_t le = hipPeekAtLastError();
    if (le != hipSuccess) fprintf(stderr, "kernel_launch: launch failed: %s\n", hipGetErrorName(le));
}
```

```cpp
#include <hip/hip_runtime.h>
#include <cstdio>
#include <cstdint>

#define LAS __attribute__((address_space(3)))
typedef unsigned short bf16;
typedef short bf16x8 __attribute__((ext_vector_type(8)));
typedef float f32x4 __attribute__((ext_vector_type(4)));
typedef float f32x16 __attribute__((ext_vector_type(16)));
typedef float f32x2 __attribute__((ext_vector_type(2)));
typedef unsigned u32x4 __attribute__((ext_vector_type(4)));
typedef unsigned u32x2 __attribute__((ext_vector_type(2)));
typedef const __attribute__((address_space(4))) float cfloat;

constexpr int D = 2048, SEQ = 4096, NL = 2, NSB = 8, NST = 4, NPAGES = 128, NPHYS = 1280;
constexpr int BW = 512, FF = 5632, INW = 13568, NPRE = 5376, NGATE = 8192, CSHIFT = 1792;
constexpr int MP = 8192, MS = 32, MR = 8224, MPAD = 8448;
constexpr int PA0 = 0, PB0 = 1024, PC0 = 2560, PD0 = 4352;
constexpr float LOG2E = 1.4426950408889634f;

constexpr size_t O_Y = 0, O_KP = 16842752, O_VP = 25231360, O_KS = 33619968, O_VS = 33652736, O_WP = 33685504, O_WS = 33816576,
                 O_SHP = 34340864, O_SHS = 34348032, O_CP = 34376704, O_CS = 34438144, O_GV = 34683904, O_END = 34716672;

constexpr size_t al(size_t x) { return (x + 1048575) & ~(size_t)1048575; }
constexpr size_t WS_CTL = 0, CTL_BYTES = 1048576;
constexpr size_t SZ_WIN = (size_t)INW * D * 2, SZ_WBO = (size_t)4 * D * BW * 2, SZ_WMIX = (size_t)D * D * 2, SZ_WGU = (size_t)2 * FF * D * 2, SZ_WDN = (size_t)D * FF * 2, SZ_LW = (size_t)512 * 256 * 2;
constexpr size_t WS_WIN = al(WS_CTL + CTL_BYTES);
constexpr size_t WS_WBO = al(WS_WIN + NL * SZ_WIN);
constexpr size_t WS_WMIX = al(WS_WBO + NL * SZ_WBO);
constexpr size_t WS_WGU = al(WS_WMIX + NL * SZ_WMIX);
constexpr size_t WS_WDN = al(WS_WGU + NL * SZ_WGU);
constexpr size_t WS_LW = al(WS_WDN + NL * SZ_WDN);
constexpr size_t WS_H = al(WS_LW + NL * SZ_LW);
constexpr size_t WS_P = al(WS_H + (size_t)MPAD * D * 2);
constexpr size_t WS_G = al(WS_P + (size_t)MPAD * NPRE * 2);
constexpr size_t WS_ACT = al(WS_G + (size_t)MPAD * NGATE * 2);
constexpr size_t WS_MF = al(WS_ACT + (size_t)4 * MPAD * BW * 2);
constexpr size_t WS_MB = al(WS_MF + 1048576);
constexpr size_t WS_X1 = al(WS_MB + (size_t)MPAD * D * 2);
constexpr size_t WS_HID = al(WS_X1 + (size_t)MPAD * D * 4);
constexpr size_t WS_XL = al(WS_HID + (size_t)MPAD * FF * 2);
constexpr size_t WS_QB = al(WS_XL + (size_t)MPAD * D * 4);
constexpr size_t WS_KB = al(WS_QB + (size_t)MP * BW * 2);
constexpr size_t WS_VT = al(WS_KB + (size_t)MP * BW * 2);
constexpr size_t WS_QS = al(WS_VT + (size_t)MP * BW * 2);
constexpr size_t WS_OSEG = al(WS_QS + (size_t)MS * BW * 4);
constexpr size_t WS_TSEG = al(WS_OSEG + (size_t)8 * 64 * 16 * 128 * 4);
constexpr size_t SZ_RW = (size_t)MR * BW * 4;
constexpr size_t WS_R = al(WS_TSEG + 8 * 64 * 16 * 4);
constexpr size_t SZ_RWL = al(SZ_RW);
constexpr size_t WS_W = WS_R + NL * SZ_RWL, WS_KX = WS_W + NL * SZ_RWL, WS_V = WS_KX + NL * SZ_RWL, WS_KK = al(WS_V + SZ_RW), WS_KKA = WS_KK + NL * SZ_RWL, WS_GG = WS_KKA + NL * SZ_RWL;
constexpr size_t WS_OL = al(WS_GG + SZ_RW), WS_PR = al(WS_OL + SZ_RW);
constexpr size_t WS_RK = al(WS_PR + SZ_RW);
constexpr size_t SZ_CH = (size_t)16 * 64 * 4096 * 4;
constexpr size_t WS_PC = al(WS_RK + (size_t)MR * 8 * 4), WS_LC = al(WS_PC + SZ_CH), WS_SS = al(WS_LC + SZ_CH);
constexpr size_t WS_OPART = al(WS_SS + SZ_CH);
constexpr size_t WS_TPART = al(WS_OPART + (size_t)8 * 16 * 2 * 8 * 8 * 64 * 16);
constexpr size_t WS_END = al(WS_TPART + (size_t)8 * 16 * 8 * 64 * 4);

constexpr int CW_BAR = 4096;
constexpr int CW_RS = 16384;
constexpr int CW_Q = 8192;

constexpr int LDS_BYTES = 147456, LDS_CTL_OFF = 143360;

__device__ __forceinline__ unsigned f2bf(float f) { unsigned u = __builtin_bit_cast(unsigned, f); return (u + 0x7fffu + ((u >> 16) & 1u)) >> 16; }
typedef __bf16 bf16x2_t __attribute__((ext_vector_type(2)));
__device__ __forceinline__ unsigned pk2(float lo, float hi) { const f32x2 v = {lo, hi}; const bf16x2_t b = __builtin_convertvector(v, bf16x2_t); return __builtin_bit_cast(unsigned, b); }
__device__ __forceinline__ float wave_sum(float v) {
#pragma unroll
    for (int o = 1; o < 64; o <<= 1) v += __shfl_xor(v, o);
    return v;
}
__device__ __forceinline__ float ex2(float x) { return __builtin_amdgcn_exp2f(x); }
__device__ __forceinline__ float rcpf_(float x) { return __builtin_amdgcn_rcpf(x); }
__device__ __forceinline__ float sigmoidf_(float x) { return rcpf_(1.0f + ex2(-x * LOG2E)); }
__device__ __forceinline__ float gelu_tanh(float x) {
    const float u = 0.7978845608028654f * (x + 0.044715f * x * x * x);
    const float t = 1.0f - 2.0f * rcpf_(1.0f + ex2(2.0f * LOG2E * u));
    return 0.5f * x * (1.0f + t);
}
__device__ __forceinline__ f32x4 ldb4(const bf16* p) { const u32x2 w = *(const u32x2*)p; return (f32x4){__builtin_bit_cast(float, w.x << 16), __builtin_bit_cast(float, w.x & 0xffff0000u), __builtin_bit_cast(float, w.y << 16), __builtin_bit_cast(float, w.y & 0xffff0000u)}; }
#define GAS1 __attribute__((address_space(1)))
#define LDS_WAIT() asm volatile("s_waitcnt lgkmcnt(0)" ::: "memory")
#define VM_WAIT() asm volatile("s_waitcnt vmcnt(0)" ::: "memory")

namespace pg8 {
typedef unsigned short bf16_t;
constexpr int BM = 256, BK = 64, HALF = 128, HTB = HALF * BK * 2, STAGE_BYTES = 8 * HTB, NXCD = 8, WGM = 8;
__host__ __device__ __forceinline__ int lds_byte(int r, int c) { const int st = (r >> 4) * 2 + (c >> 5), rr = r & 15, cc = c & 31, ob = rr * 64 + cc * 2; return st * 1024 + (ob ^ (((ob >> 9) & 1) << 5)); }
__host__ __device__ __forceinline__ void stage_rc(int b, int& R, int& C) { const int st = b / 1024, sb = b % 1024, swz = sb ^ (((sb >> 9) & 1) << 5); R = (st >> 1) * 16 + swz / 64; C = (st & 1) * 32 + (swz % 64) / 2; }
__host__ __device__ __forceinline__ int perm32(int rho) { const int n = rho >> 4, i = rho & 15; return 8 * (i >> 2) + 4 * n + (i & 3); }
struct Unit { int pm, pn, pb; };
struct Gemm { const bf16_t* A; const bf16_t* Bt; int M, N, K; size_t sA, sB; };
struct StaticOrder {
    int nM, nN, nwg, G, c;
    __host__ __device__ void init(int M, int N, int G_, int c_) { nM = M / BM; nN = N / BM; nwg = nM * nN; G = G_; c = c_; }
    __host__ __device__ void initn(int nM_, int nN_, int G_, int c_) { nM = nM_; nN = nN_; nwg = nM * nN; G = G_; c = c_; }
    __host__ __device__ bool next(int i, Unit& u) const {
        const long L = (long)i * G + c; if (L >= nwg) return false;
        int wgid = (int)L; { const int q = nwg / NXCD, r = nwg % NXCD, xcd = wgid % NXCD, off = wgid / NXCD; wgid = (xcd < r ? xcd * (q + 1) : r * (q + 1) + (xcd - r) * q) + off; }
        const int nig = WGM * nN, gid = wgid / nig, fm = gid * WGM, gsz = (nM - fm) < WGM ? (nM - fm) : WGM;
        u.pm = fm + ((wgid % nig) % gsz); u.pn = (wgid % nig) / gsz; u.pb = 0; return true;
    }
};
struct MergeOrder {
    StaticOrder so;
    __host__ __device__ bool next(int i, Unit& u) const { if (!so.next(i >> 2, u)) return false; u.pb = i & 3; return true; }
};
__device__ __forceinline__ unsigned cvt_pk_bf16(float lo, float hi) { return pk2(lo, hi); }

template <class Epi, class Sched, bool ALIGN_EPI, int NB = 2>
__device__ __forceinline__ void gemm_phase(const int tid, LAS unsigned char* lds, const Gemm g, const Sched& S, const Epi& E) {
    const int wid = __builtin_amdgcn_readfirstlane(tid >> 6), lane = tid & 63, wr = wid >> 2, wc = wid & 3, fr = lane & 15, fq = lane >> 4;
    const int K = g.K, nt = K / BK;
    unsigned voffA[2], voffB[2];
#pragma unroll
    for (int i = 0; i < 2; ++i) { int R, C; stage_rc(tid * 16 + i * 8192, R, C); const int Rb = (R & ~31) + perm32(R & 31);
        voffA[i] = (unsigned)(R * K + C) * 2u; voffB[i] = (unsigned)(Rb * K + C) * 2u; }
    const size_t kstep = (size_t)(BK * 2);
    const size_t hstep = (size_t)HALF * K * 2;
    const size_t tstep = 2 * hstep;
    const size_t bstep = (NB == 2) ? tstep : hstep;
    const unsigned ldsw = (unsigned)wid * 1024u;
    const int aoff = lds_byte(wr * 64 + fr, fq * 8), boff = lds_byte(wc * 32 + fr, fq * 8);
#define PG8_SA(b, h) (((b) * 2 + (h)) * HTB)
#define PG8_SB(b, h) ((4 + (b) * 2 + (h)) * HTB)
#define PG8_STAGE(bufoff, gbase, voff) do { _Pragma("unroll") for (int _i = 0; _i < 2; ++_i) \
        __builtin_amdgcn_global_load_lds((const unsigned*)((const char*)(gbase) + (voff)[_i]), (LAS unsigned*)(lds + (bufoff) + ldsw + _i * 8192), 16, 0, 0); } while (0)
#define PG8_LDA(dst, b, h) do { _Pragma("unroll") for (int m = 0; m < 4; ++m) _Pragma("unroll") for (int k = 0; k < 2; ++k) dst[m][k] = *(const LAS bf16x8*)(lds + PG8_SA(b, h) + aoff + m * 2048 + k * 1024); } while (0)
#define PG8_LDB(dst, b, h) do { _Pragma("unroll") for (int n = 0; n < 2; ++n) _Pragma("unroll") for (int k = 0; k < 2; ++k) dst[n][k] = *(const LAS bf16x8*)(lds + PG8_SB(b, h) + boff + n * 2048 + k * 1024); } while (0)
#define PG8_MMA(ai, bj, At, Bt) do { __builtin_amdgcn_s_setprio(1); _Pragma("unroll") for (int m = 0; m < 4; ++m) _Pragma("unroll") for (int n = 0; n < 2; ++n) _Pragma("unroll") for (int k = 0; k < 2; ++k) \
        acc[ai][bj][m][n] = __builtin_amdgcn_mfma_f32_16x16x32_bf16(Bt[n][k], At[m][k], acc[ai][bj][m][n], 0, 0, 0); __builtin_amdgcn_s_setprio(0); } while (0)
#define PG8_WAIT_V(n) asm volatile("s_waitcnt vmcnt(" #n ")" ::: "memory")
#define PG8_WAIT_L(n) asm volatile("s_waitcnt lgkmcnt(" #n ")" ::: "memory")
#define PG8_BAR __builtin_amdgcn_s_barrier()
#define PG8_SCHED __builtin_amdgcn_sched_barrier(0)
    Unit cur, nxt; int ui = 0;
    if (!S.next(0, cur)) return;
    f32x4 acc[2][NB][4][2];
    f32x4 xreg[NB == 1 ? 2 : 1][NB == 1 ? 4 : 1][NB == 1 ? 2 : 1];
#pragma unroll
    for (int a = 0; a < 2; ++a)
#pragma unroll
        for (int b = 0; b < NB; ++b)
#pragma unroll
            for (int m = 0; m < 4; ++m)
#pragma unroll
                for (int n = 0; n < 2; ++n) acc[a][b][m][n] = (f32x4){0.f, 0.f, 0.f, 0.f};
    bf16x8 At[4][2], B0[2][2], B1[NB == 2 ? 2 : 1][2];
    const char* cA = (const char*)(g.A + (size_t)cur.pb * g.sA) + (size_t)cur.pm * tstep; const char* cB = (const char*)(g.Bt + (size_t)cur.pb * g.sB) + (size_t)cur.pn * bstep;
    if constexpr (NB == 2) {
        PG8_STAGE(PG8_SB(0, 0), cB, voffB); PG8_STAGE(PG8_SB(0, 1), cB + hstep, voffB); PG8_STAGE(PG8_SA(0, 0), cA, voffA); PG8_STAGE(PG8_SA(0, 1), cA + hstep, voffA);
        if (wr == 1) PG8_BAR;
        PG8_WAIT_V(2); PG8_BAR;
        PG8_STAGE(PG8_SB(1, 0), cB + kstep, voffB); PG8_STAGE(PG8_SA(1, 0), cA + kstep, voffA); PG8_STAGE(PG8_SB(1, 1), cB + hstep + kstep, voffB);
        PG8_WAIT_V(6); PG8_BAR;
    } else {
        PG8_STAGE(PG8_SB(0, 0), cB, voffB); PG8_STAGE(PG8_SA(0, 0), cA, voffA); PG8_STAGE(PG8_SA(0, 1), cA + hstep, voffA);
        if (wr == 1) PG8_BAR;
        PG8_WAIT_V(2); PG8_BAR;
        PG8_STAGE(PG8_SB(1, 0), cB + kstep, voffB); PG8_STAGE(PG8_SA(1, 0), cA + kstep, voffA);
        PG8_WAIT_V(4); PG8_BAR;
    }
    for (;;) {
        const bool has_next = S.next(ui + 1, nxt);
        const char* nA = has_next ? (const char*)(g.A + (size_t)nxt.pb * g.sA) + (size_t)nxt.pm * tstep : cA; const char* nB = has_next ? (const char*)(g.Bt + (size_t)nxt.pb * g.sB) + (size_t)nxt.pn * bstep : cB;
        for (int t = 0; t < nt; t += 2) {
            const bool last = (t == nt - 2);
            const char* a1 = cA + (size_t)(t + 1) * kstep;
            const char* a2 = last ? nA : cA + (size_t)(t + 2) * kstep; const char* b2 = last ? nB : cB + (size_t)(t + 2) * kstep;
            const char* a3 = a2 + kstep; const char* b3 = b2 + kstep;
            if constexpr (NB == 2) {
            PG8_LDB(B0, 0, 0); PG8_LDB(B1, 0, 1); PG8_SCHED; PG8_LDA(At, 0, 0); PG8_STAGE(PG8_SA(1, 1), a1 + hstep, voffA);
            PG8_WAIT_V(8); PG8_WAIT_L(0); PG8_BAR; PG8_MMA(0, 0, At, B0); PG8_MMA(0, 1, At, B1); PG8_BAR; PG8_SCHED;
            PG8_LDA(At, 0, 1); PG8_STAGE(PG8_SB(0, 0), b2, voffB); PG8_STAGE(PG8_SB(0, 1), b2 + hstep, voffB); PG8_STAGE(PG8_SA(0, 0), a2, voffA);
            PG8_WAIT_V(8); PG8_WAIT_L(0); PG8_BAR; PG8_MMA(1, 0, At, B0); PG8_MMA(1, 1, At, B1); PG8_BAR; PG8_SCHED;
            PG8_LDB(B0, 1, 0); PG8_LDB(B1, 1, 1); PG8_SCHED; PG8_LDA(At, 1, 0); PG8_STAGE(PG8_SA(0, 1), a2 + hstep, voffA);
            PG8_WAIT_V(8); PG8_WAIT_L(0); PG8_BAR; PG8_MMA(0, 0, At, B0); PG8_MMA(0, 1, At, B1); PG8_BAR; PG8_SCHED;
            PG8_LDA(At, 1, 1); PG8_STAGE(PG8_SB(1, 0), b3, voffB); PG8_STAGE(PG8_SB(1, 1), b3 + hstep, voffB); PG8_STAGE(PG8_SA(1, 0), a3, voffA);
            PG8_WAIT_V(8); PG8_WAIT_L(0); PG8_BAR; PG8_MMA(1, 0, At, B0); PG8_MMA(1, 1, At, B1); PG8_BAR; PG8_SCHED;
            } else {
            PG8_LDB(B0, 0, 0); PG8_SCHED; PG8_LDA(At, 0, 0); PG8_STAGE(PG8_SA(1, 1), a1 + hstep, voffA);
            PG8_WAIT_V(6); PG8_WAIT_L(0); PG8_BAR; PG8_MMA(0, 0, At, B0); PG8_BAR; PG8_SCHED;
            PG8_LDA(At, 0, 1); PG8_STAGE(PG8_SB(0, 0), b2, voffB); PG8_STAGE(PG8_SA(0, 0), a2, voffA);
            PG8_WAIT_V(6); PG8_WAIT_L(0); PG8_BAR; PG8_MMA(1, 0, At, B0); PG8_BAR; PG8_SCHED;
            PG8_LDB(B0, 1, 0); PG8_SCHED; PG8_LDA(At, 1, 0); PG8_STAGE(PG8_SA(0, 1), a2 + hstep, voffA);
            PG8_WAIT_V(6); PG8_WAIT_L(0); PG8_BAR; PG8_MMA(0, 0, At, B0); PG8_BAR; PG8_SCHED;
            PG8_LDA(At, 1, 1); PG8_STAGE(PG8_SB(1, 0), b3, voffB); PG8_STAGE(PG8_SA(1, 0), a3, voffA);
            PG8_WAIT_V(6); PG8_WAIT_L(0); PG8_BAR; PG8_MMA(1, 0, At, B0); PG8_BAR; PG8_SCHED;
            }
        }
        if constexpr (ALIGN_EPI) { if (wr == 0) PG8_BAR; }
        if constexpr (NB == 2) E(acc, cur, wr, wc, fr, fq); else E(acc, xreg, cur, wr, wc, fr, fq);
        if (!has_next) break;
#pragma unroll
        for (int a = 0; a < 2; ++a)
#pragma unroll
            for (int b = 0; b < NB; ++b)
#pragma unroll
                for (int m = 0; m < 4; ++m)
#pragma unroll
                    for (int n = 0; n < 2; ++n) acc[a][b][m][n] = (f32x4){0.f, 0.f, 0.f, 0.f};
        cur = nxt; cA = nA; cB = nB; ++ui;
        if constexpr (ALIGN_EPI) { if (wr == 1) PG8_BAR; }
    }
    PG8_WAIT_V(0);
    if constexpr (!ALIGN_EPI) { if (wr == 0) PG8_BAR; }
    PG8_BAR;
#undef PG8_SA
#undef PG8_SB
#undef PG8_STAGE
#undef PG8_LDA
#undef PG8_LDB
#undef PG8_MMA
#undef PG8_WAIT_V
#undef PG8_WAIT_L
#undef PG8_BAR
#undef PG8_SCHED
}

struct EpiIn {
    bf16_t* P; bf16_t* G; const float* rs;
    __device__ __forceinline__ void operator()(const f32x4 (&acc)[2][2][4][2], const Unit& u, int wr, int wc, int fr, int fq) const {
        const int row0 = u.pm * BM + wr * 64 + fr;
        float scv[2][4];
#pragma unroll
        for (int ai = 0; ai < 2; ++ai)
#pragma unroll
            for (int m = 0; m < 4; ++m) scv[ai][m] = rs ? rs[row0 + ai * HALF + m * 16] : 0.f;
#pragma unroll
        for (int ai = 0; ai < 2; ++ai)
#pragma unroll
            for (int m = 0; m < 4; ++m) scv[ai][m] = rs ? 1.0f / sqrtf(scv[ai][m] * (1.0f / D) + 1e-6f) : 1.0f;
        if (u.pn < 21) {
            const int col0 = u.pn * BM + wc * 32 + 8 * fq;
#pragma unroll
            for (int ai = 0; ai < 2; ++ai)
#pragma unroll
                for (int m = 0; m < 4; ++m) { bf16_t* rowp = P + (size_t)(row0 + ai * HALF + m * 16) * NPRE + col0;
                    const float sc = scv[ai][m];
#pragma unroll
                    for (int bj = 0; bj < 2; ++bj) { const f32x4 v0 = acc[ai][bj][m][0] * sc, v1 = acc[ai][bj][m][1] * sc;
                        u32x4 w; w.x = cvt_pk_bf16(v0[0], v0[1]); w.y = cvt_pk_bf16(v0[2], v0[3]); w.z = cvt_pk_bf16(v1[0], v1[1]); w.w = cvt_pk_bf16(v1[2], v1[3]);
                        *(u32x4*)(rowp + bj * HALF) = w; } }
        } else {
            const int col0 = (u.pn - 21) * BM + wc * 32 + 8 * fq;
#pragma unroll
            for (int ai = 0; ai < 2; ++ai)
#pragma unroll
                for (int m = 0; m < 4; ++m) { bf16_t* rowp = G + (size_t)(row0 + ai * HALF + m * 16) * NGATE + col0;
                    const float sc = scv[ai][m];
#pragma unroll
                    for (int bj = 0; bj < 2; ++bj) { const f32x4 v0 = acc[ai][bj][m][0] * sc, v1 = acc[ai][bj][m][1] * sc;
                        u32x4 w; w.x = cvt_pk_bf16(sigmoidf_(v0[0]), sigmoidf_(v0[1])); w.y = cvt_pk_bf16(sigmoidf_(v0[2]), sigmoidf_(v0[3]));
                        w.z = cvt_pk_bf16(sigmoidf_(v1[0]), sigmoidf_(v1[1])); w.w = cvt_pk_bf16(sigmoidf_(v1[2]), sigmoidf_(v1[3]));
                        *(u32x4*)(rowp + bj * HALF) = w; } }
        }
    }
};
__device__ __forceinline__ f32x4 bf4lo(u32x4 g) { return (f32x4){__builtin_bit_cast(float, g.x << 16), __builtin_bit_cast(float, g.x & 0xffff0000u), __builtin_bit_cast(float, g.y << 16), __builtin_bit_cast(float, g.y & 0xffff0000u)}; }
__device__ __forceinline__ f32x4 bf4hi(u32x4 g) { return (f32x4){__builtin_bit_cast(float, g.z << 16), __builtin_bit_cast(float, g.z & 0xffff0000u), __builtin_bit_cast(float, g.w << 16), __builtin_bit_cast(float, g.w & 0xffff0000u)}; }
struct EpiMerge {
    const bf16_t* G; bf16_t* MB;
    __device__ __forceinline__ void operator()(const f32x4 (&acc)[2][1][4][2], f32x4 (&mr)[2][4][2], const Unit& u, int wr, int wc, int fr, int fq) const {
        const int row0 = u.pm * BM + wr * 64 + fr, col0 = u.pn * HALF + wc * 32 + 8 * fq;
        u32x4 gv[2][4];
#pragma unroll
        for (int ai = 0; ai < 2; ++ai)
#pragma unroll
            for (int m = 0; m < 4; ++m) gv[ai][m] = *(const u32x4*)(G + (size_t)(row0 + ai * HALF + m * 16) * NGATE + (size_t)u.pb * D + col0);
#pragma unroll
        for (int ai = 0; ai < 2; ++ai)
#pragma unroll
            for (int m = 0; m < 4; ++m) {
                const f32x4 p0 = acc[ai][0][m][0] * bf4lo(gv[ai][m]), p1 = acc[ai][0][m][1] * bf4hi(gv[ai][m]);
                if (u.pb == 0) { mr[ai][m][0] = p0; mr[ai][m][1] = p1; } else { mr[ai][m][0] += p0; mr[ai][m][1] += p1; }
                if (u.pb == 3) { const f32x4 v0 = mr[ai][m][0], v1 = mr[ai][m][1];
                    u32x4 w; w.x = cvt_pk_bf16(v0[0], v0[1]); w.y = cvt_pk_bf16(v0[2], v0[3]); w.z = cvt_pk_bf16(v1[0], v1[1]); w.w = cvt_pk_bf16(v1[2], v1[3]);
                    *(u32x4*)(MB + (size_t)(row0 + ai * HALF + m * 16) * D + col0) = w; } }
    }
};
struct EpiRes {
    const void* r0; int rb16; float* out; bf16_t* Hn; float* rs;
    __device__ __forceinline__ void operator()(const f32x4 (&acc)[2][2][4][2], const Unit& u, int wr, int wc, int fr, int fq) const {
        const int row0 = u.pm * BM + wr * 64 + fr, col0 = u.pn * BM + wc * 32 + 8 * fq;
#pragma unroll
        for (int aih = 0; aih < 4; ++aih) { const int ai = aih >> 1, m0 = (aih & 1) * 2;
            f32x4 rv[4][2][2];
            if (rb16) {
                u32x4 rw[2][2];
#pragma unroll
                for (int m = m0; m < m0 + 2; ++m)
#pragma unroll
                    for (int bj = 0; bj < 2; ++bj) rw[m - m0][bj] = *(const u32x4*)((const bf16_t*)r0 + (size_t)(row0 + ai * HALF + m * 16) * D + col0 + bj * HALF);
#pragma unroll
                for (int m = m0; m < m0 + 2; ++m)
#pragma unroll
                    for (int bj = 0; bj < 2; ++bj) { const u32x4 x = rw[m - m0][bj];
                        rv[m][bj][0] = (f32x4){__builtin_bit_cast(float, x.x << 16), __builtin_bit_cast(float, x.x & 0xffff0000u), __builtin_bit_cast(float, x.y << 16), __builtin_bit_cast(float, x.y & 0xffff0000u)};
                        rv[m][bj][1] = (f32x4){__builtin_bit_cast(float, x.z << 16), __builtin_bit_cast(float, x.z & 0xffff0000u), __builtin_bit_cast(float, x.w << 16), __builtin_bit_cast(float, x.w & 0xffff0000u)}; }
            } else {
#pragma unroll
                for (int m = m0; m < m0 + 2; ++m) { const float* rp = (const float*)r0 + (size_t)(row0 + ai * HALF + m * 16) * D + col0;
#pragma unroll
                    for (int bj = 0; bj < 2; ++bj) { rv[m][bj][0] = *(const f32x4*)(rp + bj * HALF); rv[m][bj][1] = *(const f32x4*)(rp + bj * HALF + 4); } }
            }
#pragma unroll
            for (int m = m0; m < m0 + 2; ++m) { const int row = row0 + ai * HALF + m * 16;
                float ss = 0.f;
#pragma unroll
                for (int bj = 0; bj < 2; ++bj) { const f32x4 v0 = acc[ai][bj][m][0] + rv[m][bj][0], v1 = acc[ai][bj][m][1] + rv[m][bj][1];
                    if (out) { float* op = out + (size_t)row * D + col0 + bj * HALF; *(f32x4*)op = v0; *(f32x4*)(op + 4) = v1; }
                    if (Hn) { ss += (v0[0] * v0[0] + v0[1] * v0[1]) + (v0[2] * v0[2] + v0[3] * v0[3]) + (v1[0] * v1[0] + v1[1] * v1[1]) + (v1[2] * v1[2] + v1[3] * v1[3]);
                        u32x4 w; w.x = cvt_pk_bf16(v0[0], v0[1]); w.y = cvt_pk_bf16(v0[2], v0[3]); w.z = cvt_pk_bf16(v1[0], v1[1]); w.w = cvt_pk_bf16(v1[2], v1[3]);
                        *(u32x4*)(Hn + (size_t)row * D + col0 + bj * HALF) = w; } }
                if (Hn) { ss += __shfl_xor(ss, 16); ss += __shfl_xor(ss, 32); if (fq == 0) (void)__hip_atomic_fetch_add(rs + row, ss, __ATOMIC_RELAXED, __HIP_MEMORY_SCOPE_AGENT); }
            }
        }
    }
};
struct EpiGU {
    bf16_t* HID; const float* rs;
    __device__ __forceinline__ void operator()(const f32x4 (&acc)[2][2][4][2], const Unit& u, int wr, int wc, int fr, int fq) const {
        const int row0 = u.pm * BM + wr * 64 + fr, col0 = u.pn * HALF + wc * 32 + 8 * fq;
        float scv[2][4];
#pragma unroll
        for (int ai = 0; ai < 2; ++ai)
#pragma unroll
            for (int m = 0; m < 4; ++m) scv[ai][m] = rs[row0 + ai * HALF + m * 16];
#pragma unroll
        for (int ai = 0; ai < 2; ++ai)
#pragma unroll
            for (int m = 0; m < 4; ++m) { const size_t row = (size_t)(row0 + ai * HALF + m * 16);
                const float sc = 1.0f / sqrtf(scv[ai][m] * (1.0f / D) + 1e-6f);
                const f32x4 g0 = acc[ai][0][m][0] * sc, g1 = acc[ai][0][m][1] * sc, u0 = acc[ai][1][m][0] * sc, u1 = acc[ai][1][m][1] * sc;
                float o[8];
#pragma unroll
                for (int j = 0; j < 4; ++j) { o[j] = g0[j] * sigmoidf_(g0[j]) * u0[j]; o[4 + j] = g1[j] * sigmoidf_(g1[j]) * u1[j]; }
                u32x4 w; w.x = cvt_pk_bf16(o[0], o[1]); w.y = cvt_pk_bf16(o[2], o[3]); w.z = cvt_pk_bf16(o[4], o[5]); w.w = cvt_pk_bf16(o[6], o[7]);
                *(u32x4*)(HID + row * FF + col0) = w; }
    }
};
}

#define XB_TMO      128
#define XB_XCNT(j)  (256  + 64 * (j))
#define XB_XSUB(j)  (1280 + 64 * (j))
#define XB_XGEN(j)  (2304 + 64 * (j))
#define XB_TOP      3328
#define XB_TOPGEN   3392
#define XCD_BAR_WORDS 3456
#define XB_SPIN_CAP (1u << 18)
__device__ __forceinline__ unsigned xb_ld(unsigned* p)              { return __hip_atomic_load(p, __ATOMIC_RELAXED, __HIP_MEMORY_SCOPE_AGENT); }
__device__ __forceinline__ unsigned xb_add(unsigned* p, unsigned v) { return __hip_atomic_fetch_add(p, v, __ATOMIC_RELAXED, __HIP_MEMORY_SCOPE_AGENT); }
__device__ __forceinline__ unsigned xb_xcc_id() { return (unsigned)__builtin_amdgcn_s_getreg((3 << 11) | 20) & 0xFu; }
#define XB_SPIN(cond, bar) do { unsigned _sp = 0; while (cond) { __builtin_amdgcn_s_sleep(1); \
    if ((++_sp & 255u) == 0u) { if (xb_ld(&(bar)[XB_TMO])) break; if (_sp > XB_SPIN_CAP) { atomicAdd(&(bar)[XB_TMO], 1u); break; } } } } while (0)
struct XcdBarrier { unsigned* bar; unsigned x; volatile LAS unsigned* st; };
__device__ __forceinline__ XcdBarrier xcd_barrier_post(unsigned* bar, volatile LAS unsigned* st) {
    XcdBarrier b; b.bar = bar; b.x = xb_xcc_id(); b.st = st;
    if (threadIdx.x == 0) (void)xb_add(&bar[XB_XCNT(b.x)], 1u);
    return b;
}
__device__ __forceinline__ void xcd_barrier_complete(unsigned* bar, unsigned x, unsigned& nloc, unsigned& nx) {
    const unsigned G = gridDim.x * gridDim.y * gridDim.z;
    unsigned sum, cnt, mine, sp = 0u;
    for (;;) {
        sum = 0u; cnt = 0u; mine = 0u;
#pragma unroll
        for (unsigned j = 0; j < 16; ++j) { const unsigned c = xb_ld(&bar[XB_XCNT(j)]); sum += c; cnt += (c > 0u) ? 1u : 0u; mine = (j == x) ? c : mine; }
        if (sum == G) break;
        __builtin_amdgcn_s_sleep(1);
        if ((++sp & 255u) == 0u) { if (xb_ld(&bar[XB_TMO])) break; if (sp > XB_SPIN_CAP) { atomicAdd(&bar[XB_TMO], 1u); break; } }
    }
    nloc = mine > 0u ? mine : 1u; nx = cnt > 0u ? cnt : 1u;
}
__device__ __forceinline__ void xcd_barrier(const XcdBarrier& b) {
    asm volatile("s_waitcnt vmcnt(0)" ::: "memory");
    __syncthreads();
    if (threadIdx.x == 0) {
        unsigned* bar = b.bar;
        __builtin_amdgcn_s_waitcnt(0);
        unsigned nloc = b.st[0], nx = b.st[1];
        if (nloc == 0u) { xcd_barrier_complete(bar, b.x, nloc, nx); b.st[0] = nloc; b.st[1] = nx; }
        const unsigned old = xb_add(&bar[XB_XSUB(b.x)], 1u);
        const unsigned gen = old / nloc;
        if (old + 1u == (gen + 1u) * nloc) {
            __builtin_amdgcn_fence(__ATOMIC_RELEASE, "agent");
            asm volatile("s_waitcnt vmcnt(0)" ::: "memory");
            const unsigned og = xb_add(&bar[XB_TOP], 1u);
            const unsigned tg = og / nx;
            if (og + 1u == (tg + 1u) * nx) xb_add(&bar[XB_TOPGEN], 1u);
            else XB_SPIN(xb_ld(&bar[XB_TOPGEN]) == tg, bar);
            __builtin_amdgcn_fence(__ATOMIC_ACQUIRE, "agent");
            xb_add(&bar[XB_XGEN(b.x)], 1u);
            asm volatile("s_waitcnt vmcnt(0)" ::: "memory");
        } else {
            XB_SPIN(xb_ld(&bar[XB_XGEN(b.x)]) == gen, bar);
            __builtin_amdgcn_fence(__ATOMIC_ACQUIRE, "agent");
            asm volatile("s_waitcnt vmcnt(0)" ::: "memory");
        }
    }
    __syncthreads();
}

struct Args { const GAS1 void* in[41]; GAS1 float* out; GAS1 unsigned char* ws; int ph_lo, ph_hi, li, pad; };
struct Frame {
    LAS unsigned char* lds;
    int tid, lane, wave, vcu, G;
};
constexpr int NW = 8;

__device__ __forceinline__ void cvt_item(const float* W, int N, bf16* WT, int Kd, int k0, int n0, int drow0, int kd0, LAS float* scr, int lane, const float* gk = nullptr) {
    const int lr = lane >> 4, lc = (lane & 15) * 4;
    f32x4 v[16];
#pragma unroll
    for (int i = 0; i < 16; ++i) v[i] = __builtin_nontemporal_load((const f32x4*)(W + (size_t)(k0 + 4 * i + lr) * N + n0 + lc));
    if (gk) {
#pragma unroll
        for (int i = 0; i < 16; ++i) v[i] *= gk[k0 + 4 * i + lr]; }
#pragma unroll
    for (int i = 0; i < 16; ++i) { LAS float* s = scr + (4 * i + lr) * 65 + lc; s[0] = v[i][0]; s[1] = v[i][1]; s[2] = v[i][2]; s[3] = v[i][3]; }
    LDS_WAIT(); asm volatile("" ::: "memory");
    const int c = lane & 7;
#pragma unroll
    for (int j = 0; j < 8; ++j) { const int n = (lane >> 3) + 8 * j; const LAS float* s = scr + (8 * c) * 65 + n;
        u32x4 o; o.x = pk2(s[0 * 65], s[1 * 65]); o.y = pk2(s[2 * 65], s[3 * 65]); o.z = pk2(s[4 * 65], s[5 * 65]); o.w = pk2(s[6 * 65], s[7 * 65]);
        *(u32x4*)(WT + (size_t)(drow0 + n) * Kd + kd0 + 8 * c) = o; }
    LDS_WAIT(); asm volatile("" ::: "memory");
}
__device__ __forceinline__ void p0_convert(Frame& F, const Args& a) {
    LAS float* scr = (LAS float*)(F.lds + F.wave * 16640);
    const int gw = F.vcu * NW + F.wave, NGW = F.G * NW;
    constexpr int I_IN = 32 * 212, I_BO = 8 * 32, I_MIX = 32 * 32, I_G = 32 * 88, I_DN = 88 * 32, I_LW = 8, I_LG = 16;
    constexpr int PER_L = I_IN + 4 * I_BO + I_MIX + 2 * I_G + I_DN + 2 * I_LW + I_LG;
    for (int it = gw; it < NL * PER_L; it += NGW) {
        const int l = it / PER_L; int r = it % PER_L;
        unsigned char* ws = ((unsigned char*)a.ws);
        if (r < I_IN) { const int kb = r / 212, nb = r % 212; cvt_item((const float*)a.in[9] + (size_t)l * D * INW, INW, (bf16*)(ws + WS_WIN + l * SZ_WIN), D, kb * 64, nb * 64, nb * 64, kb * 64, scr, F.lane, (const float*)a.in[8] + l * D); continue; } r -= I_IN;
        if (r < 4 * I_BO) { const int b = r / I_BO, q = r % I_BO, kb = q / 32, nb = q % 32; const int idx = (b == 0) ? 14 : (b == 1) ? 18 : (b == 2) ? 30 : 35;
            cvt_item((const float*)a.in[idx] + (size_t)l * BW * D, D, (bf16*)(ws + WS_WBO + l * SZ_WBO) + (size_t)b * D * BW, BW, kb * 64, nb * 64, nb * 64, kb * 64, scr, F.lane); continue; } r -= 4 * I_BO;
        if (r < I_MIX) { const int kb = r / 32, nb = r % 32; cvt_item((const float*)a.in[36] + (size_t)l * D * D, D, (bf16*)(ws + WS_WMIX + l * SZ_WMIX), D, kb * 64, nb * 64, nb * 64, kb * 64, scr, F.lane); continue; } r -= I_MIX;
        if (r < 2 * I_G) { const int up = r / I_G, q = r % I_G, kb = q / 88, nb = q % 88, n0 = nb * 64;
            cvt_item((const float*)a.in[up ? 39 : 38] + (size_t)l * D * FF, FF, (bf16*)(ws + WS_WGU + l * SZ_WGU), D, kb * 64, n0, (n0 / 128) * 256 + up * 128 + (n0 % 128), kb * 64, scr, F.lane, (const float*)a.in[37] + l * D); continue; } r -= 2 * I_G;
        if (r < I_DN) { const int kb = r / 32, nb = r % 32; cvt_item((const float*)a.in[40] + (size_t)l * FF * D, D, (bf16*)(ws + WS_WDN + l * SZ_WDN), FF, kb * 64, nb * 64, nb * 64, kb * 64, scr, F.lane); continue; } r -= I_DN;
        bf16* lw = (bf16*)(ws + WS_LW + l * SZ_LW);
        if (r < I_LW) { cvt_item((const float*)a.in[21] + (size_t)l * 64 * 512, 512, lw, 256, 0, r * 64, r * 64, 0, scr, F.lane); continue; } r -= I_LW;
        if (r < I_LW) { cvt_item((const float*)a.in[23] + (size_t)l * 64 * 512, 512, lw, 256, 0, r * 64, r * 64, 64, scr, F.lane); continue; } r -= I_LW;
        { const int kb = r / 8, nb = r % 8; cvt_item((const float*)a.in[24] + (size_t)l * 128 * 512, 512, lw, 256, kb * 64, nb * 64, nb * 64, 128 + kb * 64, scr, F.lane); }
    }
}

__device__ __forceinline__ void norm_phase(Frame& F, const float* s0, const float* s1, bf16* H) {
    const int gw = F.vcu * NW + F.wave, NGW = F.G * NW;
    for (int m = gw; m < MPAD; m += NGW) {
        u32x2* o = (u32x2*)(H + (size_t)m * D) + F.lane;
        if (m >= MR) {
#pragma unroll
            for (int j = 0; j < 8; ++j) o[64 * j] = (u32x2){0u, 0u};
            continue; }
        const f32x4* xr = (const f32x4*)((m < MP) ? s0 + (size_t)m * D : s1 + (size_t)(m - MP) * D) + F.lane;
        f32x4 v[8]; float ss = 0.f;
#pragma unroll
        for (int j = 0; j < 8; ++j) { v[j] = xr[64 * j]; ss += (v[j][0] * v[j][0] + v[j][1] * v[j][1]) + (v[j][2] * v[j][2] + v[j][3] * v[j][3]); }
        const float rs = 1.0f / sqrtf(wave_sum(ss) * (1.0f / D) + 1e-6f);
#pragma unroll
        for (int j = 0; j < 8; ++j) { const f32x4 y = v[j] * rs; o[64 * j] = (u32x2){pk2(y[0], y[1]), pk2(y[2], y[3])}; }
    }
}

__device__ __forceinline__ void gmlp_item(Frame& F, const Args& a, int l, int chunk, int g, const bf16* P, bf16* ACTA) {
    LAS bf16* Vt = (LAS bf16*)F.lds;
    const int lane = F.lane, w = F.wave;
    const float* lng = (const float*)a.in[10] + l * 512; const float* lnb = (const float*)a.in[11] + l * 512;
    const float* ws_ = (const float*)a.in[12] + (size_t)(l * 4 + g) * 128 * 128; const float* bs = (const float*)a.in[13] + (l * 4 + g) * 128;
    const int row0 = chunk * 128;
    f32x4 uv[8]; float btv[8];
    { const int li_ = lane & 15, q_ = lane >> 4, c0_ = 128 * g + 16 * w + 4 * q_;
#pragma unroll
      for (int tt = 0; tt < 8; ++tt) { const int t = 16 * tt + li_; uv[tt] = ldb4(P + (size_t)(row0 + t) * NPRE + PA0 + c0_); btv[tt] = bs[t]; } }
    const int myj = g >> 1, mylo = (g & 1) * 32;
    const f32x4 lgv = *(const f32x4*)(lng + myj * 256 + 4 * lane), lbv = *(const f32x4*)(lnb + myj * 256 + 4 * lane);
#pragma unroll 1
    for (int i0 = 0; i0 < 16; i0 += 8) {
        f32x4 xa[8], xb[8];
#pragma unroll
        for (int i = 0; i < 8; ++i) { const bf16* pr = P + (size_t)(row0 + w * 16 + i0 + i) * NPRE + PA0 + 512; xa[i] = ldb4(pr + 4 * lane); xb[i] = ldb4(pr + 256 + 4 * lane); }
#pragma unroll
        for (int i = 0; i < 8; ++i) {
            const int s = w * 16 + i0 + i; f32x4 x0 = xa[i], x1 = xb[i];
#pragma unroll
            for (int j = 0; j < 4; ++j) { x0[j] = gelu_tanh(x0[j]); x1[j] = gelu_tanh(x1[j]); }
            const float mean = wave_sum((x0[0] + x0[1]) + (x0[2] + x0[3]) + (x1[0] + x1[1]) + (x1[2] + x1[3])) * (1.f / 512.f);
            x0 -= mean; x1 -= mean;
            const float var = wave_sum((x0[0] * x0[0] + x0[1] * x0[1]) + (x0[2] * x0[2] + x0[3] * x0[3]) + (x1[0] * x1[0] + x1[1] * x1[1]) + (x1[2] * x1[2] + x1[3] * x1[3])) * (1.f / 512.f);
            const float rstd = 1.0f / sqrtf(var + 1e-5f);
            const f32x4 xm = myj ? x1 : x0;
            if ((lane >> 5) == (g & 1)) {
                const int cl = 4 * (lane - mylo);
#pragma unroll
                for (int j = 0; j < 4; ++j) Vt[(cl + j) * 136 + s] = (bf16)f2bf(xm[j] * rstd * lgv[j] + lbv[j]);
            }
        }
    }
    LDS_WAIT(); __syncthreads();
    const int li = lane & 15, q = lane >> 4;
    f32x4 acc[8];
#pragma unroll
    for (int tt = 0; tt < 8; ++tt) acc[tt] = (f32x4){0.f, 0.f, 0.f, 0.f};
#pragma unroll
    for (int ks = 0; ks < 4; ++ks) {
        const bf16x8 af = *(const LAS bf16x8*)(Vt + (16 * w + li) * 136 + 32 * ks + 8 * q);
        const int s0 = 32 * ks + 8 * q;
        f32x4 wl[8][2];
#pragma unroll
        for (int tt = 0; tt < 8; ++tt) { if (32 * ks > 16 * tt + 15) continue; const int t = 16 * tt + li; wl[tt][0] = *(const f32x4*)(ws_ + t * 128 + s0); wl[tt][1] = *(const f32x4*)(ws_ + t * 128 + s0 + 4); }
#pragma unroll
        for (int tt = 0; tt < 8; ++tt) {
            if (32 * ks > 16 * tt + 15) continue;
            const int t = 16 * tt + li;
            float wv[8] = {wl[tt][0][0], wl[tt][0][1], wl[tt][0][2], wl[tt][0][3], wl[tt][1][0], wl[tt][1][1], wl[tt][1][2], wl[tt][1][3]};
#pragma unroll
            for (int j = 0; j < 8; ++j) if (s0 + j > t) wv[j] = 0.f;
            u32x4 bw; bw.x = pk2(wv[0], wv[1]); bw.y = pk2(wv[2], wv[3]); bw.z = pk2(wv[4], wv[5]); bw.w = pk2(wv[6], wv[7]);
            acc[tt] = __builtin_amdgcn_mfma_f32_16x16x32_bf16(af, __builtin_bit_cast(bf16x8, bw), acc[tt], 0, 0, 0);
        }
    }
    {
        const int c0 = 128 * g + 16 * w + 4 * q;
#pragma unroll
        for (int tt = 0; tt < 8; ++tt) {
            const int t = 16 * tt + li; float o[4];
#pragma unroll
            for (int j = 0; j < 4; ++j) o[j] = gelu_tanh(uv[tt][j]) * (acc[tt][j] + btv[tt]);
            *(u32x2*)(ACTA + (size_t)(row0 + t) * BW + c0) = (u32x2){pk2(o[0], o[1]), pk2(o[2], o[3])};
        }
    }
    __syncthreads();
}
__device__ __forceinline__ void gmlp_sample_item(Frame& F, const Args& a, int l, const bf16* P, bf16* ACTA) {
    const int lane = F.lane, sb = F.wave;
    const float* lng = (const float*)a.in[10] + l * 512; const float* lnb = (const float*)a.in[11] + l * 512;
    float vn[4][8], uu[4][8];
#pragma unroll
    for (int t = 0; t < 4; ++t) {
        const bf16* pr = P + (size_t)(MP + sb * 4 + t) * NPRE + PA0;
        f32x4 u0 = ldb4(pr + 4 * lane), u1 = ldb4(pr + 256 + 4 * lane), x0 = ldb4(pr + 512 + 4 * lane), x1 = ldb4(pr + 768 + 4 * lane);
#pragma unroll
        for (int j = 0; j < 4; ++j) { x0[j] = gelu_tanh(x0[j]); x1[j] = gelu_tanh(x1[j]); uu[t][j] = gelu_tanh(u0[j]); uu[t][4 + j] = gelu_tanh(u1[j]); }
        const float mean = wave_sum((x0[0] + x0[1]) + (x0[2] + x0[3]) + (x1[0] + x1[1]) + (x1[2] + x1[3])) * (1.f / 512.f);
        x0 -= mean; x1 -= mean;
        const float var = wave_sum((x0[0] * x0[0] + x0[1] * x0[1]) + (x0[2] * x0[2] + x0[3] * x0[3]) + (x1[0] * x1[0] + x1[1] * x1[1]) + (x1[2] * x1[2] + x1[3] * x1[3])) * (1.f / 512.f);
        const float rstd = 1.0f / sqrtf(var + 1e-5f);
        const f32x4 g0 = *(const f32x4*)(lng + 4 * lane), g1 = *(const f32x4*)(lng + 256 + 4 * lane), b0 = *(const f32x4*)(lnb + 4 * lane), b1 = *(const f32x4*)(lnb + 256 + 4 * lane);
        f32x4 y0 = x0 * rstd * g0 + b0, y1 = x1 * rstd * g1 + b1;
        float* gv = ((float*)a.out) + O_GV + (size_t)((l * NSB + sb) * NST + t) * 512;
        *(f32x4*)(gv + 4 * lane) = y0; *(f32x4*)(gv + 256 + 4 * lane) = y1;
#pragma unroll
        for (int j = 0; j < 4; ++j) { vn[t][j] = y0[j]; vn[t][4 + j] = y1[j]; }
    }
#pragma unroll
    for (int t = 0; t < 4; ++t) {
        float o[8];
#pragma unroll
        for (int hf = 0; hf < 2; ++hf) {
            const int g = hf * 2 + (lane >> 5);
            const float* wg = (const float*)a.in[12] + (size_t)(l * 4 + g) * 128 * 128; const float bt = ((const float*)a.in[13])[(l * 4 + g) * 128 + t];
#pragma unroll
            for (int j = 0; j < 4; ++j) { float s = bt;
#pragma unroll
                for (int s2 = 0; s2 <= t; ++s2) s += wg[t * 128 + s2] * vn[s2][hf * 4 + j];
                o[hf * 4 + j] = uu[t][hf * 4 + j] * s; }
        }
        bf16* op = ACTA + (size_t)(MP + sb * 4 + t) * BW;
        *(u32x2*)(op + 4 * lane) = (u32x2){pk2(o[0], o[1]), pk2(o[2], o[3])}; *(u32x2*)(op + 256 + 4 * lane) = (u32x2){pk2(o[4], o[5]), pk2(o[6], o[7])};
    }
}
__device__ __forceinline__ void bprep_item(Frame& F, const Args& a, int l, int item, const bf16* P, bf16* QB, bf16* KB, bf16* VT, float* QS) {
    const int lane = F.lane, w = F.wave; const bool samp = (item == 256); const int row0 = item * 32;
    LAS float* vs = (LAS float*)F.lds;
    const float* qn = (const float*)a.in[15] + l * 128; const float* kn = (const float*)a.in[16] + l * 128;
    const f32x4 qg = *(const f32x4*)(qn + 4 * (lane & 31)), kg = *(const f32x4*)(kn + 4 * (lane & 31));
    const float qs = 0.08838834764831845f * LOG2E;
    f32x4 xall[4][6];
#pragma unroll
    for (int i = 0; i < 4; ++i) { const bf16* pr = P + (size_t)(row0 + w * 4 + i) * NPRE + PB0;
#pragma unroll
        for (int j = 0; j < 6; ++j) xall[i][j] = ldb4(pr + j * 256 + 4 * lane); }
#pragma unroll
    for (int i = 0; i < 4; ++i) {
        const int r = w * 4 + i, row = row0 + r;
        f32x4 x[6];
#pragma unroll
        for (int j = 0; j < 6; ++j) x[j] = xall[i][j];
        float* ko; float* vo;
        if (!samp) { ko = ((float*)a.out) + O_KP + ((size_t)l * MP + row) * 512; vo = ((float*)a.out) + O_VP + ((size_t)l * MP + row) * 512; }
        else { ko = ((float*)a.out) + O_KS + ((size_t)l * MS + r) * 512; vo = ((float*)a.out) + O_VS + ((size_t)l * MS + r) * 512; }
#pragma unroll
        for (int j = 0; j < 4; ++j) {
            float ss = (x[j][0] * x[j][0] + x[j][1] * x[j][1]) + (x[j][2] * x[j][2] + x[j][3] * x[j][3]);
#pragma unroll
            for (int o = 1; o < 32; o <<= 1) ss += __shfl_xor(ss, o);
            const float rs = 1.0f / sqrtf(ss * (1.f / 128.f) + 1e-6f);
            if (j < 2) { const f32x4 y = x[j] * rs * qg * qs;
                if (!samp) *(u32x2*)(QB + (size_t)row * BW + j * 256 + 4 * lane) = (u32x2){pk2(y[0], y[1]), pk2(y[2], y[3])};
                else *(f32x4*)(QS + (size_t)r * BW + j * 256 + 4 * lane) = y; }
            else { const f32x4 y = x[j] * rs * kg; *(f32x4*)(ko + (j - 2) * 256 + 4 * lane) = y;
                if (!samp) *(u32x2*)(KB + (size_t)row * BW + (j - 2) * 256 + 4 * lane) = (u32x2){pk2(y[0], y[1]), pk2(y[2], y[3])}; }
        }
#pragma unroll
        for (int j = 4; j < 6; ++j) { *(f32x4*)(vo + (j - 4) * 256 + 4 * lane) = x[j];
            if (!samp) { LAS float* s = vs + r * 513 + (j - 4) * 256 + 4 * lane; s[0] = x[j][0]; s[1] = x[j][1]; s[2] = x[j][2]; s[3] = x[j][3]; } }
    }
    if (!samp) {
        LDS_WAIT(); __syncthreads();
        const int n = F.tid, b = row0 / SEQ, t0 = row0 % SEQ, h = n >> 7, d = n & 127;
        bf16* vp = VT + ((size_t)((b * 4 + h) * 128 + d)) * SEQ + t0;
#pragma unroll
        for (int c = 0; c < 4; ++c) { const LAS float* s = vs + (8 * c) * 513 + n;
            u32x4 o; o.x = pk2(s[0], s[513]); o.y = pk2(s[2 * 513], s[3 * 513]); o.z = pk2(s[4 * 513], s[5 * 513]); o.w = pk2(s[6 * 513], s[7 * 513]);
            *(u32x4*)(vp + 8 * c) = o; }
        LDS_WAIT(); __syncthreads();
    }
}
__device__ __forceinline__ void cprep_item(Frame& F, const Args& a, int l, int item, const bf16* P, unsigned char* ws) {
    const int lane = F.lane, w = F.wave, tid = F.tid; const bool samp = (item == 256); const int row0 = item * 32;
    LAS bf16* act = (LAS bf16*)F.lds;
    const float* mu = (const float*)a.in[19] + l * CSHIFT;
    const float* sh0 = (const float*)a.in[6] + (size_t)l * NSB * CSHIFT;
    {
        const int r = tid >> 4, cg = tid & 15, row = row0 + r;
        const bool first = samp ? ((r & 3) == 0) : ((row % SEQ) == 0);
        const bf16* pc = P + (size_t)row * NPRE + PC0 + 1536 + cg * 16;
        const float* ps = sh0 + (size_t)(r >> 2) * CSHIFT + 1536 + cg * 16;
        unsigned o[8];
#pragma unroll
        for (int j = 0; j < 4; ++j) {
            const f32x4 c = ldb4(pc + 4 * j); f32x4 p = first ? (samp ? *(const f32x4*)(ps + 4 * j) : (f32x4){0.f, 0.f, 0.f, 0.f}) : ldb4(pc - NPRE + 4 * j); const f32x4 m = *(const f32x4*)(mu + 1536 + cg * 16 + 4 * j);
            f32x4 x = c + (p - c) * m;
#pragma unroll
            for (int e = 0; e < 4; ++e) { if (cg < 4) x[e] = 1.0f - 2.0f * rcpf_(1.0f + ex2(2.0f * LOG2E * x[e])); else if (cg >= 8) x[e] = sigmoidf_(x[e]); }
            o[2 * j] = pk2(x[0], x[1]); o[2 * j + 1] = pk2(x[2], x[3]);
        }
        LAS u32x4* dst = (LAS u32x4*)(act + r * 264 + cg * 16);
        dst[0] = (u32x4){o[0], o[1], o[2], o[3]}; dst[1] = (u32x4){o[4], o[5], o[6], o[7]};
    }
    LDS_WAIT(); __syncthreads();
    const int li = lane & 15, q = lane >> 4;
    const bf16* lw = (const bf16*)(ws + WS_LW + l * SZ_LW);
    const float* w0 = (const float*)a.in[20] + l * 512; const float* a0 = (const float*)a.in[22] + l * 512;
    const float* k_k = (const float*)a.in[25] + l * 512; const float* k_a = (const float*)a.in[26] + l * 512; const float* r_k = (const float*)a.in[27] + l * 512;
    float* Rr = (float*)(ws + WS_R + l * SZ_RWL); float* Ww = (float*)(ws + WS_W + l * SZ_RWL); float* KX = (float*)(ws + WS_KX + l * SZ_RWL); float* Vv = (float*)(ws + WS_V);
    float* KK = (float*)(ws + WS_KK + l * SZ_RWL); float* KKA = (float*)(ws + WS_KKA + l * SZ_RWL); float* GG = (float*)(ws + WS_GG); float* RK = (float*)(ws + WS_RK);
    int lwo = (64 * w + li) * 256 + 8 * q, aco = li * 264 + 8 * q, c00 = 64 * w + 4 * q;
    asm volatile("" : "+v"(lwo), "+v"(aco), "+v"(c00));
    f32x4 xsv[2][4][3];
    int rows[2];
#define CPREP_LOAD_XS(mt) do { const int r = 16 * (mt) + li, row = row0 + r; rows[mt] = row; \
        const bool first = samp ? ((r & 3) == 0) : ((row % SEQ) == 0); \
        const bf16* pc = P + (size_t)row * NPRE + PC0; \
        const float* ps = sh0 + (size_t)(r >> 2) * CSHIFT; \
        _Pragma("unroll") for (int ct = 0; ct < 4; ++ct) _Pragma("unroll") for (int j = 0; j < 3; ++j) { const int c0 = c00 + 16 * ct; const f32x4 c = ldb4(pc + j * 512 + c0); \
            const f32x4 p = first ? (samp ? *(const f32x4*)(ps + j * 512 + c0) : (f32x4){0.f, 0.f, 0.f, 0.f}) : ldb4(pc - NPRE + j * 512 + c0); xsv[mt][ct][j] = c + (p - c) * *(const f32x4*)(mu + j * 512 + c0); } } while (0)
    CPREP_LOAD_XS(0);
    f32x4 aw[2][4], aa[2][4], ag[2][4];
#pragma unroll
    for (int mt = 0; mt < 2; ++mt)
#pragma unroll
        for (int ct = 0; ct < 4; ++ct) { aw[mt][ct] = (f32x4){0.f, 0.f, 0.f, 0.f}; aa[mt][ct] = aw[mt][ct]; ag[mt][ct] = aw[mt][ct]; }
#pragma unroll
    for (int hb = 0; hb < 4; ++hb) {
        bf16x8 af[2][4];
#pragma unroll
        for (int k2 = 0; k2 < 2; ++k2)
#pragma unroll
            for (int ct = 0; ct < 4; ++ct) af[k2][ct] = *(const bf16x8*)(lw + lwo + ct * 16 * 256 + 32 * (hb * 2 + k2));
#pragma unroll
        for (int k2 = 0; k2 < 2; ++k2) { const int ks = hb * 2 + k2;
#pragma unroll
            for (int mt = 0; mt < 2; ++mt) { const bf16x8 bfr = *(const LAS bf16x8*)(act + aco + mt * 16 * 264 + 32 * ks);
#pragma unroll
                for (int ct = 0; ct < 4; ++ct) {
                    if (ks < 2) aw[mt][ct] = __builtin_amdgcn_mfma_f32_16x16x32_bf16(af[k2][ct], bfr, aw[mt][ct], 0, 0, 0);
                    else if (ks < 4) aa[mt][ct] = __builtin_amdgcn_mfma_f32_16x16x32_bf16(af[k2][ct], bfr, aa[mt][ct], 0, 0, 0);
                    else ag[mt][ct] = __builtin_amdgcn_mfma_f32_16x16x32_bf16(af[k2][ct], bfr, ag[mt][ct], 0, 0, 0);
                } } }
        asm volatile("" ::: "memory");
    }
#pragma unroll
    for (int mt = 0; mt < 2; ++mt) {
        if (mt == 1) { asm volatile("" ::: "memory"); CPREP_LOAD_XS(1); }
        const int row = rows[mt];
        f32x4 kkv[4], av[4]; float ss = 0.f, rk = 0.f;
#pragma unroll
        for (int ct = 0; ct < 4; ++ct) {
            const int c0 = c00 + 16 * ct;
            f32x4 xs[3];
#pragma unroll
            for (int j = 0; j < 3; ++j) xs[j] = xsv[mt][ct][j];
            const f32x4 w0v = *(const f32x4*)(w0 + c0), a0v = *(const f32x4*)(a0 + c0), kkw = *(const f32x4*)(k_k + c0), kaw = *(const f32x4*)(k_a + c0), rkw = *(const f32x4*)(r_k + c0);
            f32x4 dec;
#pragma unroll
            for (int e = 0; e < 4; ++e) {
                const float x = -(w0v[e] + aw[mt][ct][e]);
                const float sp = fmaxf(x, 0.f) + 0.6931471805599453f * __builtin_amdgcn_logf(1.0f + ex2(-fabsf(x) * LOG2E));
                dec[e] = ex2(-LOG2E * ex2(LOG2E * (-sp - 0.5f)));
                av[ct][e] = sigmoidf_(a0v[e] + aa[mt][ct][e]);
            }
            kkv[ct] = xs[1] * kkw;
            const f32x4 kxv = xs[1] * (1.0f + (av[ct] - 1.0f) * kaw);
            ss += (kkv[ct][0] * kkv[ct][0] + kkv[ct][1] * kkv[ct][1]) + (kkv[ct][2] * kkv[ct][2] + kkv[ct][3] * kkv[ct][3]);
            const f32x4 t = xs[0] * kxv * rkw; rk += (t[0] + t[1]) + (t[2] + t[3]);
            const size_t o = (size_t)row * BW + c0;
            *(f32x4*)(Rr + o) = xs[0]; *(f32x4*)(Ww + o) = dec; *(f32x4*)(KX + o) = kxv; *(f32x4*)(Vv + o) = xs[2]; *(f32x4*)(GG + o) = ag[mt][ct];
        }
        ss += __shfl_xor(ss, 16); ss += __shfl_xor(ss, 32); rk += __shfl_xor(rk, 16); rk += __shfl_xor(rk, 32);
        const float rn = 1.0f / sqrtf(fmaxf(ss, 1e-24f));
#pragma unroll
        for (int ct = 0; ct < 4; ++ct) { const size_t o = (size_t)row * BW + c00 + 16 * ct; const f32x4 kk = kkv[ct] * rn; *(f32x4*)(KK + o) = kk; *(f32x4*)(KKA + o) = kk * av[ct]; }
        if (q == 0) RK[(size_t)row * 8 + w] = rk;
    }
#undef CPREP_LOAD_XS
    if (!samp) { if ((row0 + 32) % SEQ == 0) { const int b = row0 / SEQ; const bf16* src = P + (size_t)(row0 + 31) * NPRE + PC0; float* dst = ((float*)a.out) + O_SHP + (size_t)(l * 2 + b) * CSHIFT;
            for (int i = tid; i < CSHIFT; i += 512) dst[i] = __builtin_bit_cast(float, (unsigned)src[i] << 16); } }
    else { for (int i = tid; i < NSB * CSHIFT; i += 512) { const int sb = i / CSHIFT, c = i % CSHIFT; ((float*)a.out)[O_SHS + (size_t)(l * NSB + sb) * CSHIFT + c] = __builtin_bit_cast(float, (unsigned)P[(size_t)(MP + sb * 4 + 3) * NPRE + PC0 + c] << 16); } }
    __syncthreads();
}
__device__ __forceinline__ void dconv_item(Frame& F, const Args& a, int l, int item, const bf16* P, bf16* ACTD) {
    const int tid = F.tid, lane = F.lane, w = F.wave;
    LAS float* z = (LAS float*)F.lds;
    LAS float* red = (LAS float*)(F.lds + 62 * 512 * 4);
    const bool samp = item >= 256; const int sb = item - 256;
    const int rowbase = samp ? MP + sb * 4 : item * 32;
    const int t0 = samp ? 0 : (item * 32) % SEQ, ntok = samp ? 4 : 32;
    const float* conv0 = (const float*)a.in[7] + (size_t)(l * NSB + (samp ? sb : 0)) * 30 * 512;
    const int c = tid;
    const float* cw = (const float*)a.in[31] + (size_t)l * 31 * 512; const float cb = ((const float*)a.in[32])[l * 512 + c];
    const float lg = ((const float*)a.in[33])[l * 512 + c], lb = ((const float*)a.in[34])[l * 512 + c];
    float wv[31];
#pragma unroll
    for (int j = 0; j < 31; ++j) wv[j] = cw[j * 512 + c];
    {
        const int rs = tid >> 7, c4 = (tid & 127) * 4, nrow = 30 + ntok;
#pragma unroll
        for (int hb = 0; hb < 2; ++hb) {
            f32x4 va[8], ga[8];
#pragma unroll
            for (int jj = 0; jj < 8; ++jj) { const int i = rs + 4 * (hb * 8 + jj), t = t0 - 30 + i;
                va[jj] = (f32x4){0.f, 0.f, 0.f, 0.f}; ga[jj] = va[jj];
                if (i < nrow) {
                    if (t < 0) { if (samp) va[jj] = *(const f32x4*)(conv0 + (size_t)i * 512 + c4); }
                    else { const bf16* pr = P + (size_t)(rowbase - 30 + i) * NPRE + PD0 + c4; va[jj] = ldb4(pr); ga[jj] = ldb4(pr + 512); } } }
#pragma unroll
            for (int jj = 0; jj < 8; ++jj) { const int i = rs + 4 * (hb * 8 + jj), t = t0 - 30 + i;
                if (i < nrow) { f32x4 zv = va[jj];
                    if (t >= 0) { zv[0] *= sigmoidf_(ga[jj][0]); zv[1] *= sigmoidf_(ga[jj][1]); zv[2] *= sigmoidf_(ga[jj][2]); zv[3] *= sigmoidf_(ga[jj][3]); }
                    *(LAS f32x4*)(z + i * 512 + c4) = zv; } }
        }
    }
    LDS_WAIT(); __syncthreads();
    if (samp) { float* dst = ((float*)a.out) + O_CS + (size_t)(l * NSB + sb) * 30 * 512; for (int i = 0; i < 30; ++i) dst[(size_t)i * 512 + c] = z[(4 + i) * 512 + c]; }
    else if (t0 + 32 == SEQ) { float* dst = ((float*)a.out) + O_CP + (size_t)(l * 2 + (item * 32) / SEQ) * 30 * 512; for (int i = 0; i < 30; ++i) dst[(size_t)i * 512 + c] = z[(32 + i) * 512 + c]; }
    float y[32];
#pragma unroll
    for (int t = 0; t < 32; ++t) y[t] = cb;
#pragma unroll
    for (int i = 0; i < 62; ++i) {
        if (i < 30 + ntok) { const float zi = z[i * 512 + c];
#pragma unroll
            for (int t = 0; t < 32; ++t) { if (i - t >= 0 && i - t <= 30) y[t] = fmaf(zi, wv[i - t], y[t]); } }
    }
    {
        float u1[16], u2[16];
        { const bool hb = (lane & 32) != 0;
#pragma unroll
          for (int j = 0; j < 16; ++j) { const float ka = hb ? y[16 + j] : y[j], sa = hb ? y[j] : y[16 + j]; u1[j] = ka + __shfl_xor(sa, 32); u2[j] = ka * ka + __shfl_xor(sa * sa, 32); } }
        float v1[8], v2[8];
        { const bool hb = (lane & 16) != 0;
#pragma unroll
          for (int j = 0; j < 8; ++j) { v1[j] = (hb ? u1[8 + j] : u1[j]) + __shfl_xor(hb ? u1[j] : u1[8 + j], 16); v2[j] = (hb ? u2[8 + j] : u2[j]) + __shfl_xor(hb ? u2[j] : u2[8 + j], 16); } }
        float w1[4], w2[4];
        { const bool hb = (lane & 8) != 0;
#pragma unroll
          for (int j = 0; j < 4; ++j) { w1[j] = (hb ? v1[4 + j] : v1[j]) + __shfl_xor(hb ? v1[j] : v1[4 + j], 8); w2[j] = (hb ? v2[4 + j] : v2[j]) + __shfl_xor(hb ? v2[j] : v2[4 + j], 8); } }
        float x1[2], x2[2];
        { const bool hb = (lane & 4) != 0;
#pragma unroll
          for (int j = 0; j < 2; ++j) { x1[j] = (hb ? w1[2 + j] : w1[j]) + __shfl_xor(hb ? w1[j] : w1[2 + j], 4); x2[j] = (hb ? w2[2 + j] : w2[j]) + __shfl_xor(hb ? w2[j] : w2[2 + j], 4); } }
        float z1, z2;
        { const bool hb = (lane & 2) != 0; z1 = (hb ? x1[1] : x1[0]) + __shfl_xor(hb ? x1[0] : x1[1], 2); z2 = (hb ? x2[1] : x2[0]) + __shfl_xor(hb ? x2[0] : x2[1], 2); }
        z1 += __shfl_xor(z1, 1); z2 += __shfl_xor(z2, 1);
        const int trow = ((lane >> 5) & 1) * 16 + ((lane >> 4) & 1) * 8 + ((lane >> 3) & 1) * 4 + ((lane >> 2) & 1) * 2 + ((lane >> 1) & 1);
        if ((lane & 1) == 0) { red[(trow * 8 + w) * 2] = z1; red[(trow * 8 + w) * 2 + 1] = z2; }
    }
    LDS_WAIT(); __syncthreads();
    if (tid < 32) { float s1 = 0.f, s2 = 0.f;
#pragma unroll
        for (int j = 0; j < 8; ++j) { s1 += red[(tid * 8 + j) * 2]; s2 += red[(tid * 8 + j) * 2 + 1]; }
        const float mean = s1 * (1.f / 512.f), var = fmaxf(s2 * (1.f / 512.f) - mean * mean, 0.f);
        red[512 + tid * 2] = mean; red[512 + tid * 2 + 1] = 1.0f / sqrtf(var + 1e-5f); }
    LDS_WAIT(); __syncthreads();
#pragma unroll
    for (int t = 0; t < 32; ++t) { if (t < ntok) { const float v = (y[t] - red[512 + t * 2]) * red[512 + t * 2 + 1] * lg + lb; ACTD[(size_t)(rowbase + t) * BW + c] = (bf16)f2bf(v * sigmoidf_(v)); } }
    __syncthreads();
}

template <bool SK>
__device__ __forceinline__ void scan_task(const float* R, const float* W, const float* KX, const float* KK, const float* KKA, const float* V, float* OUT, float* STT, const float* S0, float* SOUT, int nstep, int lane) {
    float s[64];
    if (S0) {
#pragma unroll
        for (int k4 = 0; k4 < 16; ++k4) { const f32x4 v = *(const f32x4*)(S0 + lane * 64 + 4 * k4); s[4 * k4] = v[0]; s[4 * k4 + 1] = v[1]; s[4 * k4 + 2] = v[2]; s[4 * k4 + 3] = v[3]; }
    } else {
#pragma unroll
        for (int k = 0; k < 64; ++k) s[k] = SK ? 0.f : (k == lane ? 1.f : 0.f);
    }
    float pf0 = 0.f, pf1 = 0.f, pf2 = 0.f, pf3 = 0.f, pf4 = 0.f;
    for (int t = 0; t < nstep; ++t) {
        asm volatile("" :: "v"(pf0), "v"(pf1), "v"(pf2), "v"(pf3), "v"(pf4));
        { const int tp = (t + 2 < nstep) ? t + 2 : t; const size_t po = (size_t)tp * BW + lane;
          pf0 = KK[po]; pf1 = W[po]; pf2 = KKA[po]; pf3 = KX[po]; pf4 = R[po]; }
        cfloat* kk = (cfloat*)(KK + (size_t)t * BW); cfloat* w = (cfloat*)(W + (size_t)t * BW); cfloat* kka = (cfloat*)(KKA + (size_t)t * BW);
        cfloat* kx = (cfloat*)(KX + (size_t)t * BW); cfloat* r = (cfloat*)(R + (size_t)t * BW);
        float d0 = 0.f, d1 = 0.f;
#pragma unroll
        for (int k = 0; k < 64; k += 2) { d0 = fmaf(s[k], kk[k], d0); d1 = fmaf(s[k + 1], kk[k + 1], d1); }
        const float nd = -(d0 + d1);
        const float vt = SK ? V[(size_t)t * BW + lane] : 0.f;
        float o0 = 0.f, o1 = 0.f;
#pragma unroll
        for (int k = 0; k < 64; k += 2) {
            float x = s[k] * w[k]; x = fmaf(nd, kka[k], x); if (SK) x = fmaf(vt, kx[k], x); s[k] = x; o0 = fmaf(x, r[k], o0);
            float y = s[k + 1] * w[k + 1]; y = fmaf(nd, kka[k + 1], y); if (SK) y = fmaf(vt, kx[k + 1], y); s[k + 1] = y; o1 = fmaf(y, r[k + 1], o1);
        }
        OUT[(size_t)t * BW + lane] = o0 + o1;
    }
    asm volatile("" :: "v"(pf0), "v"(pf1), "v"(pf2), "v"(pf3), "v"(pf4));
    if (STT) {
#pragma unroll
        for (int k = 0; k < 64; ++k) STT[k * 64 + lane] = s[k];
    }
    if (SOUT) {
#pragma unroll
        for (int k4 = 0; k4 < 16; ++k4) *(f32x4*)(SOUT + lane * 64 + 4 * k4) = (f32x4){s[4 * k4], s[4 * k4 + 1], s[4 * k4 + 2], s[4 * k4 + 3]};
    }
}
__device__ __forceinline__ const float* uni_ptr(const float* p) { const unsigned long long v = (unsigned long long)p; const unsigned lo = __builtin_amdgcn_readfirstlane((unsigned)v), hi = __builtin_amdgcn_readfirstlane((unsigned)(v >> 32)); return (const float*)(((unsigned long long)hi << 32) | lo); }
__device__ __forceinline__ void scan_item(Frame& F, int l, int item, unsigned char* ws) {
    const int b = item >> 7, chunk = (item >> 1) & 63, hq = item & 1, h = hq * 4 + (F.wave & 3);
    const size_t ro = ((size_t)(b * SEQ + chunk * 64)) * BW + h * 64; const size_t so = ((size_t)((b * 8 + h) * 64 + chunk)) * 4096;
    const float* R = (const float*)(ws + WS_R + l * SZ_RWL) + ro; const float* W = (const float*)(ws + WS_W + l * SZ_RWL) + ro; const float* KX = (const float*)(ws + WS_KX + l * SZ_RWL) + ro;
    const float* KK = (const float*)(ws + WS_KK + l * SZ_RWL) + ro; const float* KKA = (const float*)(ws + WS_KKA + l * SZ_RWL) + ro; const float* V = (const float*)(ws + WS_V) + ro;
    if (F.wave >> 2) scan_task<true>(uni_ptr(R), uni_ptr(W), uni_ptr(KX), uni_ptr(KK), uni_ptr(KKA), V, (float*)(ws + WS_OL) + ro, (float*)(ws + WS_LC) + so, nullptr, nullptr, 64, F.lane);
    else scan_task<false>(uni_ptr(R), uni_ptr(W), uni_ptr(KX), uni_ptr(KK), uni_ptr(KKA), V, (float*)(ws + WS_PR) + ro, nullptr, nullptr, (float*)(ws + WS_PC) + so, 64, F.lane);
}
__device__ __forceinline__ void scan_sample_item(Frame& F, const Args& a, int l, int sb, unsigned char* ws) {
    const int h = F.wave; const size_t ro = ((size_t)(MP + sb * 4)) * BW + h * 64;
    const float* S0 = (const float*)a.in[5] + ((size_t)((l * NSB + sb) * 8 + h)) * 4096; float* SO = ((float*)a.out) + O_WS + ((size_t)((l * NSB + sb) * 8 + h)) * 4096;
    scan_task<true>(uni_ptr((const float*)(ws + WS_R + l * SZ_RWL) + ro), uni_ptr((const float*)(ws + WS_W + l * SZ_RWL) + ro), uni_ptr((const float*)(ws + WS_KX + l * SZ_RWL) + ro), uni_ptr((const float*)(ws + WS_KK + l * SZ_RWL) + ro), uni_ptr((const float*)(ws + WS_KKA + l * SZ_RWL) + ro),
                    (const float*)(ws + WS_V) + ro, (float*)(ws + WS_OL) + ro, nullptr, S0, SO, 4, F.lane);
}
__device__ __forceinline__ float4 ld4(const float* p) { return *(const float4*)p; }
__device__ __forceinline__ void decode_item(Frame& F, const Args& a, int l, int item, unsigned char* ws) {
    const int sb = item >> 6, seg = item & 63, lane = F.lane, w = F.wave, tid = F.tid;
    LAS float* OM = (LAS float*)F.lds; LAS float* BT = OM + 256 * 16; LAS float* SEGT = BT + 256 * 16;
    const float* QS = (const float*)(ws + WS_QS); const int* pt = (const int*)a.in[4] + sb * NPAGES;
    const float* ck = (const float*)a.in[2] + (size_t)l * NPHYS * 128 * 512; const float* cv = (const float*)a.in[3] + (size_t)l * NPHYS * 128 * 512;
    const float* bias = (const float*)a.in[17] + l * 4;
    f32x4 Qr[4][2];
#pragma unroll
    for (int qi = 0; qi < 4; ++qi)
#pragma unroll
        for (int g = 0; g < 2; ++g) Qr[qi][g] = *(const f32x4*)(QS + (size_t)(sb * 4 + qi) * BW + g * 256 + 4 * lane);
    const int page = pt[seg * 2 + (w >> 2)];
    const size_t rbase = ((size_t)page * 128 + (w & 3) * 32) * 512;
    const int b4 = (lane >> 4) & 1, b3 = (lane >> 3) & 1, b2 = (lane >> 2) & 1;
    const int vidx = b4 * 4 + b3 * 2 + b2, qi_m = vidx >> 1, head_m = (vidx & 1) * 2 + (lane >> 5);
    const float bias_m = bias[head_m] * LOG2E;
    {
        f32x4 ka[4][2], kb[4][2];
#define DEC_LOADK(dst, i0) do { asm volatile("" ::: "memory"); _Pragma("unroll") for (int u = 0; u < 4; ++u) { const float* kr = ck + rbase + (size_t)((i0) + u) * 512; dst[u][0] = __builtin_nontemporal_load((const f32x4*)(kr + 4 * lane)); dst[u][1] = __builtin_nontemporal_load((const f32x4*)(kr + 256 + 4 * lane)); } } while (0)
#define DEC_SCORE(src, i0) do { _Pragma("unroll") for (int u = 0; u < 4; ++u) { \
            float v[8]; \
            _Pragma("unroll") for (int qi = 0; qi < 4; ++qi) { const f32x4 p0 = src[u][0] * Qr[qi][0], p1 = src[u][1] * Qr[qi][1]; v[qi * 2] = (p0[0] + p0[1]) + (p0[2] + p0[3]); v[qi * 2 + 1] = (p1[0] + p1[1]) + (p1[2] + p1[3]); } \
            float r4[4], r2[2], r1; \
            _Pragma("unroll") for (int j = 0; j < 4; ++j) { const float snd = b4 ? v[j] : v[4 + j], kp = b4 ? v[4 + j] : v[j]; r4[j] = kp + __shfl_xor(snd, 16); } \
            _Pragma("unroll") for (int j = 0; j < 2; ++j) { const float snd = b3 ? r4[j] : r4[2 + j], kp = b3 ? r4[2 + j] : r4[j]; r2[j] = kp + __shfl_xor(snd, 8); } \
            { const float snd = b2 ? r2[0] : r2[1], kp = b2 ? r2[1] : r2[0]; r1 = kp + __shfl_xor(snd, 4); } \
            r1 += __shfl_xor(r1, 2); r1 += __shfl_xor(r1, 1); \
            const float e = ex2(r1 + bias_m), om = rcpf_(1.0f + e), bt = e * om; \
            if ((lane & 3) == 0) { const int kl = w * 32 + (i0) + u; OM[kl * 16 + qi_m * 4 + head_m] = om; BT[kl * 16 + qi_m * 4 + head_m] = bt; } } } while (0)
        DEC_LOADK(ka, 0); DEC_LOADK(kb, 4); DEC_SCORE(ka, 0); DEC_LOADK(ka, 8); DEC_SCORE(kb, 4); DEC_LOADK(kb, 12); DEC_SCORE(ka, 8); DEC_LOADK(ka, 16); DEC_SCORE(kb, 12); DEC_LOADK(kb, 20); DEC_SCORE(ka, 16); DEC_LOADK(ka, 24); DEC_SCORE(kb, 20); DEC_LOADK(kb, 28); DEC_SCORE(ka, 24); DEC_SCORE(kb, 28);
#undef DEC_LOADK
#undef DEC_SCORE
    }
    LDS_WAIT(); __syncthreads();
    {
        const int qh = tid & 15, sg = tid >> 4;
        float pr = 1.f;
#pragma unroll
        for (int j = 0; j < 8; ++j) pr *= OM[(sg * 8 + j) * 16 + qh];
        SEGT[sg * 16 + qh] = pr;
        LDS_WAIT(); __syncthreads();
        float suf = 1.f;
        for (int s2 = 31; s2 > sg; --s2) suf *= SEGT[s2 * 16 + qh];
#pragma unroll
        for (int j = 7; j >= 0; --j) { const int kl = sg * 8 + j; const float att = BT[kl * 16 + qh] * suf; suf *= OM[kl * 16 + qh]; BT[kl * 16 + qh] = att; }
        if (sg == 0) ((float*)(ws + WS_TSEG))[(size_t)(sb * 64 + seg) * 16 + qh] = suf;
    }
    LDS_WAIT(); __syncthreads();
    f32x4 O[4][2];
#pragma unroll
    for (int qi = 0; qi < 4; ++qi) { O[qi][0] = (f32x4){0.f, 0.f, 0.f, 0.f}; O[qi][1] = O[qi][0]; }
    const int hh = lane >> 5;
    {
        f32x4 va[4][2], vb[4][2];
#define DEC_LOADV(dst, i0) do { asm volatile("" ::: "memory"); _Pragma("unroll") for (int u = 0; u < 4; ++u) { const float* vr = cv + rbase + (size_t)((i0) + u) * 512; dst[u][0] = __builtin_nontemporal_load((const f32x4*)(vr + 4 * lane)); dst[u][1] = __builtin_nontemporal_load((const f32x4*)(vr + 256 + 4 * lane)); } } while (0)
#define DEC_ACC(src, i0) do { _Pragma("unroll") for (int u = 0; u < 4; ++u) { const int kl = w * 32 + (i0) + u; \
            _Pragma("unroll") for (int qi = 0; qi < 4; ++qi) { const float a0 = BT[kl * 16 + qi * 4 + hh], a1 = BT[kl * 16 + qi * 4 + 2 + hh]; O[qi][0] += src[u][0] * a0; O[qi][1] += src[u][1] * a1; } } } while (0)
        DEC_LOADV(va, 0); DEC_LOADV(vb, 4); DEC_ACC(va, 0); DEC_LOADV(va, 8); DEC_ACC(vb, 4); DEC_LOADV(vb, 12); DEC_ACC(va, 8); DEC_LOADV(va, 16); DEC_ACC(vb, 12); DEC_LOADV(vb, 20); DEC_ACC(va, 16); DEC_LOADV(va, 24); DEC_ACC(vb, 20); DEC_LOADV(vb, 28); DEC_ACC(va, 24); DEC_ACC(vb, 28);
#undef DEC_LOADV
#undef DEC_ACC
    }
    __syncthreads();
    LAS float* RED = (LAS float*)F.lds;
#pragma unroll
    for (int qi = 0; qi < 4; ++qi)
#pragma unroll
        for (int g = 0; g < 2; ++g) { LAS float* d = RED + ((w * 16 + qi * 4 + g * 2 + hh) * 128 + 4 * (lane & 31)); d[0] = O[qi][g][0]; d[1] = O[qi][g][1]; d[2] = O[qi][g][2]; d[3] = O[qi][g][3]; }
    LDS_WAIT(); __syncthreads();
    { f32x4 s = (f32x4){0.f, 0.f, 0.f, 0.f};
#pragma unroll
      for (int j = 0; j < 8; ++j) { const LAS float* p = RED + j * 2048 + tid * 4; s += (f32x4){p[0], p[1], p[2], p[3]}; }
      *(f32x4*)((float*)(ws + WS_OSEG) + (size_t)(sb * 64 + seg) * 2048 + tid * 4) = s; }
    __syncthreads();
}

__device__ __forceinline__ void attn_unit(Frame& F, int b, int h, int qt, int kb_lo, int nkb, const bf16* QB, const bf16* KB, const bf16* VT, bf16* OUT, float bias2, f32x4* part, float* tpart) {
    LAS bf16* Ks = (LAS bf16*)F.lds;
    LAS bf16* Vs = (LAS bf16*)(F.lds + 34816);
    const int w = F.wave, lane = F.lane, li = lane & 15, g = lane >> 4, tid = F.tid;
    const int q0 = qt * 128 + w * 16, qpos = q0 + li;
    bf16x8 qf[4];
    { const bf16* qp = QB + (size_t)(b * SEQ + qpos) * BW + h * 128 + 8 * g;
#pragma unroll
      for (int ks = 0; ks < 4; ++ks) qf[ks] = *(const bf16x8*)(qp + 32 * ks); }
    f32x4 oacc[8];
#pragma unroll
    for (int dt = 0; dt < 8; ++dt) oacc[dt] = (f32x4){0.f, 0.f, 0.f, 0.f};
    float carry = 1.f;
    const int kr0 = tid >> 4, kc0 = (tid & 15) * 8;
    const int vr0 = tid >> 3, vc0 = (tid & 7) * 8;
    const bf16* kg = KB + (size_t)(b * SEQ) * BW + h * 128 + kc0;
    const bf16* vg = VT + (size_t)((b * 4 + h) * 128) * SEQ + vc0;
    u32x4 lk[2], lv[2];
    { const int kb = kb_lo + nkb - 1;
      lk[0] = *(const u32x4*)(kg + (size_t)(kb * 64 + kr0) * BW); lk[1] = *(const u32x4*)(kg + (size_t)(kb * 64 + kr0 + 32) * BW);
      lv[0] = *(const u32x4*)(vg + (size_t)vr0 * SEQ + kb * 64); lv[1] = *(const u32x4*)(vg + (size_t)(vr0 + 64) * SEQ + kb * 64);
      *(LAS u32x4*)(Ks + kr0 * 136 + kc0) = lk[0]; *(LAS u32x4*)(Ks + (kr0 + 32) * 136 + kc0) = lk[1];
      *(LAS u32x4*)(Vs + vr0 * 72 + vc0) = lv[0]; *(LAS u32x4*)(Vs + (vr0 + 64) * 72 + vc0) = lv[1]; }
    LDS_WAIT(); __syncthreads();
    for (int it = 0; it < nkb; ++it) {
        const int kb = kb_lo + nkb - 1 - it, buf = it & 1; const bool more = (it + 1 < nkb);
        if (more) { const int k2 = kb - 1;
            lk[0] = *(const u32x4*)(kg + (size_t)(k2 * 64 + kr0) * BW); lk[1] = *(const u32x4*)(kg + (size_t)(k2 * 64 + kr0 + 32) * BW);
            lv[0] = *(const u32x4*)(vg + (size_t)vr0 * SEQ + k2 * 64); lv[1] = *(const u32x4*)(vg + (size_t)(vr0 + 64) * SEQ + k2 * 64); }
        if (kb * 64 < q0 + 15) {
            const LAS bf16* Kb = Ks + buf * (64 * 136); const LAS bf16* Vb = Vs + buf * (128 * 72);
            f32x4 s[4];
#pragma unroll
            for (int st = 0; st < 4; ++st) { s[st] = (f32x4){bias2, bias2, bias2, bias2};
#pragma unroll
                for (int ks = 0; ks < 4; ++ks) { const bf16x8 af = *(const LAS bf16x8*)(Kb + (16 * st + li) * 136 + 32 * ks + 8 * g); s[st] = __builtin_amdgcn_mfma_f32_16x16x32_bf16(af, qf[ks], s[st], 0, 0, 0); } }
            float om[4][4], bt[4][4], lt[4], X[4], GT[4];
            if (kb * 64 + 63 >= q0) {
                const int kbase = kb * 64 + 4 * g;
#pragma unroll
                for (int st = 0; st < 4; ++st)
#pragma unroll
                    for (int r = 0; r < 4; ++r) { const float e = ex2(s[st][r]); float o = rcpf_(1.0f + e), bb = e * o;
                        if (kbase + 16 * st + r >= qpos) { o = 1.f; bb = 0.f; }
                        om[st][r] = o; bt[st][r] = bb; }
            } else {
#pragma unroll
                for (int st = 0; st < 4; ++st)
#pragma unroll
                    for (int r = 0; r < 4; ++r) { const float e = ex2(s[st][r]); const float o = rcpf_(1.0f + e); om[st][r] = o; bt[st][r] = e * o; }
            }
#pragma unroll
            for (int st = 0; st < 4; ++st) {
                const float sp2 = om[st][3], sp1 = sp2 * om[st][2], sp0 = sp1 * om[st][1]; lt[st] = sp0 * om[st][0];
                bt[st][2] *= sp2; bt[st][1] *= sp1; bt[st][0] *= sp0;
                const float xa = __shfl_xor(lt[st], 16), xb = __shfl_xor(lt[st], 32), xc = __shfl_xor(lt[st], 48);
                X[st] = (g == 0) ? xa * xb * xc : (g == 1) ? xb * xc : (g == 2) ? xa : 1.f;
                GT[st] = lt[st] * xa * xb * xc;
            }
            const float Y3 = carry, Y2 = Y3 * GT[3], Y1 = Y2 * GT[2], Y0 = Y1 * GT[1];
            carry = Y0 * GT[0];
            const float f[4] = {Y0 * X[0], Y1 * X[1], Y2 * X[2], Y3 * X[3]};
            bf16x8 pf[2];
#pragma unroll
            for (int ks = 0; ks < 2; ++ks) { u32x4 pw; pw.x = pk2(bt[2 * ks][0] * f[2 * ks], bt[2 * ks][1] * f[2 * ks]); pw.y = pk2(bt[2 * ks][2] * f[2 * ks], bt[2 * ks][3] * f[2 * ks]);
                pw.z = pk2(bt[2 * ks + 1][0] * f[2 * ks + 1], bt[2 * ks + 1][1] * f[2 * ks + 1]); pw.w = pk2(bt[2 * ks + 1][2] * f[2 * ks + 1], bt[2 * ks + 1][3] * f[2 * ks + 1]); pf[ks] = __builtin_bit_cast(bf16x8, pw); }
#pragma unroll
            for (int dt = 0; dt < 8; ++dt)
#pragma unroll
                for (int ks = 0; ks < 2; ++ks) { const LAS bf16* vp = Vb + (16 * dt + li) * 72 + 32 * ks + 4 * g;
                    const u32x2 a0 = *(const LAS u32x2*)vp, a1 = *(const LAS u32x2*)(vp + 16); const u32x4 av = (u32x4){a0.x, a0.y, a1.x, a1.y};
                    oacc[dt] = __builtin_amdgcn_mfma_f32_16x16x32_bf16(__builtin_bit_cast(bf16x8, av), pf[ks], oacc[dt], 0, 0, 0); }
        }
        if (more) { const int nb = buf ^ 1;
            *(LAS u32x4*)(Ks + nb * (64 * 136) + kr0 * 136 + kc0) = lk[0]; *(LAS u32x4*)(Ks + nb * (64 * 136) + (kr0 + 32) * 136 + kc0) = lk[1];
            *(LAS u32x4*)(Vs + nb * (128 * 72) + vr0 * 72 + vc0) = lv[0]; *(LAS u32x4*)(Vs + nb * (128 * 72) + (vr0 + 64) * 72 + vc0) = lv[1]; }
        LDS_WAIT(); __syncthreads();
    }
    if (part) {
#pragma unroll
        for (int dt = 0; dt < 8; ++dt) part[(w * 8 + dt) * 64 + lane] = oacc[dt];
        if (tpart) tpart[w * 64 + lane] = carry;
    } else {
        bf16* op = OUT + (size_t)(b * SEQ + qpos) * BW + h * 128 + 4 * g;
#pragma unroll
        for (int dt = 0; dt < 8; ++dt) *(u32x2*)(op + 16 * dt) = (u32x2){pk2(oacc[dt][0], oacc[dt][1]), pk2(oacc[dt][2], oacc[dt][3])};
    }
}
__device__ __forceinline__ void attn_combine_item(Frame& F, int item, unsigned char* ws, bf16* OUT) {
    const int bh = item >> 4, q16 = item & 15, qt = 16 + q16, b = bh >> 2, h = bh & 3, w = F.wave, lane = F.lane, li = lane & 15, g = lane >> 4;
    const size_t base = (size_t)(bh * 16 + q16);
    const float* pl = (const float*)(ws + WS_OPART) + (base * 2 + 0) * 16384 + (size_t)(w * 8 * 64 + lane) * 4;
    const float* pr = (const float*)(ws + WS_OPART) + (base * 2 + 1) * 16384 + (size_t)(w * 8 * 64 + lane) * 4;
    const float t = ((const float*)(ws + WS_TPART))[base * 512 + w * 64 + lane];
    bf16* op = OUT + (size_t)(b * SEQ + qt * 128 + w * 16 + li) * BW + h * 128 + 4 * g;
#pragma unroll
    for (int dt = 0; dt < 8; ++dt) { const f32x4 a = *(const f32x4*)(pr + dt * 256), c = *(const f32x4*)(pl + dt * 256); const f32x4 o = a + c * t; *(u32x2*)(op + 16 * dt) = (u32x2){pk2(o[0], o[1]), pk2(o[2], o[3])}; }
}
#define CARRY_BAR() do { asm volatile("s_waitcnt lgkmcnt(0)" ::: "memory"); __builtin_amdgcn_s_barrier(); asm volatile("" ::: "memory"); } while (0)
__device__ __forceinline__ void carry_item(Frame& F, const Args& a, int l, int bh, unsigned char* ws) {
    const int lane = F.lane, w = F.wave, bi = w & 1, bj = (w >> 1) & 1, kh = w >> 2, l31 = lane & 31, hi = lane >> 5;
    LAS float* St = (LAS float*)F.lds;
    LAS float* Pp = (LAS float*)(F.lds + 16384);
    const float* PC = (const float*)(ws + WS_PC) + (size_t)bh * 64 * 4096; const float* LC = (const float*)(ws + WS_LC) + (size_t)bh * 64 * 4096; float* SS = (float*)(ws + WS_SS) + (size_t)bh * 64 * 4096;
    for (int i = F.tid; i < 4096; i += 512) { St[i] = 0.f; SS[i] = 0.f; }
    const int lo_p = (32 * kh + hi) * 64 + 32 * bi + l31, lo_s = (32 * kh + hi) * 64 + 32 * bj + l31, lo_o = (32 * bi + 4 * hi) * 64 + 32 * bj + l31;
    float afn[16], ltn[16];
#pragma unroll
    for (int kk2 = 0; kk2 < 16; ++kk2) afn[kk2] = PC[lo_p + kk2 * 128];
#pragma unroll
    for (int r = 0; r < 16; ++r) ltn[r] = (kh == 0) ? LC[lo_o + ((r & 3) + 8 * (r >> 2)) * 64] : 0.f;
    CARRY_BAR();
    for (int c = 0; c < 64; ++c) {
        float af[16], lt[16];
#pragma unroll
        for (int i = 0; i < 16; ++i) { af[i] = afn[i]; lt[i] = ltn[i]; }
        if (c < 63) {
            const float* Pn = PC + (size_t)(c + 1) * 4096; const float* Ln = LC + (size_t)(c + 1) * 4096;
#pragma unroll
            for (int kk2 = 0; kk2 < 16; ++kk2) afn[kk2] = Pn[lo_p + kk2 * 128];
            if (kh == 0) {
#pragma unroll
                for (int r = 0; r < 16; ++r) ltn[r] = Ln[lo_o + ((r & 3) + 8 * (r >> 2)) * 64];
            }
        }
        float bfv[16];
#pragma unroll
        for (int kk2 = 0; kk2 < 16; ++kk2) bfv[kk2] = St[lo_s + kk2 * 128];
        f32x16 acc0, acc1;
#pragma unroll
        for (int r = 0; r < 16; ++r) { acc0[r] = 0.f; acc1[r] = 0.f; }
#pragma unroll
        for (int kk2 = 0; kk2 < 16; kk2 += 2) { acc0 = __builtin_amdgcn_mfma_f32_32x32x2f32(af[kk2], bfv[kk2], acc0, 0, 0, 0); acc1 = __builtin_amdgcn_mfma_f32_32x32x2f32(af[kk2 + 1], bfv[kk2 + 1], acc1, 0, 0, 0); }
        if (kh == 1) {
#pragma unroll
            for (int r = 0; r < 16; ++r) Pp[(bj * 2 + bi) * 1024 + r * 64 + lane] = acc0[r] + acc1[r];
        }
        CARRY_BAR();
        if (kh == 0) {
            float* so = SS + (size_t)(c + 1) * 4096;
#pragma unroll
            for (int r = 0; r < 16; ++r) { const int jo = ((r & 3) + 8 * (r >> 2)) * 64;
                const float nv = (acc0[r] + acc1[r]) + Pp[(bj * 2 + bi) * 1024 + r * 64 + lane] + lt[r];
                St[lo_o + jo] = nv;
                if (c < 63) so[lo_o + jo] = nv;
                else { const int j = 32 * bi + (r & 3) + 8 * (r >> 2) + 4 * hi, v = 32 * bj + l31; ((float*)a.out)[O_WP + ((size_t)(l * 16 + bh)) * 4096 + v * 64 + j] = nv; } }
        }
        CARRY_BAR();
    }
}

__device__ __forceinline__ void fixup_item(Frame& F, const Args& a, int l, int item, unsigned char* ws, bf16* ACTC) {
    const int b = item >> 7, chunk = (item >> 1) & 63, h = (item & 1) * 4 + (F.wave >> 1), th = F.wave & 1, lane = F.lane, l31 = lane & 31, hi = lane >> 5;
    LAS float* pr = (LAS float*)(F.lds + F.wave * 8704);
    LAS float* stt = pr + 2080;
    const size_t ro = ((size_t)(b * SEQ + chunk * 64 + 32 * th)) * BW + h * 64;
    const float* PR = (const float*)(ws + WS_PR) + ro; const float* OL = (const float*)(ws + WS_OL) + ro;
    const float* St = (const float*)(ws + WS_SS) + ((size_t)((b * 8 + h) * 64 + chunk)) * 4096;
    f32x16 acc[2];
    const float gg = ((const float*)a.in[28])[l * 512 + h * 64 + lane], gb = ((const float*)a.in[29])[l * 512 + h * 64 + lane];
    const float* Vv = (const float*)(ws + WS_V) + ro; const float* GG = (const float*)(ws + WS_GG) + ro; const float* RK = (const float*)(ws + WS_RK) + ((size_t)(b * SEQ + chunk * 64 + 32 * th)) * 8 + h;
    float b0[32], b1[32];
    {
        float prv[32];
#pragma unroll
        for (int t = 0; t < 32; ++t) prv[t] = PR[(size_t)t * BW + lane];
#pragma unroll
        for (int vj = 0; vj < 2; ++vj)
#pragma unroll
            for (int r = 0; r < 16; ++r) acc[vj][r] = OL[(size_t)((r & 3) + 8 * (r >> 2) + 4 * hi) * BW + 32 * vj + l31];
        if (chunk > 0) {
#pragma unroll
            for (int j = 0; j < 32; ++j) { const int m = 2 * j + hi; b0[j] = St[m * 64 + l31]; b1[j] = St[m * 64 + 32 + l31]; }
        }
#pragma unroll
        for (int t = 0; t < 32; ++t) pr[t * 65 + lane] = prv[t];
    }
    LDS_WAIT();
    if (chunk > 0) {
#pragma unroll
        for (int j = 0; j < 32; ++j) { const int m = 2 * j + hi; const float a0 = pr[l31 * 65 + m];
            acc[0] = __builtin_amdgcn_mfma_f32_32x32x2f32(a0, b0[j], acc[0], 0, 0, 0); acc[1] = __builtin_amdgcn_mfma_f32_32x32x2f32(a0, b1[j], acc[1], 0, 0, 0); }
    }
    float vv[32], gv[32], rk[32];
#pragma unroll
    for (int t = 0; t < 32; ++t) { vv[t] = Vv[(size_t)t * BW + lane]; gv[t] = GG[(size_t)t * BW + lane]; rk[t] = RK[(size_t)t * 8]; }
#pragma unroll
    for (int vj = 0; vj < 2; ++vj)
#pragma unroll
        for (int r = 0; r < 16; ++r) pr[((r & 3) + 8 * (r >> 2) + 4 * hi) * 65 + 32 * vj + l31] = acc[vj][r];
    LDS_WAIT();
    if (lane < 32) { float s1 = 0.f;
#pragma unroll 16
        for (int v = 0; v < 64; ++v) s1 += pr[lane * 65 + v];
        const float mean = s1 * (1.f / 64.f); float s2 = 0.f;
#pragma unroll 16
        for (int v = 0; v < 64; ++v) { const float d = pr[lane * 65 + v] - mean; s2 = fmaf(d, d, s2); }
        stt[lane * 2] = mean; stt[lane * 2 + 1] = 1.0f / sqrtf(s2 * (1.f / 64.f) + 64e-5f); }
    LDS_WAIT();
    bf16* op = ACTC + (size_t)(b * SEQ + chunk * 64 + 32 * th) * BW + h * 64 + lane;
#pragma unroll
    for (int t = 0; t < 32; ++t) {
        const float y = ((pr[t * 65 + lane] - stt[t * 2]) * stt[t * 2 + 1] * gg + gb + rk[t] * vv[t]) * gv[t];
        op[(size_t)t * BW] = (bf16)f2bf(y); }
    LDS_WAIT();
}
__device__ __forceinline__ void cpost_sample_item(Frame& F, const Args& a, int l, int part, unsigned char* ws, bf16* ACTC) {
    const int h = F.wave, lane = F.lane;
    const float gg = ((const float*)a.in[28])[l * 512 + h * 64 + lane], gb = ((const float*)a.in[29])[l * 512 + h * 64 + lane];
    float xo[8], vv[8], gv[8], rk[8];
#pragma unroll
    for (int j = 0; j < 8; ++j) { const int r = part * 8 + j; const size_t o = (size_t)(MP + r) * BW + h * 64 + lane;
        xo[j] = ((const float*)(ws + WS_OL))[o]; vv[j] = ((const float*)(ws + WS_V))[o]; gv[j] = ((const float*)(ws + WS_GG))[o]; rk[j] = ((const float*)(ws + WS_RK))[(size_t)(MP + r) * 8 + h]; }
#pragma unroll
    for (int j = 0; j < 8; ++j) { const int r = part * 8 + j; const size_t o = (size_t)(MP + r) * BW + h * 64 + lane;
        float x = xo[j];
        const float mean = wave_sum(x) * (1.f / 64.f); x -= mean;
        const float rstd = 1.0f / sqrtf(wave_sum(x * x) * (1.f / 64.f) + 64e-5f);
        ACTC[o] = (bf16)f2bf((x * rstd * gg + gb + rk[j] * vv[j]) * gv[j]); }
}
__device__ __forceinline__ void decode_combine_item(Frame& F, const Args& a, int l, int qi, unsigned char* ws, bf16* ACTB) {
    const int sb = F.wave, lane = F.lane, hh = lane >> 5;
    const float* QS = (const float*)(ws + WS_QS); const float* OSEG = (const float*)(ws + WS_OSEG); const float* TSEG = (const float*)(ws + WS_TSEG);
    const float* bias = (const float*)a.in[17] + l * 4; const float bz[2] = {bias[hh] * LOG2E, bias[2 + hh] * LOG2E};
    const float* kn = ((float*)a.out) + O_KS + ((size_t)l * MS + sb * 4) * 512; const float* vn = ((float*)a.out) + O_VS + ((size_t)l * MS + sb * 4) * 512;
    float one = 1.f; asm volatile("" : "+v"(one));
    f32x4 O[2] = {(f32x4){0.f, 0.f, 0.f, 0.f}, (f32x4){0.f, 0.f, 0.f, 0.f}}; float carry[2] = {one, one};
    f32x4 q[2];
#pragma unroll
    for (int g = 0; g < 2; ++g) q[g] = *(const f32x4*)(QS + (size_t)(sb * 4 + qi) * BW + g * 256 + 4 * lane);
    for (int j = qi - 1; j >= 0; --j) {
#pragma unroll
        for (int g = 0; g < 2; ++g) {
            const f32x4 kv = *(const f32x4*)(kn + (size_t)j * 512 + g * 256 + 4 * lane), p = kv * q[g];
            float d = (p[0] + p[1]) + (p[2] + p[3]);
#pragma unroll
            for (int o = 1; o < 32; o <<= 1) d += __shfl_xor(d, o);
            const float e = ex2(d + bz[g]), om = rcpf_(1.0f + e), att = e * om * carry[g];
            O[g] += *(const f32x4*)(vn + (size_t)j * 512 + g * 256 + 4 * lane) * att; carry[g] *= om;
        }
    }
#pragma unroll 1
    for (int hs = 1; hs >= 0; --hs) {
        float tv[2][32];
#pragma unroll
        for (int g = 0; g < 2; ++g)
#pragma unroll
            for (int sg = 0; sg < 32; ++sg) tv[g][sg] = TSEG[(size_t)(sb * 64 + hs * 32 + sg) * 16 + qi * 4 + g * 2 + hh];
#pragma unroll
        for (int g = 0; g < 2; ++g) { float c = carry[g];
#pragma unroll
            for (int sg = 31; sg >= 0; --sg) { const float t = tv[g][sg]; tv[g][sg] = c; c *= t; }
            carry[g] = c; }
#pragma unroll
        for (int sb8 = 0; sb8 < 4; ++sb8) {
            f32x4 ov[2][8];
#pragma unroll
            for (int g = 0; g < 2; ++g)
#pragma unroll
                for (int j = 0; j < 8; ++j) { const int seg = hs * 32 + sb8 * 8 + j; ov[g][j] = *(const f32x4*)(OSEG + ((size_t)(sb * 64 + seg) * 16 + qi * 4 + g * 2 + hh) * 128 + 4 * (lane & 31)); }
#pragma unroll
            for (int g = 0; g < 2; ++g)
#pragma unroll
                for (int j = 0; j < 8; ++j) O[g] += ov[g][j] * tv[g][sb8 * 8 + j];
        }
    }
    bf16* op = ACTB + (size_t)(MP + sb * 4 + qi) * BW;
#pragma unroll
    for (int g = 0; g < 2; ++g) *(u32x2*)(op + g * 256 + 4 * lane) = (u32x2){pk2(O[g][0], O[g][1]), pk2(O[g][2], O[g][3])};
}

template <int MODE>
__device__ __forceinline__ void skinny_rows(Frame& F, const bf16* A, size_t sA, const bf16* Bt, size_t sB, int K, const bf16* G, bf16* MB, const void* res, int rb16, float* out, bf16* Hn, float* rs) {
    constexpr int NBR = (MODE == 0) ? 4 : 1;
    const int u = F.vcu; if (u >= 256) return;
    const int rt = u & 1, ct = u >> 1, lane = F.lane, li = lane & 15, q = lane >> 4, w = F.wave;
    LAS f32x4* red = (LAS f32x4*)F.lds;
    f32x4 acc[NBR];
    const int nks = K / 32;
#pragma unroll
    for (int b = 0; b < NBR; ++b) {
        acc[b] = (f32x4){0.f, 0.f, 0.f, 0.f};
        const bf16* ap = A + (size_t)b * sA + (size_t)(MP + 16 * rt + li) * K + 8 * q;
        const bf16* bp = Bt + (size_t)b * sB + (size_t)(16 * ct + li) * K + 8 * q;
#pragma unroll 4
        for (int ks = w; ks < nks; ks += 8) {
            const bf16x8 av = *(const bf16x8*)(ap + 32 * ks), bv = *(const bf16x8*)(bp + 32 * ks);
            acc[b] = __builtin_amdgcn_mfma_f32_16x16x32_bf16(bv, av, acc[b], 0, 0, 0);
        }
        red[(w * NBR + b) * 64 + lane] = acc[b];
    }
    LDS_WAIT(); __syncthreads();
    if (w == 0) {
        const int row = MP + 16 * rt + li, col = 16 * ct + 4 * q;
        f32x4 tot = (f32x4){0.f, 0.f, 0.f, 0.f};
#pragma unroll
        for (int b = 0; b < NBR; ++b) {
            f32x4 v = red[b * 64 + lane];
#pragma unroll
            for (int j = 1; j < 8; ++j) v += red[(j * NBR + b) * 64 + lane];
            if (MODE == 0) { const u32x2 gw = *(const u32x2*)(G + (size_t)row * NGATE + (size_t)b * D + col);
                const f32x4 gf = (f32x4){__builtin_bit_cast(float, gw.x << 16), __builtin_bit_cast(float, gw.x & 0xffff0000u), __builtin_bit_cast(float, gw.y << 16), __builtin_bit_cast(float, gw.y & 0xffff0000u)};
                tot += v * gf; }
            else tot += v;
        }
        if (MODE == 0) *(u32x2*)(MB + (size_t)row * D + col) = (u32x2){pk2(tot[0], tot[1]), pk2(tot[2], tot[3])};
        else { f32x4 rv;
            if (rb16) { const u32x2 x = *(const u32x2*)((const bf16*)res + (size_t)row * D + col);
                rv = (f32x4){__builtin_bit_cast(float, x.x << 16), __builtin_bit_cast(float, x.x & 0xffff0000u), __builtin_bit_cast(float, x.y << 16), __builtin_bit_cast(float, x.y & 0xffff0000u)}; }
            else rv = *(const f32x4*)((const float*)res + (size_t)(row - MP) * D + col);
            const f32x4 v = rv + tot; if (out) *(f32x4*)(out + (size_t)(row - MP) * D + col) = v;
            if (Hn) { *(u32x2*)(Hn + (size_t)row * D + col) = (u32x2){pk2(v[0], v[1]), pk2(v[2], v[3])};
                float ss = (v[0] * v[0] + v[1] * v[1]) + (v[2] * v[2] + v[3] * v[3]); ss += __shfl_xor(ss, 16); ss += __shfl_xor(ss, 32);
                if (q == 0) (void)__hip_atomic_fetch_add(rs + row, ss, __ATOMIC_RELAXED, __HIP_MEMORY_SCOPE_AGENT); } }
    }
    __syncthreads();
}

constexpr int NPH = 1 + NL * 11;
__global__ void __launch_bounds__(512, 2) mk_fwd(Args args) {
    extern __shared__ __attribute__((aligned(16))) unsigned char lds_raw[];
    Frame F; F.lds = (LAS unsigned char*)lds_raw; F.tid = threadIdx.x; F.lane = F.tid & 63; F.wave = __builtin_amdgcn_readfirstlane(F.tid >> 6);
    F.G = gridDim.x; { const int bx = blockIdx.x; F.vcu = (F.G % 8 == 0) ? (bx % 8) * (F.G / 8) + bx / 8 : bx; }
    unsigned char* ws = (unsigned char*)args.ws;
    volatile LAS unsigned* MISC = (volatile LAS unsigned*)(F.lds + LDS_CTL_OFF);
    for (int u = F.tid; u < (LDS_BYTES - LDS_CTL_OFF) / 4; u += 512) ((LAS unsigned*)(F.lds + LDS_CTL_OFF))[u] = 0u;
    __syncthreads();
    const bool single = (args.ph_hi - args.ph_lo) > 1;
    XcdBarrier bar; bar.bar = (unsigned*)(ws + WS_CTL) + CW_BAR; bar.x = 0; bar.st = nullptr;
    if (single) bar = xcd_barrier_post((unsigned*)(ws + WS_CTL) + CW_BAR, MISC + 8);
    const int lo = args.ph_lo, hi = args.ph_hi; const int sel = args.li ? args.li : 0xff;
#ifndef PH_MASK
#define PH_MASK 0xFFFu
#endif
#define IN(k) (lo <= (k) && (k) < hi)
#define EN(x) (((PH_MASK) >> (x)) & 1u)
#define SEAM(k) do { if (IN(k) && IN((k) + 1)) xcd_barrier(bar); } while (0)

#define PH_PTRS GAS1 unsigned char* wsg_ = args.ws; int lp = l; asm volatile("" : "+s"(wsg_), "+s"(lp)); unsigned char* wsp = (unsigned char*)wsg_; Frame Fp = F; asm volatile("" : "+v"(Fp.tid), "+v"(Fp.lane), "+s"(Fp.wave), "+s"(Fp.vcu)); \
    bf16* H = (bf16*)(wsp + WS_H); bf16* P = (bf16*)(wsp + WS_P); bf16* G = (bf16*)(wsp + WS_G); bf16* ACT = (bf16*)(wsp + WS_ACT); float* MF = (float*)(wsp + WS_MF); bf16* MB = (bf16*)(wsp + WS_MB); \
    float* X1 = (float*)(wsp + WS_X1); bf16* HID = (bf16*)(wsp + WS_HID); float* XL = (float*)(wsp + WS_XL); bf16* QB = (bf16*)(wsp + WS_QB); bf16* KB = (bf16*)(wsp + WS_KB); bf16* VT = (bf16*)(wsp + WS_VT); float* QS = (float*)(wsp + WS_QS); \
    (void)H; (void)P; (void)G; (void)ACT; (void)MF; (void)MB; (void)X1; (void)HID; (void)XL; (void)QB; (void)KB; (void)VT; (void)QS;

    if (IN(0) && EN(11)) { const int l = 0; PH_PTRS; p0_convert(Fp, args); norm_phase(Fp, (const float*)args.in[0], (const float*)args.in[1], H); }
    SEAM(0);
    for (int l = 0; l < NL; ++l) {
        const int pb = 1 + l * 11;
        if (IN(pb + 0) && EN(0)) { PH_PTRS;
            pg8::Gemm g{H, (const bf16*)(wsp + WS_WIN + lp * SZ_WIN), MPAD, INW, D, 0, 0}; pg8::StaticOrder S; S.init(MPAD, INW, F.G, (int)blockIdx.x);
            pg8::EpiIn E{P, G, lp > 0 ? (const float*)((unsigned*)(wsp + WS_CTL) + CW_RS + ((lp - 1) * 2 + 1) * MPAD) : nullptr};
            pg8::gemm_phase<pg8::EpiIn, pg8::StaticOrder, true>(Fp.tid, Fp.lds, g, S, E);
        }
        SEAM(pb + 0);
        if (IN(pb + 1) && EN(1)) {
            constexpr int N_C = 257, N_A = 257, N_D = 264, N_B = 257;
            unsigned* qctr = (unsigned*)(ws + WS_CTL) + CW_Q + 64 * (l * 16 + 0);
            volatile LAS int* qslot = (volatile LAS int*)(F.lds + LDS_CTL_OFF + 64);
            int it = F.vcu;
            while (it < N_C + N_A + N_D + N_B) {
                int nx = 0; if (F.tid == 0) nx = 256 + (int)__hip_atomic_fetch_add(qctr, 1u, __ATOMIC_RELAXED, __HIP_MEMORY_SCOPE_AGENT);
                int r = it; PH_PTRS;
                if (r < N_C) { if (sel & 1) cprep_item(Fp, args, lp, r, P, wsp); }
                else if ((r -= N_C) < N_A) { if (sel & 4) { if (r < 256) gmlp_item(Fp, args, lp, r >> 2, r & 3, P, ACT); else gmlp_sample_item(Fp, args, lp, P, ACT); } }
                else if ((r -= N_A) < N_D) { if (sel & 2) dconv_item(Fp, args, lp, r, P, ACT + (size_t)3 * MPAD * BW); }
                else { r -= N_D; if (sel & 8) bprep_item(Fp, args, lp, r, P, QB, KB, VT, QS); }
                if (F.tid == 0) *qslot = nx;
                __syncthreads(); it = __builtin_amdgcn_readfirstlane(*qslot); __syncthreads();
            }
        }
        SEAM(pb + 1);
        if (IN(pb + 2) && EN(2)) {
            for (int it = F.vcu; it < 256; it += F.G) {
                PH_PTRS;
                if (sel & 1) scan_item(Fp, lp, it, wsp);
            }
        }
        SEAM(pb + 2);
        if (IN(pb + 3) && EN(3)) {
            const int u = F.vcu;
            if (u < 256) {
                { PH_PTRS; const int bh = u >> 5, qt = u & 31; if (qt < 2 && (sel & 1)) carry_item(Fp, args, lp, bh * 2 + qt, wsp); }
                if ((u & 31) == 2 && (sel & 1)) { PH_PTRS; scan_sample_item(Fp, args, lp, u >> 5, wsp); }
                {
                    unsigned* actr = (unsigned*)(ws + WS_CTL) + CW_Q + 64 * (l * 16 + 2 + (u >> 5));
                    volatile LAS int* qslot = (volatile LAS int*)(F.lds + LDS_CTL_OFF + 64);
                    for (;;) {
                        if (F.tid == 0) *qslot = (int)__hip_atomic_fetch_add(actr, 1u, __ATOMIC_RELAXED, __HIP_MEMORY_SCOPE_AGENT);
                        __syncthreads(); const int qi = __builtin_amdgcn_readfirstlane(*qslot); __syncthreads();
                        if (qi >= 112) break;
                        const int blk = qi / 7, pos = qi % 7;
                        PH_PTRS; const int bh = u >> 5;
                        if (pos == 0 || pos == 3 || pos == 5) {
                            if (!(sel & 2)) continue;
                            const int pi = 3 * blk + (pos == 0 ? 0 : pos == 3 ? 1 : 2);
                            const float b2 = ((const float*)args.in[17])[lp * 4 + (bh & 3)] * LOG2E;
                            bf16* AO = ACT + (size_t)1 * MPAD * BW;
                            int qt, kb_lo, nkb; f32x4* part = nullptr; float* tp = nullptr;
                            if (pi < 8) { qt = 15 - pi; kb_lo = 0; nkb = 2 * qt + 2; }
                            else if (pi >= 40) { qt = 47 - pi; kb_lo = 0; nkb = 2 * qt + 2; }
                            else { qt = 31 - ((pi - 8) >> 1); const int right = (pi - 8) & 1, q16 = qt - 16; kb_lo = right ? qt + 1 : 0; nkb = qt + 1;
                                part = (f32x4*)(wsp + WS_OPART) + ((size_t)((bh * 16 + q16) * 2 + right)) * 4096;
                                if (right) tp = (float*)(wsp + WS_TPART) + (size_t)(bh * 16 + q16) * 512; }
                            attn_unit(Fp, bh >> 2, bh & 3, qt, kb_lo, nkb, QB, KB, VT, AO, b2, part, tp);
                        } else {
                            if (!(sel & 4)) continue;
                            const int di = 4 * blk + (pos == 1 ? 0 : pos == 2 ? 1 : pos == 4 ? 2 : 3);
                            decode_item(Fp, args, lp, bh * 64 + di, wsp);
                        }
                    }
                }
            }
        }
        SEAM(pb + 3);
        if (IN(pb + 4) && EN(4)) {
            for (int it = F.vcu; it < 256 + 8; it += F.G) {
                PH_PTRS;
                if (it < 256) { fixup_item(Fp, args, lp, it, wsp, ACT + (size_t)2 * MPAD * BW); __syncthreads(); }
                else if (it < 260) cpost_sample_item(Fp, args, lp, it - 256, wsp, ACT + (size_t)2 * MPAD * BW);
                else decode_combine_item(Fp, args, lp, it - 260, wsp, ACT + (size_t)1 * MPAD * BW);
            }
            { const int ci = 255 - F.vcu; if (ci < 128) { PH_PTRS; attn_combine_item(Fp, ci, wsp, ACT + (size_t)1 * MPAD * BW); } }
        }
        SEAM(pb + 4);
        if (IN(pb + 5) && EN(5)) { PH_PTRS;
            pg8::Gemm g{ACT, (const bf16*)(wsp + WS_WBO + lp * SZ_WBO), MP, D, BW, (size_t)MPAD * BW, (size_t)D * BW}; pg8::MergeOrder S; S.so.initn(MP / 256, D / 128, F.G, (int)blockIdx.x);
            pg8::EpiMerge E{G, MB};
            pg8::gemm_phase<pg8::EpiMerge, pg8::MergeOrder, true, 1>(Fp.tid, Fp.lds, g, S, E);
            skinny_rows<0>(Fp, ACT, (size_t)MPAD * BW, (const bf16*)(wsp + WS_WBO + lp * SZ_WBO), (size_t)D * BW, BW, G, MB, nullptr, 0, nullptr, nullptr, nullptr);
        }
        SEAM(pb + 5);
        if (IN(pb + 6) && EN(6)) { PH_PTRS;
            const void* xin0 = lp == 0 ? (const void*)(const float*)args.in[0] : (const void*)H; const void* xin1 = lp == 0 ? (const void*)(const float*)args.in[1] : (const void*)H;
            pg8::Gemm g{MB, (const bf16*)(wsp + WS_WMIX + lp * SZ_WMIX), MP, D, D, 0, 0}; pg8::StaticOrder S; S.init(MP, D, F.G, (int)blockIdx.x);
            float* rsp = (float*)((unsigned*)(wsp + WS_CTL) + CW_RS + (lp * 2 + 0) * MPAD);
            pg8::EpiRes E{xin0, lp != 0, nullptr, H, rsp};
            pg8::gemm_phase<pg8::EpiRes, pg8::StaticOrder, true>(Fp.tid, Fp.lds, g, S, E);
            skinny_rows<1>(Fp, MB, 0, (const bf16*)(wsp + WS_WMIX + lp * SZ_WMIX), 0, D, nullptr, nullptr, xin1, lp != 0, nullptr, H, rsp);
        }
        SEAM(pb + 6);
        if (IN(pb + 8) && EN(8)) { PH_PTRS;
            pg8::Gemm g{H, (const bf16*)(wsp + WS_WGU + lp * SZ_WGU), MPAD, 2 * FF, D, 0, 0}; pg8::StaticOrder S; S.init(MPAD, 2 * FF, F.G, (int)blockIdx.x);
            pg8::EpiGU E{HID, (const float*)((unsigned*)(wsp + WS_CTL) + CW_RS + (lp * 2 + 0) * MPAD)};
            pg8::gemm_phase<pg8::EpiGU, pg8::StaticOrder, true>(Fp.tid, Fp.lds, g, S, E);
        }
        SEAM(pb + 8);
        if (IN(pb + 9) && EN(9)) { PH_PTRS;
            const bool nxt = lp + 1 < NL; float* yout = nxt ? nullptr : ((float*)args.out) + O_Y;
            pg8::Gemm g{HID, (const bf16*)(wsp + WS_WDN + lp * SZ_WDN), MP, D, FF, 0, 0}; pg8::StaticOrder S; S.init(MP, D, F.G, (int)blockIdx.x);
            float* rsp = (float*)((unsigned*)(wsp + WS_CTL) + CW_RS + (lp * 2 + 1) * MPAD);
            pg8::EpiRes E{H, 1, yout, nxt ? H : nullptr, rsp};
            pg8::gemm_phase<pg8::EpiRes, pg8::StaticOrder, true>(Fp.tid, Fp.lds, g, S, E);
            skinny_rows<1>(Fp, HID, 0, (const bf16*)(wsp + WS_WDN + lp * SZ_WDN), 0, FF, nullptr, nullptr, H, 1, nxt ? nullptr : yout + (size_t)MP * D, nxt ? H : nullptr, rsp);
        }
        if (l + 1 < NL) SEAM(pb + 9);
    }
#undef IN
#undef SEAM
}

#ifndef MK_PER_PHASE
#define MK_PER_PHASE 0
#endif
extern "C" void kernel_launch(void* const* d_in, const int* in_sizes, int n_in, void* d_out, int out_size, void* d_ws, size_t ws_size, hipStream_t stream) {
    static int grid = 0;
    if (grid == 0) {
        if (n_in != 41 || (size_t)out_size != O_END || ws_size < WS_END) { fprintf(stderr, "kernel_launch: unexpected shapes: n_in %d out %d ws %zu (need %zu)\n", n_in, out_size, ws_size, (size_t)WS_END); grid = -1; return; }
        int dev = 0, cus = 0, per_cu = 0;
        if (hipGetDevice(&dev) != hipSuccess || hipDeviceGetAttribute(&cus, hipDeviceAttributeMultiprocessorCount, dev) != hipSuccess) { grid = -1; return; }
        if (hipFuncSetAttribute((const void*)mk_fwd, hipFuncAttributeMaxDynamicSharedMemorySize, LDS_BYTES) != hipSuccess) { fprintf(stderr, "kernel_launch: hipFuncSetAttribute failed\n"); grid = -1; return; }
        if (hipOccupancyMaxActiveBlocksPerMultiprocessor(&per_cu, (const void*)mk_fwd, 512, LDS_BYTES) != hipSuccess || per_cu < 1) fprintf(stderr, "kernel_launch: occupancy query reports %d\n", per_cu);
        (void)hipGetLastError();
        grid = cus;
        if (grid != 256) fprintf(stderr, "kernel_launch: %d CUs (built for 256)\n", grid);
    }
    if (grid < 0) return;
    (void)hipMemsetAsync((char*)d_ws + WS_CTL, 0, CTL_BYTES, stream);
    Args a{};
    for (int i = 0; i < 41; ++i) a.in[i] = (const GAS1 void*)d_in[i];
    a.out = (GAS1 float*)d_out; a.ws = (GAS1 unsigned char*)d_ws; a.li = 0; a.pad = 0;
#ifndef MAX_PH
#define MAX_PH NPH
#endif
#if MK_PER_PHASE
    for (int p = 0; p < MAX_PH; ++p) { a.ph_lo = p; a.ph_hi = p + 1; hipLaunchKernelGGL(mk_fwd, dim3(grid), dim3(512), LDS_BYTES, stream, a); }
#else
    a.ph_lo = 0; a.ph_hi = MAX_PH;
    hipLaunchKernelGGL(mk_fwd, dim3(grid), dim3(512), LDS_BYTES, stream, a);
#endif
#ifdef PROBE_PH
    for (int r = 0; r < PROBE_N; ++r) { a.ph_lo = (PROBE_PH < 0) ? 0 : 1 + (NL - 1) * 11 + PROBE_PH; a.ph_hi = a.ph_lo + 1; a.li = PROBE_SEL; hipLaunchKernelGGL(mk_fwd, dim3(grid), dim3(512), LDS_BYTES, stream, a); }
#endif
    const hipError_t le = hipPeekAtLastError();
    if (le != hipSuccess) fprintf(stderr, "kernel_launch: launch failed: %s\n", hipGetErrorName(le));
}
```
